# Optimizing an MI355X kernel written in HIP

```python
import jax, jax.numpy as jnp
from jax import lax
import numpy as np

D_MODEL = 1024
BATCH = 4
SEQ = 8192
DEPTH = 2

HEAD_DIM = 64
ROPE_THETA = 10000.0
Q_BLOCK = 128
LN_EPS = 1e-5

NSA_HEADS = 8
NSA_KV_HEADS = 2
NSA_GROUP = NSA_HEADS // NSA_KV_HEADS
CMP_BLOCK = 32
CMP_STRIDE = 16
CMP_HIDDEN = 2 * HEAD_DIM
SLC_BLOCK = 64
SLC_TOPN = 16
WINDOW = 512
FORCE_BONUS = 1.0e4

MOBA_HEADS = 8
MOBA_BLOCK = 256
MOBA_TOPK = 3
MOBA_Q_BLOCK = 32

SB_HEADS = 16

N_GROUPS = 4
EXPERTS_PER_GROUP = 4
N_EXPERTS = N_GROUPS * EXPERTS_PER_GROUP
TOPK_IN_GROUP = 2
EXPERT_HIDDEN = 256

DEEPNORM_ALPHA = float((2 * DEPTH) ** 0.25)
DEEPNORM_BETA = float((8 * DEPTH) ** -0.25)

N_EVEN = (DEPTH + 1) // 2
N_ODD = DEPTH // 2

NSA_Q_W = NSA_HEADS * HEAD_DIM
NSA_KV_W = NSA_KV_HEADS * HEAD_DIM
NSA_GATE_W = 3 * NSA_HEADS
MOBA_W = MOBA_HEADS * HEAD_DIM
EVEN_WIDTHS = (NSA_Q_W, NSA_KV_W, NSA_KV_W, NSA_KV_W, NSA_KV_W, NSA_KV_W, NSA_KV_W,
               NSA_GATE_W, MOBA_W, MOBA_W, MOBA_W)
EVEN_IN_W = sum(EVEN_WIDTHS)
EVEN_SPLITS = tuple(int(v) for v in np.cumsum(EVEN_WIDTHS)[:-1])
EVEN_OUT_W = NSA_Q_W + MOBA_W
SB_W = SB_HEADS * HEAD_DIM

kernel_name = 'hybrid_nsa_moba_stickbreak_hmoe'


def layer_norm(x, g, b):
    xf = x.astype(jnp.float32)
    mu = jnp.mean(xf, axis=-1, keepdims=True)
    var = jnp.mean(jnp.square(xf - mu), axis=-1, keepdims=True)
    return ((xf - mu) * lax.rsqrt(var + LN_EPS) * g + b).astype(x.dtype)


def rope(x, positions):
    half = x.shape[-1] // 2
    inv_freq = ROPE_THETA ** (-jnp.arange(half, dtype=jnp.float32) / half)
    ang = positions.astype(jnp.float32)[..., None] * inv_freq
    cos = jnp.cos(ang)[:, :, None, :]
    sin = jnp.sin(ang)[:, :, None, :]
    x1 = x[..., :half].astype(jnp.float32)
    x2 = x[..., half:].astype(jnp.float32)
    return jnp.concatenate([x1 * cos - x2 * sin, x2 * cos + x1 * sin], axis=-1).astype(x.dtype)


def masked_softmax(s, mask):
    s = jnp.where(mask, s.astype(jnp.float32), -jnp.inf)
    m = jnp.max(s, axis=-1, keepdims=True)
    m = jnp.where(jnp.isfinite(m), m, 0.0)
    e = jnp.where(mask, jnp.exp(s - m), 0.0)
    return e / jnp.maximum(jnp.sum(e, axis=-1, keepdims=True), 1e-30)


def nsa_attention(q, k_cmp, v_cmp, k_slc, v_slc, k_win, v_win, gates,
                  cmp_pos_k, cmp_pos_v, cmp_w1_k, cmp_w2_k, cmp_w1_v, cmp_w2_v):
    B, S = q.shape[0], q.shape[1]
    scale = HEAD_DIM ** -0.5
    n_cmp = (S - CMP_BLOCK) // CMP_STRIDE + 1
    cmp_start = jnp.arange(n_cmp) * CMP_STRIDE
    cmp_end = cmp_start + CMP_BLOCK - 1
    tok_idx = cmp_start[:, None] + jnp.arange(CMP_BLOCK)[None, :]

    def compress(kv, pos_emb, w1, w2):
        blocks = kv[:, tok_idx] + pos_emb[None, None, :, None, :]
        flat = blocks.transpose(0, 1, 3, 2, 4).reshape(B, n_cmp, NSA_KV_HEADS, CMP_BLOCK * HEAD_DIM)
        return jax.nn.gelu(flat @ w1) @ w2

    kc = compress(k_cmp, cmp_pos_k, cmp_w1_k, cmp_w2_k)
    vc = compress(v_cmp, cmp_pos_v, cmp_w1_v, cmp_w2_v)

    n_slc = S // SLC_BLOCK
    slc_start = jnp.arange(n_slc) * SLC_BLOCK
    overlap = ((cmp_start[:, None] < slc_start[None, :] + SLC_BLOCK)
               & (cmp_end[:, None] >= slc_start[None, :])).astype(jnp.float32)
    top_n = min(SLC_TOPN, n_slc)
    kb = k_slc.reshape(B, n_slc, SLC_BLOCK, NSA_KV_HEADS, HEAD_DIM).transpose(0, 3, 1, 2, 4)
    vb = v_slc.reshape(B, n_slc, SLC_BLOCK, NSA_KV_HEADS, HEAD_DIM).transpose(0, 3, 1, 2, 4)
    pad = ((0, 0), (WINDOW, 0), (0, 0), (0, 0))
    kwp = jnp.pad(k_win, pad)
    vwp = jnp.pad(v_win, pad)
    bi = jnp.arange(B)[:, None, None, None]
    hi = jnp.arange(NSA_KV_HEADS)[None, :, None, None]
    blk_ids = jnp.arange(n_slc)

    def one_block(b):
        q0 = b * Q_BLOCK
        t = q0 + jnp.arange(Q_BLOCK)
        qb = lax.dynamic_slice_in_dim(q, q0, Q_BLOCK, axis=1).reshape(
            B, Q_BLOCK, NSA_KV_HEADS, NSA_GROUP, HEAD_DIM)
        gb = lax.dynamic_slice_in_dim(gates, q0, Q_BLOCK, axis=1).reshape(
            B, Q_BLOCK, NSA_KV_HEADS, NSA_GROUP, 3)
        s_c = jnp.einsum('bqkgd,bnkd->bkgqn', qb, kc) * scale
        p_c = masked_softmax(s_c, cmp_end[None, :] <= t[:, None])
        o_c = jnp.einsum('bkgqn,bnkd->bqkgd', p_c.astype(vc.dtype), vc)
        imp = jnp.einsum('bkgqn,nj->bkqj', p_c, overlap)
        cur = t // SLC_BLOCK
        forced = ((blk_ids[None, :] == 0) | (blk_ids[None, :] == cur[:, None])
                  | (blk_ids[None, :] == cur[:, None] - 1))
        valid = blk_ids[None, :] <= cur[:, None]
        score = jnp.where(forced, imp + FORCE_BONUS, jnp.where(valid, imp, -1.0))
        _, sel = lax.top_k(score, top_n)
        sel_ok = sel <= cur[None, None, :, None]
        ks = kb[bi, hi, sel]
        vs = vb[bi, hi, sel]
        kpos = sel[..., None] * SLC_BLOCK + jnp.arange(SLC_BLOCK)
        m_s = sel_ok[..., None] & (kpos <= t[None, None, :, None, None])
        n_keys = top_n * SLC_BLOCK
        s_s = jnp.einsum('bqkgd,bkqnld->bkgqnl', qb, ks).reshape(
            B, NSA_KV_HEADS, NSA_GROUP, Q_BLOCK, n_keys) * scale
        p_s = masked_softmax(s_s, m_s.reshape(B, NSA_KV_HEADS, Q_BLOCK, n_keys)[:, :, None])
        o_s = jnp.einsum('bkgqm,bkqmd->bqkgd', p_s.astype(vs.dtype),
                         vs.reshape(B, NSA_KV_HEADS, Q_BLOCK, n_keys, HEAD_DIM))
        kw = lax.dynamic_slice_in_dim(kwp, q0, WINDOW + Q_BLOCK, axis=1)
        vw = lax.dynamic_slice_in_dim(vwp, q0, WINDOW + Q_BLOCK, axis=1)
        wpos = q0 - WINDOW + jnp.arange(WINDOW + Q_BLOCK)
        dist = t[:, None] - wpos[None, :]
        m_w = (dist >= 0) & (dist < WINDOW) & (wpos[None, :] >= 0)
        s_w = jnp.einsum('bqkgd,bskd->bkgqs', qb, kw) * scale
        p_w = masked_softmax(s_w, m_w)
        o_w = jnp.einsum('bkgqs,bskd->bqkgd', p_w.astype(vw.dtype), vw)
        o = gb[..., 0:1] * o_c + gb[..., 1:2] * o_s + gb[..., 2:3] * o_w
        return o.reshape(B, Q_BLOCK, NSA_Q_W)

    out = lax.map(one_block, jnp.arange(S // Q_BLOCK))
    return out.transpose(1, 0, 2, 3).reshape(B, S, NSA_Q_W)


def moba_attention(q, k, v):
    B, S = q.shape[0], q.shape[1]
    scale = HEAD_DIM ** -0.5
    n_blk = -(-S // MOBA_BLOCK)
    pad = n_blk * MOBA_BLOCK - S
    kp = jnp.pad(k, ((0, 0), (0, pad), (0, 0), (0, 0)))
    vp = jnp.pad(v, ((0, 0), (0, pad), (0, 0), (0, 0)))
    kb = kp.reshape(B, n_blk, MOBA_BLOCK, MOBA_HEADS, HEAD_DIM).transpose(0, 3, 1, 2, 4)
    vb = vp.reshape(B, n_blk, MOBA_BLOCK, MOBA_HEADS, HEAD_DIM).transpose(0, 3, 1, 2, 4)
    k_mean = jnp.mean(kb.astype(jnp.float32), axis=3).astype(k.dtype)
    top_k = min(MOBA_TOPK, n_blk)
    bi = jnp.arange(B)[:, None, None, None]
    hi = jnp.arange(MOBA_HEADS)[None, :, None, None]
    blk_ids = jnp.arange(n_blk)
    n_sel = top_k * MOBA_BLOCK

    def one_block(b):
        q0 = b * MOBA_Q_BLOCK
        t = q0 + jnp.arange(MOBA_Q_BLOCK)
        cur = q0 // MOBA_BLOCK
        qb = lax.dynamic_slice_in_dim(q, q0, MOBA_Q_BLOCK, axis=1)
        gate = jnp.einsum('bqhd,bhnd->bhqn', qb, k_mean).astype(jnp.float32)
        gate = jnp.where(blk_ids < cur, gate, -jnp.inf)
        _, sel = lax.top_k(gate, top_k)
        sel_ok = sel < cur
        ks = kb[bi, hi, sel]
        vs = vb[bi, hi, sel]
        s_sel = jnp.einsum('bqhd,bhqnld->bhqnl', qb, ks).reshape(B, MOBA_HEADS, MOBA_Q_BLOCK, n_sel) * scale
        m_sel = jnp.broadcast_to(sel_ok[..., None], sel.shape + (MOBA_BLOCK,)).reshape(
            B, MOBA_HEADS, MOBA_Q_BLOCK, n_sel)
        k_own = lax.dynamic_index_in_dim(kb, cur, axis=2, keepdims=False)
        v_own = lax.dynamic_index_in_dim(vb, cur, axis=2, keepdims=False)
        s_own = jnp.einsum('bqhd,bhld->bhql', qb, k_own) * scale
        own_pos = cur * MOBA_BLOCK + jnp.arange(MOBA_BLOCK)
        m_own = jnp.broadcast_to(own_pos[None, :] <= t[:, None], (B, MOBA_HEADS, MOBA_Q_BLOCK, MOBA_BLOCK))
        p = masked_softmax(jnp.concatenate([s_sel, s_own], axis=-1),
                           jnp.concatenate([m_sel, m_own], axis=-1)).astype(v.dtype)
        o = (jnp.einsum('bhqm,bhqmd->bqhd', p[..., :n_sel],
                        vs.reshape(B, MOBA_HEADS, MOBA_Q_BLOCK, n_sel, HEAD_DIM))
             + jnp.einsum('bhql,bhld->bqhd', p[..., n_sel:], v_own))
        return o.reshape(B, MOBA_Q_BLOCK, MOBA_W)

    out = lax.map(one_block, jnp.arange(S // MOBA_Q_BLOCK))
    return out.transpose(1, 0, 2, 3).reshape(B, S, MOBA_W)


def stick_breaking_attention(q, k, v):
    B, S = q.shape[0], q.shape[1]
    scale = HEAD_DIM ** -0.5
    kpos = jnp.arange(S)

    def one_block(b):
        q0 = b * Q_BLOCK
        t = q0 + jnp.arange(Q_BLOCK)
        qb = lax.dynamic_slice_in_dim(q, q0, Q_BLOCK, axis=1)
        z = jnp.einsum('bqhd,bshd->bhqs', qb, k).astype(jnp.float32) * scale
        mask = kpos[None, :] < t[:, None]
        log_1m = jnp.where(mask, jax.nn.log_sigmoid(-z), 0.0)
        between = lax.cumsum(log_1m, axis=3, reverse=True) - log_1m
        w = jnp.where(mask, jnp.exp(jax.nn.log_sigmoid(z) + between), 0.0)
        o = jnp.einsum('bhqs,bshd->bqhd', w.astype(v.dtype), v)
        return o.reshape(B, Q_BLOCK, SB_W)

    out = lax.map(one_block, jnp.arange(S // Q_BLOCK))
    return out.transpose(1, 0, 2, 3).reshape(B, S, SB_W)


def nsa_moba_mixer(x, positions, w_in, w_out, cmp_pos_k, cmp_pos_v, cmp_w1_k, cmp_w2_k, cmp_w1_v, cmp_w2_v):
    B, S = x.shape[0], x.shape[1]
    proj = x @ w_in
    qa, kc, vc, ksl, vsl, kw, vw, ga, qm, km, vm = jnp.split(proj, EVEN_SPLITS, axis=-1)
    heads = lambda a, h: a.reshape(B, S, h, HEAD_DIM)
    qa = rope(heads(qa, NSA_HEADS), positions)
    kc = rope(heads(kc, NSA_KV_HEADS), positions)
    ksl = rope(heads(ksl, NSA_KV_HEADS), positions)
    kw = rope(heads(kw, NSA_KV_HEADS), positions)
    gates = jax.nn.sigmoid(ga.astype(jnp.float32)).astype(x.dtype).reshape(B, S, NSA_HEADS, 3)
    o_a = nsa_attention(qa, kc, heads(vc, NSA_KV_HEADS), ksl, heads(vsl, NSA_KV_HEADS),
                        kw, heads(vw, NSA_KV_HEADS), gates,
                        cmp_pos_k, cmp_pos_v, cmp_w1_k, cmp_w2_k, cmp_w1_v, cmp_w2_v)
    o_b = moba_attention(rope(heads(qm, MOBA_HEADS), positions),
                         rope(heads(km, MOBA_HEADS), positions), heads(vm, MOBA_HEADS))
    return jnp.concatenate([o_a, o_b], axis=-1) @ w_out


def stick_breaking_mixer(x, w_in, w_out):
    B, S = x.shape[0], x.shape[1]
    q, k, v = jnp.split(x @ w_in, 3, axis=-1)
    heads = lambda a: a.reshape(B, S, SB_HEADS, HEAD_DIM)
    return stick_breaking_attention(heads(q), heads(k), heads(v)) @ w_out


def hierarchical_moe(x, w_grp, b_grp, w_rt, b_rt, w_gate, w_up, w_down):
    p_grp = jax.nn.softmax((x @ w_grp + b_grp).astype(jnp.float32), axis=-1)
    g = jnp.argmax(p_grp, axis=-1)
    w_g = jnp.max(p_grp, axis=-1)
    logits_all = jnp.einsum('bsd,gde->bsge', x, w_rt) + b_rt
    logits = jnp.take_along_axis(logits_all, g[..., None, None], axis=2)[..., 0, :].astype(jnp.float32)
    top_val, top_idx = lax.top_k(logits, TOPK_IN_GROUP)
    w_e = jax.nn.softmax(top_val, axis=-1) * w_g[..., None]
    expert_id = g[..., None] * EXPERTS_PER_GROUP + top_idx
    combine = jnp.sum(jax.nn.one_hot(expert_id, N_EXPERTS, dtype=jnp.float32) * w_e[..., None], axis=2)

    def per_sequence(args):
        xs, cs = args
        h = jax.nn.silu(jnp.einsum('sd,edf->sef', xs, w_gate)) * jnp.einsum('sd,edf->sef', xs, w_up)
        return jnp.einsum('sef,efd->sd', h * cs[..., None].astype(h.dtype), w_down)

    return lax.map(per_sequence, (x, combine))


def _normal(key, shape, std):
    return jax.random.normal(key, shape, jnp.float32) * std


def setup_inputs(seed: int = 0) -> dict:
    key = jax.random.key(seed)
    ks = jax.random.split(key, 24)
    D = D_MODEL
    flat_cmp = CMP_BLOCK * HEAD_DIM
    return {
        'x': jax.random.normal(ks[0], (BATCH, SEQ, D), jnp.float32),
        'positions': jnp.broadcast_to(jnp.arange(SEQ, dtype=jnp.int32), (BATCH, SEQ)),
        'ab_w_in': _normal(ks[1], (N_EVEN, D, EVEN_IN_W), D ** -0.5),
        'ab_w_out': _normal(ks[2], (N_EVEN, EVEN_OUT_W, D), DEEPNORM_BETA * EVEN_OUT_W ** -0.5),
        'nsa_cmp_pos_k': _normal(ks[3], (N_EVEN, CMP_BLOCK, HEAD_DIM), 0.02),
        'nsa_cmp_pos_v': _normal(ks[4], (N_EVEN, CMP_BLOCK, HEAD_DIM), 0.02),
        'nsa_cmp_w1_k': _normal(ks[5], (N_EVEN, flat_cmp, CMP_HIDDEN), flat_cmp ** -0.5),
        'nsa_cmp_w2_k': _normal(ks[6], (N_EVEN, CMP_HIDDEN, HEAD_DIM), CMP_HIDDEN ** -0.5),
        'nsa_cmp_w1_v': _normal(ks[7], (N_EVEN, flat_cmp, CMP_HIDDEN), flat_cmp ** -0.5),
        'nsa_cmp_w2_v': _normal(ks[8], (N_EVEN, CMP_HIDDEN, HEAD_DIM), CMP_HIDDEN ** -0.5),
        'sb_w_in': _normal(ks[9], (N_ODD, D, 3 * SB_W), D ** -0.5),
        'sb_w_out': _normal(ks[10], (N_ODD, SB_W, D), DEEPNORM_BETA * SB_W ** -0.5),
        'ln_mix_g': 1.0 + _normal(ks[11], (DEPTH, D), 0.02),
        'ln_mix_b': _normal(ks[12], (DEPTH, D), 0.02),
        'ln_ffn_g': 1.0 + _normal(ks[13], (DEPTH, D), 0.02),
        'ln_ffn_b': _normal(ks[14], (DEPTH, D), 0.02),
        'moe_w_grp': _normal(ks[15], (DEPTH, D, N_GROUPS), D ** -0.5),
        'moe_b_grp': _normal(ks[16], (DEPTH, N_GROUPS), 0.01),
        'moe_w_rt': _normal(ks[17], (DEPTH, N_GROUPS, D, EXPERTS_PER_GROUP), D ** -0.5),
        'moe_b_rt': _normal(ks[18], (DEPTH, N_GROUPS, EXPERTS_PER_GROUP), 0.01),
        'moe_w_gate': _normal(ks[19], (DEPTH, N_EXPERTS, D, EXPERT_HIDDEN), D ** -0.5),
        'moe_w_up': _normal(ks[20], (DEPTH, N_EXPERTS, D, EXPERT_HIDDEN), D ** -0.5),
        'moe_w_down': _normal(ks[21], (DEPTH, N_EXPERTS, EXPERT_HIDDEN, D), DEEPNORM_BETA * EXPERT_HIDDEN ** -0.5),
    }


def reference(x, positions, ab_w_in, ab_w_out, nsa_cmp_pos_k, nsa_cmp_pos_v, nsa_cmp_w1_k, nsa_cmp_w2_k,
              nsa_cmp_w1_v, nsa_cmp_w2_v, sb_w_in, sb_w_out, ln_mix_g, ln_mix_b, ln_ffn_g, ln_ffn_b,
              moe_w_grp, moe_b_grp, moe_w_rt, moe_b_rt, moe_w_gate, moe_w_up, moe_w_down):
    for layer in range(DEPTH):
        i = layer // 2
        if layer % 2 == 0:
            mix = nsa_moba_mixer(x, positions, ab_w_in[i], ab_w_out[i], nsa_cmp_pos_k[i], nsa_cmp_pos_v[i],
                                 nsa_cmp_w1_k[i], nsa_cmp_w2_k[i], nsa_cmp_w1_v[i], nsa_cmp_w2_v[i])
        else:
            mix = stick_breaking_mixer(x, sb_w_in[i], sb_w_out[i])
        x = layer_norm(DEEPNORM_ALPHA * x + mix, ln_mix_g[layer], ln_mix_b[layer])
        ffn = hierarchical_moe(x, moe_w_grp[layer], moe_b_grp[layer], moe_w_rt[layer], moe_b_rt[layer],
                               moe_w_gate[layer], moe_w_up[layer], moe_w_down[layer])
        x = layer_norm(DEEPNORM_ALPHA * x + ffn, ln_ffn_g[layer], ln_ffn_b[layer])
    return x
```

```cpp
#include <hip/hip_runtime.h>
#include <cstdio>
#include <cstdint>
#include <cmath>

#ifndef MK_N_LAUNCHES
#define MK_N_LAUNCHES 0
#endif

namespace pg8 {
#define PG8_LAS __attribute__((address_space(3)))
typedef unsigned short bf16_t;
typedef short bf16x8 __attribute__((ext_vector_type(8)));
typedef float f32x4 __attribute__((ext_vector_type(4)));
typedef unsigned u32x4 __attribute__((ext_vector_type(4)));
constexpr int BM = 256, BK = 64, HALF = 128, HTB = HALF * BK * 2  , STAGE_BYTES = 8 * HTB, NXCD = 8, WGM = 8;

__host__ __device__ __forceinline__ int lds_byte(int r, int c) { const int st = (r >> 4) * 2 + (c >> 5), rr = r & 15, cc = c & 31, ob = rr * 64 + cc * 2; return st * 1024 + (ob ^ (((ob >> 9) & 1) << 5)); }
__host__ __device__ __forceinline__ void stage_rc(int b, int& R, int& C) { const int st = b / 1024, sb = b % 1024, swz = sb ^ (((sb >> 9) & 1) << 5); R = (st >> 1) * 16 + swz / 64; C = (st & 1) * 32 + (swz % 64) / 2; }
__host__ __device__ __forceinline__ int perm32(int rho) { const int n = rho >> 4, i = rho & 15; return 8 * (i >> 2) + 4 * n + (i & 3); }

struct Unit { int pm, pn, aux; };
struct Gemm { const bf16_t* A; const bf16_t* Bt; int M, N, K; };

struct StaticOrder {
    int nM, nN, nwg, G, c;
    __host__ __device__ void init(int M, int N, int G_, int c_) { nM = M / BM; nN = N / BM; nwg = nM * nN; G = G_; c = c_; }
    __host__ __device__ bool next(int i, Unit& u) const {
        const long L = (long)i * G + c; if (L >= nwg) return false;
        int wgid = (int)L; { const int q = nwg / NXCD, r = nwg % NXCD, xcd = wgid % NXCD, off = wgid / NXCD; wgid = (xcd < r ? xcd * (q + 1) : r * (q + 1) + (xcd - r) * q) + off; }
        const int nig = WGM * nN, gid = wgid / nig, fm = gid * WGM, gsz = (nM - fm) < WGM ? (nM - fm) : WGM;
        u.pm = fm + ((wgid % nig) % gsz); u.pn = (wgid % nig) / gsz; u.aux = 0; return true;
    }
    __device__ __forceinline__ const char* aptr(const Gemm& g, const Unit& u, size_t tstep) const { return (const char*)g.A + (size_t)u.pm * tstep; }
    __device__ __forceinline__ const char* bptr(const Gemm& g, const Unit& u, size_t tstep) const { return (const char*)g.Bt + (size_t)u.pn * tstep; }
    __device__ __forceinline__ void a_ready(const Unit&) const {}
    __device__ __forceinline__ void done(const Unit&) const {}
};

__device__ __forceinline__ unsigned cvt_pk_bf16(float lo, float hi) { unsigned r; asm volatile("v_cvt_pk_bf16_f32 %0, %1, %2" : "=v"(r) : "v"(lo), "v"(hi)); return r; }
typedef unsigned u32x2 __attribute__((ext_vector_type(2)));
constexpr int SEQ_ = 8192;
constexpr size_t E_QA = 0, E_KCMP = 16777216, E_KSLC = 20971520, E_KWIN = 25165824, E_VCMP = 29360128, E_VSLC = 33554432, E_VWIN = 37748736,
                 E_QM = 41943040, E_KM = 58720256, E_VM = 75497472;

struct EpiProj0 {
    static constexpr bool PERM = true, AFTER_DRAIN = false;
    bf16_t* qkv; float* gates; const float* cosT; const float* sinT;
    __device__ __forceinline__ void operator()(const f32x4 (&acc)[2][2][4][2], const Unit& u, int wr, int wc, int fr, int fq) const {
        const int row0 = u.pm * BM + wr * 64 + fr;
#pragma unroll
        for (int bj = 0; bj < 2; ++bj) {
            const int hs = u.pn * 4 + bj * 2 + (wc >> 1);
            const int p0 = 32 * (wc & 1) + 8 * fq;
            if (hs < 44) {
                const bool rope = (hs < 14) || (hs >= 20 && hs < 36);
                size_t base; int nh, hh;
                if (hs < 8) { base = E_QA; nh = 8; hh = hs; }
                else if (hs < 20) { base = E_KCMP + (size_t)((hs - 8) >> 1) * 4194304; nh = 2; hh = (hs - 8) & 1; }
                else { base = E_QM + (size_t)((hs - 20) >> 3) * 16777216; nh = 8; hh = (hs - 20) & 7; }
#pragma unroll
                for (int ai = 0; ai < 2; ++ai)
#pragma unroll
                    for (int m = 0; m < 4; ++m) {
                        const int r = row0 + ai * HALF + m * 16, b = r >> 13, s = r & (SEQ_ - 1);
                        f32x4 v0 = acc[ai][bj][m][0], v1 = acc[ai][bj][m][1];
                        if (rope) {
                            const f32x4 c4 = *(const f32x4*)(cosT + (size_t)r * 32 + (p0 >> 1)), s4 = *(const f32x4*)(sinT + (size_t)r * 32 + (p0 >> 1));
                            const f32x4 w0 = v0, w1 = v1;
                            v0[0] = w0[0] * c4[0] - w0[1] * s4[0]; v0[1] = w0[1] * c4[0] + w0[0] * s4[0];
                            v0[2] = w0[2] * c4[1] - w0[3] * s4[1]; v0[3] = w0[3] * c4[1] + w0[2] * s4[1];
                            v1[0] = w1[0] * c4[2] - w1[1] * s4[2]; v1[1] = w1[1] * c4[2] + w1[0] * s4[2];
                            v1[2] = w1[2] * c4[3] - w1[3] * s4[3]; v1[3] = w1[3] * c4[3] + w1[2] * s4[3];
                        }
                        u32x4 w; w.x = cvt_pk_bf16(v0[0], v0[1]); w.y = cvt_pk_bf16(v0[2], v0[3]); w.z = cvt_pk_bf16(v1[0], v1[1]); w.w = cvt_pk_bf16(v1[2], v1[3]);
                        *(u32x4*)(qkv + base + ((size_t)(b * nh + hh) * SEQ_ + s) * 64 + p0) = w;
                    }
            } else if (hs == 44) {
                if ((wc & 1) == 0 && fq < 3) {
#pragma unroll
                    for (int ai = 0; ai < 2; ++ai)
#pragma unroll
                        for (int m = 0; m < 4; ++m) {
                            const int r = row0 + ai * HALF + m * 16;
                            f32x4 v0 = acc[ai][bj][m][0], v1 = acc[ai][bj][m][1];
#pragma unroll
                            for (int e = 0; e < 4; ++e) { v0[e] = 1.0f / (1.0f + __expf(-v0[e])); v1[e] = 1.0f / (1.0f + __expf(-v1[e])); }
                            *(f32x4*)(gates + (size_t)r * 24 + p0) = v0; *(f32x4*)(gates + (size_t)r * 24 + p0 + 4) = v1;
                        }
                }
            }
        }
    }
};
struct EpiProj1 {
    static constexpr bool PERM = true, AFTER_DRAIN = false;
    bf16_t* qkv;
    __device__ __forceinline__ void operator()(const f32x4 (&acc)[2][2][4][2], const Unit& u, int wr, int wc, int fr, int fq) const {
        const int row0 = u.pm * BM + wr * 64 + fr;
#pragma unroll
        for (int bj = 0; bj < 2; ++bj) {
            const int hs = u.pn * 4 + bj * 2 + (wc >> 1), p0 = 32 * (wc & 1) + 8 * fq, hh = hs & 15;
            const size_t base = (size_t)(hs >> 4) * 33554432;
#pragma unroll
            for (int ai = 0; ai < 2; ++ai)
#pragma unroll
                for (int m = 0; m < 4; ++m) {
                    const int r = row0 + ai * HALF + m * 16, b = r >> 13, s = r & (SEQ_ - 1);
                    const f32x4 v0 = acc[ai][bj][m][0], v1 = acc[ai][bj][m][1];
                    u32x4 w; w.x = cvt_pk_bf16(v0[0], v0[1]); w.y = cvt_pk_bf16(v0[2], v0[3]); w.z = cvt_pk_bf16(v1[0], v1[1]); w.w = cvt_pk_bf16(v1[2], v1[3]);
                    *(u32x4*)(qkv + base + ((size_t)(b * 16 + hh) * SEQ_ + s) * 64 + p0) = w;
                }
        }
    }
};
struct EpiRes {
    static constexpr bool PERM = false, AFTER_DRAIN = false;
    const float* resid; float* out; float alpha;
    __device__ __forceinline__ void operator()(const f32x4 (&acc)[2][2][4][2], const Unit& u, int wr, int wc, int fr, int fq) const {
        const int row0 = u.pm * BM + wr * 64 + fr, col0 = u.pn * BM + wc * 32 + 4 * fq;
#pragma unroll
        for (int ai = 0; ai < 2; ++ai)
#pragma unroll
            for (int m = 0; m < 4; ++m) { const size_t off = (size_t)(row0 + ai * HALF + m * 16) * 1024 + col0;
#pragma unroll
                for (int bj = 0; bj < 2; ++bj)
#pragma unroll
                    for (int n = 0; n < 2; ++n) { const f32x4 bs = *(const f32x4*)(resid + off + bj * HALF + n * 16); *(f32x4*)(out + off + bj * HALF + n * 16) = bs * alpha + acc[ai][bj][m][n]; } }
    }
};
struct EpiMoe1 {
    static constexpr bool PERM = true, AFTER_DRAIN = false;
    bf16_t* H; const float* wrow;
    __device__ __forceinline__ void operator()(const f32x4 (&acc)[2][2][4][2], const Unit& u, int wr, int wc, int fr, int fq) const {
        const int row0 = u.pm * BM + wr * 64 + fr, slot = u.pn >> 1;
#pragma unroll
        for (int ai = 0; ai < 2; ++ai)
#pragma unroll
            for (int m = 0; m < 4; ++m) { const int prow = row0 + ai * HALF + m * 16; const float w = wrow[(size_t)prow * 2 + slot];
#pragma unroll
                for (int bj = 0; bj < 2; ++bj) { const f32x4 g = acc[ai][bj][m][0], up = acc[ai][bj][m][1]; float hv[4];
#pragma unroll
                    for (int e = 0; e < 4; ++e) hv[e] = g[e] / (1.0f + __expf(-g[e])) * up[e] * w;
                    u32x2 o; o.x = cvt_pk_bf16(hv[0], hv[1]); o.y = cvt_pk_bf16(hv[2], hv[3]);
                    *(u32x2*)(H + (size_t)prow * 512 + u.pn * 128 + bj * 64 + wc * 16 + 4 * fq) = o; } }
    }
};
struct EpiMoe2 {
    static constexpr bool PERM = false, AFTER_DRAIN = false;
    float* R; const int* rowmap; float alpha;
    __device__ __forceinline__ void operator()(const f32x4 (&acc)[2][2][4][2], const Unit& u, int wr, int wc, int fr, int fq) const {
        const int row0 = u.pm * BM + wr * 64 + fr, col0 = u.pn * BM + wc * 32 + 4 * fq;
#pragma unroll
        for (int ai = 0; ai < 2; ++ai)
#pragma unroll
            for (int m = 0; m < 4; ++m) { const int tok = rowmap[row0 + ai * HALF + m * 16];
                if (tok >= 0) { const size_t off = (size_t)tok * 1024 + col0;
#pragma unroll
                    for (int bj = 0; bj < 2; ++bj)
#pragma unroll
                        for (int n = 0; n < 2; ++n) { const f32x4 bs = *(const f32x4*)(R + off + bj * HALF + n * 16); *(f32x4*)(R + off + bj * HALF + n * 16) = bs * alpha + acc[ai][bj][m][n]; } } }
    }
};

template <class Epi, class Sched, bool ALIGN_EPI = false, bool SP2 = false>
__device__ __forceinline__ void gemm_phase(PG8_LAS unsigned char* lds, const Gemm g, const Sched& S, const Epi& E) {
    const int tid = threadIdx.x, wid = __builtin_amdgcn_readfirstlane(tid >> 6), lane = tid & 63, wr = wid >> 2, wc = wid & 3, fr = lane & 15, fq = lane >> 4;
    const int K = g.K, nt = K / BK;
    unsigned voffA[2], voffB[2];
#pragma unroll
    for (int i = 0; i < 2; ++i) { int R, C; stage_rc(tid * 16 + i * 8192, R, C); const int Rb = Epi::PERM ? ((R & ~31) + perm32(R & 31)) : R;
        voffA[i] = (unsigned)(R * K + C) * 2u; voffB[i] = (unsigned)(Rb * K + C) * 2u; }
    const size_t kstep = (size_t)(BK * 2);
    const size_t hstep = (size_t)HALF * K * 2;
    const size_t tstep = 2 * hstep;
    const unsigned ldsw = (unsigned)wid * 1024u;
    const int aoff = lds_byte(wr * 64 + fr, fq * 8), boff = lds_byte(wc * 32 + fr, fq * 8);
#define PG8_SA(b, h) (((b) * 2 + (h)) * HTB)
#define PG8_SB(b, h) ((4 + (b) * 2 + (h)) * HTB)
#define PG8_STAGE(bufoff, gbase, voff) do { _Pragma("unroll") for (int _i = 0; _i < 2; ++_i) \
        __builtin_amdgcn_global_load_lds((const unsigned*)((const char*)(gbase) + (voff)[_i]), (PG8_LAS unsigned*)(lds + (bufoff) + ldsw + _i * 8192), 16, 0, 0); } while (0)
#define PG8_LDA(dst, b, h) do { _Pragma("unroll") for (int m = 0; m < 4; ++m) _Pragma("unroll") for (int k = 0; k < 2; ++k) dst[m][k] = *(const PG8_LAS bf16x8*)(lds + PG8_SA(b, h) + aoff + m * 2048 + k * 1024); } while (0)
#define PG8_LDB(dst, b, h) do { _Pragma("unroll") for (int n = 0; n < 2; ++n) _Pragma("unroll") for (int k = 0; k < 2; ++k) dst[n][k] = *(const PG8_LAS bf16x8*)(lds + PG8_SB(b, h) + boff + n * 2048 + k * 1024); } while (0)
#define PG8_MMA(ai, bj, At, Bt) do { __builtin_amdgcn_s_setprio(1); _Pragma("unroll") for (int m = 0; m < 4; ++m) _Pragma("unroll") for (int n = 0; n < 2; ++n) _Pragma("unroll") for (int k = 0; k < 2; ++k) \
        acc[ai][bj][m][n] = __builtin_amdgcn_mfma_f32_16x16x32_bf16(Bt[n][k], At[m][k], acc[ai][bj][m][n], 0, 0, 0); __builtin_amdgcn_s_setprio(0); } while (0)
#define PG8_WAIT_V(n) asm volatile("s_waitcnt vmcnt(" #n ")" ::: "memory")
#define PG8_WAIT_L(n) asm volatile("s_waitcnt lgkmcnt(" #n ")" ::: "memory")
#define PG8_BAR __builtin_amdgcn_s_barrier()
#define PG8_SCHED __builtin_amdgcn_sched_barrier(0)
    Unit cur, nxt; int ui = 0;
    if (!S.next(0, cur)) return;
    f32x4 acc[2][2][4][2];
#pragma unroll
    for (int a = 0; a < 2; ++a)
#pragma unroll
        for (int b = 0; b < 2; ++b)
#pragma unroll
            for (int m = 0; m < 4; ++m)
#pragma unroll
                for (int n = 0; n < 2; ++n) acc[a][b][m][n] = (f32x4){0.f, 0.f, 0.f, 0.f};
    bf16x8 At[4][2], B0[2][2], B1[2][2];
    const char* cA = S.aptr(g, cur, tstep); const char* cB = S.bptr(g, cur, tstep);
    S.a_ready(cur);
    if constexpr (SP2) {
        PG8_STAGE(PG8_SB(0, 0), cB, voffB); PG8_STAGE(PG8_SB(0, 1), cB + hstep, voffB); PG8_STAGE(PG8_SA(0, 0), cA, voffA); PG8_STAGE(PG8_SA(0, 1), cA + hstep, voffA);
        if (wr == 1) PG8_BAR;
        PG8_WAIT_V(2); PG8_BAR;
        PG8_STAGE(PG8_SB(1, 0), cB + kstep, voffB); PG8_STAGE(PG8_SA(1, 0), cA + kstep, voffA); PG8_STAGE(PG8_SB(1, 1), cB + hstep + kstep, voffB);
        PG8_WAIT_V(6); PG8_BAR;
    } else {
        PG8_STAGE(PG8_SB(0, 0), cB, voffB); PG8_STAGE(PG8_SA(0, 0), cA, voffA); PG8_STAGE(PG8_SB(0, 1), cB + hstep, voffB); PG8_STAGE(PG8_SA(0, 1), cA + hstep, voffA);
        if (wr == 1) PG8_BAR;
        PG8_WAIT_V(4); PG8_BAR;
        PG8_STAGE(PG8_SB(1, 0), cB + kstep, voffB); PG8_STAGE(PG8_SA(1, 0), cA + kstep, voffA); PG8_STAGE(PG8_SB(1, 1), cB + hstep + kstep, voffB);
        PG8_WAIT_V(6); PG8_BAR;
    }
    for (;;) {
        const bool has_next = S.next(ui + 1, nxt);
        const char* nA = has_next ? S.aptr(g, nxt, tstep) : cA; const char* nB = has_next ? S.bptr(g, nxt, tstep) : cB;
        for (int t = 0; t < nt; t += 2) {
            const bool last = (t == nt - 2);
            const char* a1 = cA + (size_t)(t + 1) * kstep;
            const char* a2 = last ? nA : cA + (size_t)(t + 2) * kstep; const char* b2 = last ? nB : cB + (size_t)(t + 2) * kstep;
            const char* a3 = a2 + kstep; const char* b3 = b2 + kstep;
            if (last && has_next) S.a_ready(nxt);
            if constexpr (SP2) {
            PG8_LDB(B0, 0, 0); PG8_LDB(B1, 0, 1); PG8_SCHED; PG8_LDA(At, 0, 0); PG8_STAGE(PG8_SA(1, 1), a1 + hstep, voffA);
            PG8_WAIT_V(8); PG8_WAIT_L(0); PG8_BAR; PG8_MMA(0, 0, At, B0); PG8_MMA(0, 1, At, B1); PG8_BAR; PG8_SCHED;
            PG8_LDA(At, 0, 1); PG8_STAGE(PG8_SB(0, 0), b2, voffB); PG8_STAGE(PG8_SB(0, 1), b2 + hstep, voffB); PG8_STAGE(PG8_SA(0, 0), a2, voffA);
            PG8_WAIT_V(8); PG8_WAIT_L(0); PG8_BAR; PG8_MMA(1, 0, At, B0); PG8_MMA(1, 1, At, B1); PG8_BAR; PG8_SCHED;
            PG8_LDB(B0, 1, 0); PG8_LDB(B1, 1, 1); PG8_SCHED; PG8_LDA(At, 1, 0); PG8_STAGE(PG8_SA(0, 1), a2 + hstep, voffA);
            PG8_WAIT_V(8); PG8_WAIT_L(0); PG8_BAR; PG8_MMA(0, 0, At, B0); PG8_MMA(0, 1, At, B1); PG8_BAR; PG8_SCHED;
            PG8_LDA(At, 1, 1); PG8_STAGE(PG8_SB(1, 0), b3, voffB); PG8_STAGE(PG8_SB(1, 1), b3 + hstep, voffB); PG8_STAGE(PG8_SA(1, 0), a3, voffA);
            PG8_WAIT_V(8); PG8_WAIT_L(0); PG8_BAR; PG8_MMA(1, 0, At, B0); PG8_MMA(1, 1, At, B1); PG8_BAR; PG8_SCHED;
            } else {
            PG8_LDB(B0, 0, 0); PG8_SCHED; PG8_LDA(At, 0, 0); PG8_STAGE(PG8_SA(1, 1), a1 + hstep, voffA);
            PG8_WAIT_L(8); PG8_BAR; PG8_WAIT_L(0); PG8_MMA(0, 0, At, B0); PG8_BAR; PG8_SCHED;
            PG8_LDB(B1, 0, 1); PG8_STAGE(PG8_SB(0, 0), b2, voffB);
            PG8_BAR; PG8_WAIT_L(0); PG8_MMA(0, 1, At, B1); PG8_BAR;
            PG8_LDA(At, 0, 1); PG8_STAGE(PG8_SA(0, 0), a2, voffA);
            PG8_BAR; PG8_WAIT_L(0); PG8_MMA(1, 0, At, B0); PG8_BAR; PG8_SCHED;
            PG8_STAGE(PG8_SB(0, 1), b2 + hstep, voffB);
            PG8_WAIT_V(6); PG8_BAR; PG8_MMA(1, 1, At, B1); PG8_BAR;
            PG8_LDB(B0, 1, 0); PG8_SCHED; PG8_LDA(At, 1, 0); PG8_STAGE(PG8_SA(0, 1), a2 + hstep, voffA);
            PG8_WAIT_L(8); PG8_BAR; PG8_WAIT_L(0); PG8_MMA(0, 0, At, B0); PG8_BAR; PG8_SCHED;
            PG8_LDB(B1, 1, 1); PG8_STAGE(PG8_SB(1, 0), b3, voffB);
            PG8_BAR; PG8_WAIT_L(0); PG8_MMA(0, 1, At, B1); PG8_BAR;
            PG8_LDA(At, 1, 1); PG8_STAGE(PG8_SA(1, 0), a3, voffA);
            PG8_BAR; PG8_WAIT_L(0); PG8_MMA(1, 0, At, B0); PG8_BAR; PG8_SCHED;
            PG8_STAGE(PG8_SB(1, 1), b3 + hstep, voffB);
            PG8_WAIT_V(6); PG8_BAR; PG8_MMA(1, 1, At, B1); PG8_BAR;
            }
        }
        if constexpr (ALIGN_EPI) { if (wr == 0) PG8_BAR; }
        if constexpr (!Epi::AFTER_DRAIN) { E(acc, cur, wr, wc, fr, fq); S.done(cur); }
        if (!has_next) break;
#pragma unroll
        for (int a = 0; a < 2; ++a)
#pragma unroll
            for (int b = 0; b < 2; ++b)
#pragma unroll
                for (int m = 0; m < 4; ++m)
#pragma unroll
                    for (int n = 0; n < 2; ++n) acc[a][b][m][n] = (f32x4){0.f, 0.f, 0.f, 0.f};
        cur = nxt; cA = nA; cB = nB; ++ui;
        if constexpr (ALIGN_EPI) { if (wr == 1) PG8_BAR; }
    }
    PG8_WAIT_V(0);
    if constexpr (!ALIGN_EPI) { if (wr == 0) PG8_BAR; }
    PG8_BAR;
    if constexpr (Epi::AFTER_DRAIN) { E.fused(acc, cur, wr, wc, fr, fq, lds, wid, lane); S.done(cur); }
#undef PG8_SA
#undef PG8_SB
#undef PG8_STAGE
#undef PG8_LDA
#undef PG8_LDB
#undef PG8_MMA
#undef PG8_WAIT_V
#undef PG8_WAIT_L
#undef PG8_BAR
#undef PG8_SCHED
}
}

constexpr int NWAVES = 8;
constexpr int BATCH = 4, SEQ = 8192, DM = 1024, NTOK = BATCH * SEQ;
constexpr int NPH = 18;
constexpr float LN_EPS = 1e-5f;
constexpr float ALPHA = 1.4142135623730951f;
constexpr float QSCALE = 0.125f;
constexpr int MAXPAN = 152, MAXROWS = MAXPAN * 256;
constexpr size_t MiB = 1u << 20;
constexpr size_t WS_CTL = 0, CTL_ZERO_BYTES = 1 * MiB;
constexpr size_t WS_POSB = 1 * MiB, WS_KC = 1 * MiB + 4096, WS_VC = WS_KC + 524288, WS_KMEAN = WS_VC + 524288;
constexpr size_t WS_COS = 4 * MiB, WS_SIN = 8 * MiB;
constexpr size_t WS_TOKI = 12 * MiB, WS_ROWMAP = WS_TOKI + 524288, WS_WROW = WS_ROWMAP + 262144;
constexpr size_t WS_WIN0 = 14 * MiB, WS_WOUT0 = 20 * MiB, WS_WIN1 = 22 * MiB, WS_WOUT1 = 28 * MiB, WS_W1E = 30 * MiB, WS_B2 = 62 * MiB;
constexpr size_t WS_ABF = 110 * MiB, WS_O = 174 * MiB, WS_QKV = 238 * MiB, WS_END = 430 * MiB;
constexpr size_t WS_GATES = WS_QKV + 176 * MiB;
constexpr size_t WS_XS = WS_QKV, WS_H = WS_QKV + 80 * MiB;
static_assert(WS_WROW + (size_t)MAXROWS * 8 <= WS_WIN0 && WS_KMEAN + 262144 <= WS_COS && (size_t)MAXROWS * 2048 <= 80 * MiB && (size_t)MAXROWS * 1024 <= 96 * MiB, "ws map");
constexpr int CW_BAR = 4096;
constexpr int CW_CNT = 16384;
constexpr int RING_BYTES = 131072;
constexpr int LDSCTL_OFF = RING_BYTES, MISC_OFF = LDSCTL_OFF + 320;
constexpr int PTAB_OFF = LDSCTL_OFF + 1024;
constexpr int LDS_BYTES = 147456;

#define GAS __attribute__((address_space(1)))
#define LAS __attribute__((address_space(3)))
typedef unsigned short bf16;
typedef unsigned v4u __attribute__((ext_vector_type(4)));
typedef unsigned v2u __attribute__((ext_vector_type(2)));
typedef float f32x4 __attribute__((ext_vector_type(4)));
typedef GAS unsigned gu32;
#define RLX_AGENT __ATOMIC_RELAXED, __HIP_MEMORY_SCOPE_AGENT
#define LDS_WAIT() asm volatile("s_waitcnt lgkmcnt(0)" ::: "memory")
__device__ __forceinline__ unsigned f2bf(float f) { unsigned u = __builtin_bit_cast(unsigned, f); return (u + 0x7fffu + ((u >> 16) & 1u)) >> 16; }
__device__ __forceinline__ unsigned pk2(float lo, float hi) { return f2bf(lo) | (f2bf(hi) << 16); }
__device__ __forceinline__ float bflo(unsigned u) { return __builtin_bit_cast(float, u << 16); }
__device__ __forceinline__ float bfhi(unsigned u) { return __builtin_bit_cast(float, u & 0xffff0000u); }
__device__ __forceinline__ float bf2f(bf16 h) { return __builtin_bit_cast(float, (unsigned)h << 16); }

#define XB_TMO      128
#define XB_XCNT(j)  (256  + 64 * (j))
#define XB_XSUB(j)  (1280 + 64 * (j))
#define XB_XGEN(j)  (2304 + 64 * (j))
#define XB_TOP      3328
#define XB_TOPGEN   3392
#define XCD_BAR_WORDS 3456
#define XB_SPIN_CAP (1u << 24)
__device__ __forceinline__ unsigned xb_ld(unsigned* p)              { return __hip_atomic_load(p, __ATOMIC_RELAXED, __HIP_MEMORY_SCOPE_AGENT); }
__device__ __forceinline__ unsigned xb_add(unsigned* p, unsigned v) { return __hip_atomic_fetch_add(p, v, __ATOMIC_RELAXED, __HIP_MEMORY_SCOPE_AGENT); }
__device__ __forceinline__ unsigned xb_xcc_id() { return (unsigned)__builtin_amdgcn_s_getreg((3 << 11) | 20) & 0xFu; }
#define XB_SPIN(cond, bar) do { unsigned _sp = 0; while (cond) { __builtin_amdgcn_s_sleep(1); \
    if ((++_sp & 255u) == 0u) { if (xb_ld(&(bar)[XB_TMO])) break; if (_sp > XB_SPIN_CAP) { atomicAdd(&(bar)[XB_TMO], 1u); break; } } } } while (0)
struct XcdBarrier { unsigned* bar; unsigned x; volatile LAS unsigned* st; };
__device__ __forceinline__ XcdBarrier xcd_barrier_post(unsigned* bar, volatile LAS unsigned* st) {
    XcdBarrier b; b.bar = bar; b.x = xb_xcc_id(); b.st = st;
    if (threadIdx.x == 0) (void)xb_add(&bar[XB_XCNT(b.x)], 1u);
    return b;
}
__device__ __forceinline__ void xcd_barrier_complete(unsigned* bar, unsigned x, unsigned& nloc, unsigned& nx) {
    const unsigned G = gridDim.x * gridDim.y * gridDim.z;
    unsigned sum, cnt, mine, sp = 0u;
    for (;;) {
        sum = 0u; cnt = 0u; mine = 0u;
#pragma unroll
        for (unsigned j = 0; j < 16; ++j) { const unsigned c = xb_ld(&bar[XB_XCNT(j)]); sum += c; cnt += (c > 0u) ? 1u : 0u; mine = (j == x) ? c : mine; }
        if (sum == G) break;
        __builtin_amdgcn_s_sleep(1);
        if ((++sp & 255u) == 0u) { if (xb_ld(&bar[XB_TMO])) break; if (sp > XB_SPIN_CAP) { atomicAdd(&bar[XB_TMO], 1u); break; } }
    }
    nloc = mine > 0u ? mine : 1u; nx = cnt > 0u ? cnt : 1u;
}
__device__ __forceinline__ void xcd_barrier(const XcdBarrier& b) {
    asm volatile("s_waitcnt vmcnt(0)" ::: "memory");
    __syncthreads();
    if (threadIdx.x == 0) {
        unsigned* bar = b.bar;
        __builtin_amdgcn_s_waitcnt(0);
        unsigned nloc = b.st[0], nx = b.st[1];
        if (nloc == 0u) { xcd_barrier_complete(bar, b.x, nloc, nx); b.st[0] = nloc; b.st[1] = nx; }
        const unsigned old = xb_add(&bar[XB_XSUB(b.x)], 1u);
        const unsigned gen = old / nloc;
        if (old + 1u == (gen + 1u) * nloc) {
            __builtin_amdgcn_fence(__ATOMIC_RELEASE, "agent");
            asm volatile("s_waitcnt vmcnt(0)" ::: "memory");
            const unsigned og = xb_add(&bar[XB_TOP], 1u);
            const unsigned tg = og / nx;
            if (og + 1u == (tg + 1u) * nx) xb_add(&bar[XB_TOPGEN], 1u);
            else XB_SPIN(xb_ld(&bar[XB_TOPGEN]) == tg, bar);
            __builtin_amdgcn_fence(__ATOMIC_ACQUIRE, "agent");
            xb_add(&bar[XB_XGEN(b.x)], 1u);
            asm volatile("s_waitcnt vmcnt(0)" ::: "memory");
        } else {
            XB_SPIN(xb_ld(&bar[XB_XGEN(b.x)]) == gen, bar);
            __builtin_amdgcn_fence(__ATOMIC_ACQUIRE, "agent");
            asm volatile("s_waitcnt vmcnt(0)" ::: "memory");
        }
    }
    __syncthreads();
}

struct Args { const float* in[23]; float* out; unsigned char* ws; int ph_lo, ph_hi, use_bar, pad; };
struct Frame {
    LAS unsigned char* lds;
    unsigned char* ws;
    int tid, lane, wave, vcu, G;
};
__device__ __forceinline__ float wave_sum(float v) {
#pragma unroll
    for (int o = 1; o < 64; o <<= 1) v += __shfl_xor(v, o);
    return v;
}

template <class Map>
__device__ __forceinline__ void tr_item(const float* W, int N, int kb, int nb, bf16* WT, int ldt, int koff, LAS float* scr, int lane, Map map) {
    const int k0 = 64 * kb, n0 = 32 * nb;
#pragma unroll 8
    for (int i = 0; i < 32; ++i) { const int kk = 2 * i + (lane >> 5), n = n0 + (lane & 31); scr[kk * 33 + (lane & 31)] = (n < N) ? W[(size_t)(k0 + kk) * N + n] : 0.f; }
    LDS_WAIT(); asm volatile("" ::: "memory");
    const int c = lane & 7;
#pragma unroll
    for (int j = 0; j < 4; ++j) { const int nl = (lane >> 3) + 8 * j, n = n0 + nl; const LAS float* s = scr + (8 * c) * 33 + nl;
        if (n < N) { const int row = map(n);
            if (row >= 0) { v4u o; o.x = pk2(s[0 * 33], s[1 * 33]); o.y = pk2(s[2 * 33], s[3 * 33]); o.z = pk2(s[4 * 33], s[5 * 33]); o.w = pk2(s[6 * 33], s[7 * 33]);
                *(v4u*)(WT + (size_t)row * ldt + koff + k0 + 8 * c) = o; } } }
    LDS_WAIT(); asm volatile("" ::: "memory");
}
__device__ __forceinline__ int rope_perm(int d) { return d < 32 ? 2 * d : 2 * (d - 32) + 1; }
struct MapIdent { __device__ __forceinline__ int operator()(int n) const { return n; } };
struct MapGU { int up; __device__ __forceinline__ int operator()(int n) const { return (n >> 2) * 8 + up * 4 + (n & 3); } };
struct MapIn0 {
    __device__ __forceinline__ int operator()(int n) const {
        int hs, d; bool rope;
        if (n < 512) { hs = n >> 6; d = n & 63; rope = true; }
        else if (n < 1280) { const int seg = (n - 512) >> 7, w = (n - 512) & 127;
            rope = (seg & 1) == 0; hs = (rope ? 8 : 14) + (seg >> 1) * 2 + (w >> 6); d = w & 63; }
        else if (n < 1304) { return 44 * 64 + (n - 1280); }
        else { const int m = n - 1304, t = m >> 9; hs = 20 + t * 8 + ((m & 511) >> 6); d = m & 63; rope = t < 2; }
        return hs * 64 + (rope ? rope_perm(d) : d);
    }
};
__device__ __forceinline__ void bucket_pair(int pi, int& lo, int& hi) { lo = pi < 3 ? 0 : (pi < 5 ? 1 : 2); hi = pi < 3 ? pi + 1 : (pi < 5 ? pi - 1 : 3); }

__device__ __forceinline__ void p0_prologue(Frame& F, const Args& A) {
    LAS float* scr = (LAS float*)(F.lds + F.wave * 16384);
    const int gw = F.vcu * NWAVES + F.wave, NGW = F.G * NWAVES;
    bf16* WIN0 = (bf16*)(F.ws + WS_WIN0); bf16* WOUT0 = (bf16*)(F.ws + WS_WOUT0); bf16* WIN1 = (bf16*)(F.ws + WS_WIN1); bf16* WOUT1 = (bf16*)(F.ws + WS_WOUT1);
    bf16* W1E = (bf16*)(F.ws + WS_W1E); bf16* B2 = (bf16*)(F.ws + WS_B2);
    constexpr int I_A = 16 * 89, I_B = 16 * 32, I_C = 16 * 96, I_D = 16 * 32, I_E = 64 * 128, I_F = 96 * 128;
    constexpr int NITEMS = I_A + I_B + I_C + I_D + I_E + I_F;
    for (int it = gw; it < NITEMS; it += NGW) {
        int r = it;
        if (r < I_A) { tr_item(A.in[2], 2840, r / 89, r % 89, WIN0, 1024, 0, scr, F.lane, MapIn0()); continue; } r -= I_A;
        if (r < I_B) { tr_item(A.in[3], 1024, r / 32, r % 32, WOUT0, 1024, 0, scr, F.lane, MapIdent()); continue; } r -= I_B;
        if (r < I_C) { tr_item(A.in[10], 3072, r / 96, r % 96, WIN1, 1024, 0, scr, F.lane, MapIdent()); continue; } r -= I_C;
        if (r < I_D) { tr_item(A.in[11], 1024, r / 32, r % 32, WOUT1, 1024, 0, scr, F.lane, MapIdent()); continue; } r -= I_D;
        if (r < I_E) { const int job = r >> 7, sub = r & 127, le = job >> 1, up = job & 1;
            const float* src = (up ? A.in[21] : A.in[20]) + (size_t)le * 1024 * 256; MapGU mp; mp.up = up;
            tr_item(src, 256, sub >> 3, sub & 7, W1E + (size_t)le * 512 * 1024, 1024, 0, scr, F.lane, mp); continue; } r -= I_E;
        { const int job = r >> 7, sub = r & 127, slot = job & 1, lb = job >> 1, layer = lb / 24, bkt = lb % 24, g = bkt / 6; int lo, hi; bucket_pair(bkt % 6, lo, hi);
            const int e = g * 4 + (slot ? hi : lo);
            tr_item(A.in[22] + (size_t)(layer * 16 + e) * 256 * 1024, 1024, sub >> 5, sub & 31, B2 + (size_t)lb * 1024 * 512, 512, slot * 256, scr, F.lane, MapIdent()); }
    }
    { const float* x = A.in[0]; bf16* xb = (bf16*)(F.ws + WS_ABF);
      for (size_t i = (size_t)(F.vcu * 512 + F.tid); i < (size_t)NTOK * DM / 8; i += (size_t)F.G * 512) {
          const f32x4 a = *(const f32x4*)(x + i * 8), b = *(const f32x4*)(x + i * 8 + 4);
          v4u o; o.x = pk2(a[0], a[1]); o.y = pk2(a[2], a[3]); o.z = pk2(b[0], b[1]); o.w = pk2(b[2], b[3]); *(v4u*)(xb + i * 8) = o; } }
    { const int* pos = (const int*)A.in[1]; float* cosT = (float*)(F.ws + WS_COS); float* sinT = (float*)(F.ws + WS_SIN);
      for (int i = F.vcu * 512 + F.tid; i < NTOK * 32; i += F.G * 512) { const int tok = i >> 5, k = i & 31;
          const float inv = powf(10000.0f, -(float)k / 32.0f), ang = (float)pos[tok] * inv; cosT[i] = cosf(ang); sinT[i] = sinf(ang); } }
    if (F.vcu == 0 && F.tid < 256) { const int sel = F.tid >> 7, j = F.tid & 127; const float* pe = A.in[4 + sel]; const float* w1 = A.in[sel ? 8 : 6]; float s = 0.f;
        for (int i = 0; i < 2048; ++i) s = fmaf(pe[i], w1[(size_t)i * 128 + j], s);
        ((float*)(F.ws + WS_POSB))[sel * 128 + j] = s; }
}

__device__ __forceinline__ float gelu_tanh(float x) { const float u = 0.7978845608028654f * (x + 0.044715f * x * x * x); return 0.5f * x * (1.0f + tanhf(u)); }
__device__ __forceinline__ void p2_compress(Frame& F, const Args& A) {
    LAS float* At = (LAS float*)F.lds;
    LAS float* part = (LAS float*)(F.lds + 36864);
    LAS float* hid = (LAS float*)(F.lds + 53248);
    const bf16* qkv = (const bf16*)(F.ws + WS_QKV);
    const float* posb = (const float*)(F.ws + WS_POSB);
    for (int item = F.vcu; item < 1024; item += F.G) {
        const int sel = item >> 9, b = (item >> 7) & 3, kv = (item >> 6) & 1, n0 = (item & 63) * 8;
        const bf16* src = qkv + (sel ? pg8::E_VCMP : pg8::E_KCMP) + (size_t)(b * 2 + kv) * SEQ * 64;
        const float* w1 = A.in[sel ? 8 : 6]; const float* w2 = A.in[sel ? 9 : 7];
        for (int idx = F.tid; idx < 144 * 64; idx += 512) { const int tl = idx >> 6, d = idx & 63, tok = 16 * n0 + tl;
            At[idx] = tok < SEQ ? bf2f(src[(size_t)tok * 64 + (sel ? d : rope_perm(d))]) : 0.f; }
        __syncthreads();
        { const int j = F.tid & 127, ks = F.tid >> 7; float acc[8];
#pragma unroll
          for (int r = 0; r < 8; ++r) acc[r] = 0.f;
          for (int l = ks * 8; l < ks * 8 + 8; ++l)
              for (int d = 0; d < 64; ++d) { const float w = w1[(size_t)(l * 64 + d) * 128 + j];
#pragma unroll
                  for (int r = 0; r < 8; ++r) acc[r] = fmaf(At[(16 * r + l) * 64 + d], w, acc[r]); }
#pragma unroll
          for (int r = 0; r < 8; ++r) part[(ks * 8 + r) * 128 + j] = acc[r]; }
        __syncthreads();
        for (int idx = F.tid; idx < 1024; idx += 512) { const int j = idx & 127;
            const float x = part[idx] + part[1024 + idx] + part[2048 + idx] + part[3072 + idx] + posb[sel * 128 + j]; hid[idx] = gelu_tanh(x); }
        __syncthreads();
        { const int r = F.tid >> 6, c = F.tid & 63; float y = 0.f;
          for (int j = 0; j < 128; ++j) y = fmaf(hid[r * 128 + j], w2[j * 64 + c], y);
          bf16* dst = (bf16*)(F.ws + (sel ? WS_VC : WS_KC)); dst[((size_t)(b * 2 + kv) * 512 + n0 + r) * 64 + (sel ? c : rope_perm(c))] = (bf16)f2bf(y); }
        __syncthreads();
    }
    { const bf16* km = qkv + pg8::E_KM; float* kmean = (float*)(F.ws + WS_KMEAN);
      for (int it = F.vcu * NWAVES + F.wave; it < 1024; it += F.G * NWAVES) { const int bh = it >> 5, blk = it & 31; float s = 0.f;
          const bf16* p = km + ((size_t)bh * SEQ + blk * 256) * 64 + F.lane;
          for (int i = 0; i < 256; ++i) s += bf2f(p[(size_t)i * 64]);
          kmean[(size_t)it * 64 + F.lane] = s * (1.0f / 256.0f); } }
}

__device__ __forceinline__ void ldrow(const bf16* p, unsigned (&r)[32]) {
#pragma unroll
    for (int i = 0; i < 8; ++i) { const v4u t = *(const v4u*)(p + 8 * i); r[4 * i] = t.x; r[4 * i + 1] = t.y; r[4 * i + 2] = t.z; r[4 * i + 3] = t.w; }
}
__device__ __forceinline__ float dot64(const unsigned (&q)[32], const unsigned (&k)[32]) {
    float s0 = 0.f, s1 = 0.f;
#pragma unroll
    for (int i = 0; i < 32; ++i) { s0 = fmaf(bflo(q[i]), bflo(k[i]), s0); s1 = fmaf(bfhi(q[i]), bfhi(k[i]), s1); }
    return s0 + s1;
}
__device__ __forceinline__ void osm_step(bool ok, float s, float& m, float& l, float (&o)[64], const unsigned (&v)[32]) {
    if (ok) {
        if (s > m) { const float f = __expf(m - s); l *= f;
#pragma unroll
            for (int i = 0; i < 64; ++i) o[i] *= f;
            m = s; }
        const float p = __expf(s - m); l += p;
#pragma unroll
        for (int i = 0; i < 32; ++i) { o[2 * i] = fmaf(p, bflo(v[i]), o[2 * i]); o[2 * i + 1] = fmaf(p, bfhi(v[i]), o[2 * i + 1]); }
    }
}

__device__ __forceinline__ void p3_nsa_naive(Frame& F, const Args& A) {
    LAS float* imp = (LAS float*)F.lds;
    const bf16* qkv = (const bf16*)(F.ws + WS_QKV);
    const float* gates = (const float*)(F.ws + WS_GATES);
    bf16* O = (bf16*)(F.ws + WS_O);
    const bf16* KC = (const bf16*)(F.ws + WS_KC); const bf16* VC = (const bf16*)(F.ws + WS_VC);
    for (int item = F.vcu; item < 512; item += F.G) {
        const int b = item >> 7, kv = (item >> 6) & 1, qt = item & 63;
        const int ql = F.tid >> 2, g = F.tid & 3, t = qt * 128 + ql, h = kv * 4 + g, tok = b * SEQ + t;
        unsigned q[32]; ldrow(qkv + pg8::E_QA + ((size_t)(b * 8 + h) * SEQ + t) * 64, q);
        float o[64]; float* otp = (float*)(F.ws + WS_ABF) + (size_t)tok * 512 + h * 64;
        for (int i = F.tid; i < 128 * 129; i += 512) imp[i] = 0.f;
        __syncthreads();
        const float g0 = gates[(size_t)tok * 24 + h * 3 + 0], g1 = gates[(size_t)tok * 24 + h * 3 + 1], g2 = gates[(size_t)tok * 24 + h * 3 + 2];
        const int nvis = t >= 31 ? min((t - 31) / 16 + 1, 511) : 0;
        const int nbound = min((qt * 128 + 127 - 31) / 16 + 1, 511);
        const bf16* kcp = KC + (size_t)(b * 2 + kv) * 512 * 64; const bf16* vcp = VC + (size_t)(b * 2 + kv) * 512 * 64;
        float m = -1e30f, l = 0.f;
#pragma unroll
        for (int i = 0; i < 64; ++i) o[i] = 0.f;
        for (int n = 0; n < nbound; ++n) { unsigned kr[32], vr[32]; ldrow(kcp + (size_t)n * 64, kr); ldrow(vcp + (size_t)n * 64, vr);
            const float s = dot64(q, kr) * QSCALE; osm_step(n < nvis, s, m, l, o, vr); }
        float linv = 1.0f / fmaxf(l, 1e-30f);
#pragma unroll
        for (int i = 0; i < 16; ++i) { f32x4 w; w[0] = g0 * linv * o[4 * i]; w[1] = g0 * linv * o[4 * i + 1]; w[2] = g0 * linv * o[4 * i + 2]; w[3] = g0 * linv * o[4 * i + 3]; *(f32x4*)(otp + 4 * i) = w; }
        { float acc = 0.f;
          for (int n = 0; n < nbound; ++n) { unsigned kr[32]; ldrow(kcp + (size_t)n * 64, kr);
              const float s = dot64(q, kr) * QSCALE; float p = (n < nvis) ? __expf(s - m) * linv : 0.f;
              p += __shfl_xor(p, 1); p += __shfl_xor(p, 2); acc += p;
              if ((n & 3) == 3) { if (g == 0) imp[ql * 129 + (n >> 2)] = acc; acc = p; } } }
        __syncthreads();
        const int cur = t >> 6; unsigned m0 = 0u, m1 = 0u, m2 = 0u, m3 = 0u;
#define SETBIT(j) do { const unsigned _b = 1u << ((j) & 31); const int _w = (j) >> 5; m0 |= _w == 0 ? _b : 0u; m1 |= _w == 1 ? _b : 0u; m2 |= _w == 2 ? _b : 0u; m3 |= _w == 3 ? _b : 0u; } while (0)
        if (cur < 16) { m0 = (1u << (cur + 1)) - 1u; }
        else { SETBIT(0); SETBIT(cur - 1); SETBIT(cur);
            for (int r = 0; r < 13; ++r) { float best = -0.5f; int bj = 1;
                for (int j = 1; j <= cur - 2; ++j) { const float v = imp[ql * 129 + j]; if (v > best) { best = v; bj = j; } }
                imp[ql * 129 + bj] = -1.0f; SETBIT(bj); } }
        m = -1e30f; l = 0.f;
#pragma unroll
        for (int i = 0; i < 64; ++i) o[i] = 0.f;
        { const bf16* kb = qkv + pg8::E_KSLC + (size_t)(b * 2 + kv) * SEQ * 64; const bf16* vb = qkv + pg8::E_VSLC + (size_t)(b * 2 + kv) * SEQ * 64;
          for (int it = 0; it < 16; ++it) {
              const bool have = (m0 | m1 | m2 | m3) != 0u; int j = 0;
              if (m0) { j = __builtin_ctz(m0); m0 &= m0 - 1u; } else if (m1) { j = 32 + __builtin_ctz(m1); m1 &= m1 - 1u; }
              else if (m2) { j = 64 + __builtin_ctz(m2); m2 &= m2 - 1u; } else if (m3) { j = 96 + __builtin_ctz(m3); m3 &= m3 - 1u; }
              for (int kk = 0; kk < 64; ++kk) { const int row = j * 64 + kk; unsigned kr[32], vr[32]; ldrow(kb + (size_t)row * 64, kr); ldrow(vb + (size_t)row * 64, vr);
                  const float s = dot64(q, kr) * QSCALE; osm_step(have && row <= t, s, m, l, o, vr); } } }
        linv = 1.0f / fmaxf(l, 1e-30f);
#pragma unroll
        for (int i = 0; i < 16; ++i) { f32x4 w = *(const f32x4*)(otp + 4 * i); w[0] = fmaf(g1 * linv, o[4 * i], w[0]); w[1] = fmaf(g1 * linv, o[4 * i + 1], w[1]); w[2] = fmaf(g1 * linv, o[4 * i + 2], w[2]); w[3] = fmaf(g1 * linv, o[4 * i + 3], w[3]); *(f32x4*)(otp + 4 * i) = w; }
        m = -1e30f; l = 0.f;
#pragma unroll
        for (int i = 0; i < 64; ++i) o[i] = 0.f;
        { const bf16* kb = qkv + pg8::E_KWIN + (size_t)(b * 2 + kv) * SEQ * 64; const bf16* vb = qkv + pg8::E_VWIN + (size_t)(b * 2 + kv) * SEQ * 64;
          const int shi = qt * 128 + 127, slo = max(qt * 128 - 511, 0);
          for (int s_ = shi; s_ >= slo; --s_) { unsigned kr[32], vr[32]; ldrow(kb + (size_t)s_ * 64, kr); ldrow(vb + (size_t)s_ * 64, vr);
              const float s = dot64(q, kr) * QSCALE; osm_step(s_ <= t && s_ > t - 512, s, m, l, o, vr); } }
        linv = 1.0f / fmaxf(l, 1e-30f);
        { bf16* op = O + (size_t)tok * 1024 + h * 64;
#pragma unroll
          for (int i = 0; i < 8; ++i) { const f32x4 a0 = *(const f32x4*)(otp + 8 * i), a1 = *(const f32x4*)(otp + 8 * i + 4); const float gl = g2 * linv; v4u w;
              w.x = pk2(fmaf(gl, o[8 * i], a0[0]), fmaf(gl, o[8 * i + 1], a0[1])); w.y = pk2(fmaf(gl, o[8 * i + 2], a0[2]), fmaf(gl, o[8 * i + 3], a0[3]));
              w.z = pk2(fmaf(gl, o[8 * i + 4], a1[0]), fmaf(gl, o[8 * i + 5], a1[1])); w.w = pk2(fmaf(gl, o[8 * i + 6], a1[2]), fmaf(gl, o[8 * i + 7], a1[3])); *(v4u*)(op + 8 * i) = w; } }
        __syncthreads();
    }
}

__device__ __forceinline__ void p3_moba_naive(Frame& F, const Args& A) {
    const bf16* qkv = (const bf16*)(F.ws + WS_QKV);
    const float* kmean = (const float*)(F.ws + WS_KMEAN);
    bf16* O = (bf16*)(F.ws + WS_O);
    for (int item = F.vcu; item < 512; item += F.G) {
        const int bh = item >> 4, tile = item & 15, b = bh >> 3, h = bh & 7, t = tile * 512 + F.tid, tok = b * SEQ + t, cur = t >> 8;
        unsigned q[32]; ldrow(qkv + pg8::E_QM + ((size_t)bh * SEQ + t) * 64, q);
        float v0 = -3e38f, v1 = -3e38f, v2 = -3e38f; int i0 = -1, i1 = -1, i2 = -1;
        for (int n = 0; n < cur; ++n) { const float* kmp = kmean + ((size_t)bh * 32 + n) * 64; float gs = 0.f;
#pragma unroll
            for (int i = 0; i < 32; ++i) { gs = fmaf(bflo(q[i]), kmp[2 * i], gs); gs = fmaf(bfhi(q[i]), kmp[2 * i + 1], gs); }
            if (gs > v0) { v2 = v1; i2 = i1; v1 = v0; i1 = i0; v0 = gs; i0 = n; } else if (gs > v1) { v2 = v1; i2 = i1; v1 = gs; i1 = n; } else if (gs > v2) { v2 = gs; i2 = n; } }
        float o[64], m = -1e30f, l = 0.f;
#pragma unroll
        for (int i = 0; i < 64; ++i) o[i] = 0.f;
        const bf16* kb = qkv + pg8::E_KM + (size_t)bh * SEQ * 64; const bf16* vb = qkv + pg8::E_VM + (size_t)bh * SEQ * 64;
        for (int si = 0; si < 3; ++si) { const int j = si == 0 ? i0 : (si == 1 ? i1 : i2); const bool have = j >= 0; const int jj = have ? j : 0;
            for (int kk = 0; kk < 256; ++kk) { const int row = jj * 256 + kk; unsigned kr[32], vr[32]; ldrow(kb + (size_t)row * 64, kr); ldrow(vb + (size_t)row * 64, vr);
                const float s = dot64(q, kr) * QSCALE; osm_step(have, s, m, l, o, vr); } }
        { const int r0 = (tile * 512 + (F.tid & ~63)) & ~255, r1 = tile * 512 + (F.tid | 63);
          for (int row = r0; row <= r1; ++row) { unsigned kr[32], vr[32]; ldrow(kb + (size_t)row * 64, kr); ldrow(vb + (size_t)row * 64, vr);
              const float s = dot64(q, kr) * QSCALE; osm_step(row <= t, s, m, l, o, vr); } }
        const float linv = 1.0f / fmaxf(l, 1e-30f);
        { bf16* op = O + (size_t)tok * 1024 + 512 + h * 64;
#pragma unroll
          for (int i = 0; i < 8; ++i) { v4u w; w.x = pk2(o[8 * i] * linv, o[8 * i + 1] * linv); w.y = pk2(o[8 * i + 2] * linv, o[8 * i + 3] * linv); w.z = pk2(o[8 * i + 4] * linv, o[8 * i + 5] * linv); w.w = pk2(o[8 * i + 6] * linv, o[8 * i + 7] * linv); *(v4u*)(op + 8 * i) = w; } }
    }
}

__device__ __forceinline__ void p11_sb_naive(Frame& F, const Args& A) {
    const bf16* qkv = (const bf16*)(F.ws + WS_QKV);
    bf16* O = (bf16*)(F.ws + WS_O);
    for (int item = F.vcu; item < 1024; item += F.G) {
        const int bh = item >> 4, tile = item & 15, b = bh >> 4, h = bh & 15, t = tile * 512 + F.tid, tok = b * SEQ + t;
        unsigned q[32]; ldrow(qkv + ((size_t)bh * SEQ + t) * 64, q);
        const bf16* kb = qkv + (size_t)33554432 + (size_t)bh * SEQ * 64; const bf16* vb = qkv + (size_t)67108864 + (size_t)bh * SEQ * 64;
        float o[64], C = 0.f;
#pragma unroll
        for (int i = 0; i < 64; ++i) o[i] = 0.f;
        for (int s_ = tile * 512 + (F.tid | 63) - 1; s_ >= 0; --s_) {
            if (!__any(C > -120.f)) break;
            unsigned kr[32], vr[32]; ldrow(kb + (size_t)s_ * 64, kr); ldrow(vb + (size_t)s_ * 64, vr);
            const float z = dot64(q, kr) * QSCALE, sp = fmaxf(z, 0.f) + __logf(1.0f + __expf(-fabsf(z)));
            if (s_ < t && C > -120.f) { const float w = __expf(z - sp + C); C -= sp;
#pragma unroll
                for (int i = 0; i < 32; ++i) { o[2 * i] = fmaf(w, bflo(vr[i]), o[2 * i]); o[2 * i + 1] = fmaf(w, bfhi(vr[i]), o[2 * i + 1]); } } }
        { bf16* op = O + (size_t)tok * 1024 + h * 64;
#pragma unroll
          for (int i = 0; i < 8; ++i) { v4u w; w.x = pk2(o[8 * i], o[8 * i + 1]); w.y = pk2(o[8 * i + 2], o[8 * i + 3]); w.z = pk2(o[8 * i + 4], o[8 * i + 5]); w.w = pk2(o[8 * i + 6], o[8 * i + 7]); *(v4u*)(op + 8 * i) = w; } }
    }
}

template <bool ROUTE, bool WBF>
__device__ __forceinline__ void ln_phase(Frame& F, const Args& A, int layer, const float* gain, const float* bias, float* R, bf16* obf) {
    const int gw = F.vcu * NWAVES + F.wave, NGW = F.G * NWAVES;
    LAS float* WR = (LAS float*)F.lds;
    if (ROUTE) {
        const float* wg = A.in[16] + (size_t)layer * 1024 * 4; const float* wrt = A.in[18] + (size_t)layer * 4 * 1024 * 4;
        for (int i = F.tid; i < 20 * 1024; i += 512) { const int c = i >> 10, k = i & 1023; WR[i] = c < 4 ? wg[k * 4 + c] : wrt[(size_t)((c - 4) >> 2) * 4096 + k * 4 + ((c - 4) & 3)]; }
        int* rowmap = (int*)(F.ws + WS_ROWMAP);
        for (int i = F.vcu * 512 + F.tid; i < MAXROWS; i += F.G * 512) rowmap[i] = -1;
        __syncthreads();
    }
    f32x4 gn[4], bs[4];
#pragma unroll
    for (int j = 0; j < 4; ++j) { gn[j] = *(const f32x4*)(gain + 4 * F.lane + 256 * j); bs[j] = *(const f32x4*)(bias + 4 * F.lane + 256 * j); }
    for (int mrow = gw; mrow < NTOK; mrow += NGW) {
        float* xr = R + (size_t)mrow * DM + 4 * F.lane;
        f32x4 v[4]; float s = 0.f;
#pragma unroll
        for (int j = 0; j < 4; ++j) { v[j] = *(const f32x4*)(xr + 256 * j); s += (v[j][0] + v[j][1]) + (v[j][2] + v[j][3]); }
        const float mean = wave_sum(s) * (1.f / DM); float s2 = 0.f;
#pragma unroll
        for (int j = 0; j < 4; ++j) { v[j] = v[j] - mean; s2 += (v[j][0] * v[j][0] + v[j][1] * v[j][1]) + (v[j][2] * v[j][2] + v[j][3] * v[j][3]); }
        const float rstd = 1.f / sqrtf(wave_sum(s2) * (1.f / DM) + LN_EPS);
#pragma unroll
        for (int j = 0; j < 4; ++j) { v[j] = v[j] * rstd * gn[j] + bs[j]; *(f32x4*)(xr + 256 * j) = v[j]; }
        if (WBF) { bf16* orow = obf + (size_t)mrow * DM + 4 * F.lane;
#pragma unroll
            for (int j = 0; j < 4; ++j) { v2u w; w.x = pk2(v[j][0], v[j][1]); w.y = pk2(v[j][2], v[j][3]); *(v2u*)(orow + 256 * j) = w; } }
        if (ROUTE) {
            float lg[4];
#pragma unroll
            for (int c = 0; c < 4; ++c) { float p = 0.f;
#pragma unroll
                for (int j = 0; j < 4; ++j) { const f32x4 w = *(const LAS f32x4*)(WR + c * 1024 + 4 * F.lane + 256 * j); p += (v[j][0] * w[0] + v[j][1] * w[1]) + (v[j][2] * w[2] + v[j][3] * w[3]); }
                lg[c] = wave_sum(p) + A.in[17][layer * 4 + c]; }
            int g = 0; float gm = lg[0];
#pragma unroll
            for (int c = 1; c < 4; ++c) if (lg[c] > gm) { gm = lg[c]; g = c; }
            const float wgp = 1.0f / ((__expf(lg[0] - gm) + __expf(lg[1] - gm)) + (__expf(lg[2] - gm) + __expf(lg[3] - gm)));
            float le[4];
#pragma unroll
            for (int e = 0; e < 4; ++e) { float p = 0.f;
#pragma unroll
                for (int j = 0; j < 4; ++j) { const f32x4 w = *(const LAS f32x4*)(WR + (4 + g * 4 + e) * 1024 + 4 * F.lane + 256 * j); p += (v[j][0] * w[0] + v[j][1] * w[1]) + (v[j][2] * w[2] + v[j][3] * w[3]); }
                le[e] = wave_sum(p) + A.in[19][layer * 16 + g * 4 + e]; }
            int i1 = 0; float e1 = le[0];
#pragma unroll
            for (int e = 1; e < 4; ++e) if (le[e] > e1) { e1 = le[e]; i1 = e; }
            int i2 = -1; float e2 = -3e38f;
#pragma unroll
            for (int e = 0; e < 4; ++e) if (e != i1 && le[e] > e2) { e2 = le[e]; i2 = e; }
            const float w1 = 1.0f / (1.0f + __expf(e2 - e1)), w2 = 1.0f - w1;
            const int lo = min(i1, i2), hi = max(i1, i2), pi = lo == 0 ? hi - 1 : (lo == 1 ? hi + 1 : 5), bkt = g * 6 + pi;
            const float wlo = (i1 < i2 ? w1 : w2) * wgp, whi = (i1 < i2 ? w2 : w1) * wgp;
            if (F.lane == 0) { f32x4 ti; ti[0] = __builtin_bit_cast(float, bkt); ti[1] = 0.f; ti[2] = wlo; ti[3] = whi; *(f32x4*)(F.ws + WS_TOKI + (size_t)mrow * 16) = ti; }
        }
    }
}
__device__ __forceinline__ int build_ptab(Frame& F, int tok_lo) {
    LAS int* ptab = (LAS int*)(F.lds + PTAB_OFF); LAS int* pstart = (LAS int*)(F.lds + PTAB_OFF + 1024);
    LAS int* cnt = (LAS int*)(F.lds + PTAB_OFF + 1280); LAS int* lt = (LAS int*)(F.lds + PTAB_OFF + 1408);
    __syncthreads();
    if (F.tid < 24) { cnt[F.tid] = 0; lt[F.tid] = 0; }
    __syncthreads();
    for (int tk = F.tid; tk < NTOK; tk += 512) { const int bkt = *(const int*)(F.ws + WS_TOKI + (size_t)tk * 16);
        __hip_atomic_fetch_add(cnt + bkt, 1, __ATOMIC_RELAXED, __HIP_MEMORY_SCOPE_WORKGROUP); if (tk < tok_lo) __hip_atomic_fetch_add(lt + bkt, 1, __ATOMIC_RELAXED, __HIP_MEMORY_SCOPE_WORKGROUP); }
    __syncthreads();
    if (F.tid == 0) { int p = 0;
        for (int bkt = 0; bkt < 24; ++bkt) { const int np = (cnt[bkt] + 255) >> 8;
            pstart[bkt] = p; for (int i = 0; i < np && p < MAXPAN; ++i) ptab[p++] = bkt; }
        pstart[24] = p; }
    __syncthreads();
    return pstart[24];
}
__device__ __forceinline__ void scatter_phase(Frame& F, const float* R) {
    const int TPW = (NTOK + F.G - 1) / F.G, tok_lo = F.vcu * TPW;
    build_ptab(F, tok_lo);
    LAS int* pstart = (LAS int*)(F.lds + PTAB_OFF + 1024); LAS int* lt = (LAS int*)(F.lds + PTAB_OFF + 1408);
    LAS int* dstl = (LAS int*)F.lds;
    LAS int* bkl = (LAS int*)(F.lds + 4096);
    for (int i = F.tid; i < TPW && tok_lo + i < NTOK; i += 512) bkl[i] = *(const int*)(F.ws + WS_TOKI + (size_t)(tok_lo + i) * 16);
    __syncthreads();
    if (F.tid == 0) { for (int i = 0; i < TPW && tok_lo + i < NTOK; ++i) { const int bkt = bkl[i]; dstl[i] = pstart[bkt] * 256 + lt[bkt]; lt[bkt] = lt[bkt] + 1; } }
    __syncthreads();
    bf16* XS = (bf16*)(F.ws + WS_XS); int* rowmap = (int*)(F.ws + WS_ROWMAP); float* wrow = (float*)(F.ws + WS_WROW);
    for (int i = F.wave; i < TPW && tok_lo + i < NTOK; i += NWAVES) {
        const int mrow = tok_lo + i, dst = dstl[i];
        const f32x4 ti = *(const f32x4*)(F.ws + WS_TOKI + (size_t)mrow * 16);
        const float* xr = R + (size_t)mrow * DM + 4 * F.lane; bf16* orow = XS + (size_t)dst * DM + 4 * F.lane;
#pragma unroll
        for (int j = 0; j < 4; ++j) { const f32x4 v = *(const f32x4*)(xr + 256 * j); v2u w; w.x = pk2(v[0], v[1]); w.y = pk2(v[2], v[3]); *(v2u*)(orow + 256 * j) = w; }
        if (F.lane == 0) { rowmap[dst] = mrow; wrow[(size_t)dst * 2] = ti[2]; wrow[(size_t)dst * 2 + 1] = ti[3]; }
    }
    __syncthreads();
}
struct MoeOrder1 {
    int G, c, nunits; const LAS int* ptab; const bf16* W1E;
    __device__ __forceinline__ bool next(int i, pg8::Unit& u) const { const int L = i * G + c; if (L >= nunits) return false; u.pm = L >> 2; u.pn = L & 3; u.aux = __builtin_amdgcn_readfirstlane(ptab[u.pm]); return true; }
    __device__ __forceinline__ const char* aptr(const pg8::Gemm& g, const pg8::Unit& u, size_t tstep) const { return (const char*)g.A + (size_t)u.pm * tstep; }
    __device__ __forceinline__ const char* bptr(const pg8::Gemm& g, const pg8::Unit& u, size_t tstep) const {
        const int grp = u.aux / 6; int lo, hi; bucket_pair(u.aux % 6, lo, hi); const int e = grp * 4 + ((u.pn >> 1) ? hi : lo);
        return (const char*)(W1E + ((size_t)e * 512 + (size_t)(u.pn & 1) * 256) * 1024); }
    __device__ __forceinline__ void a_ready(const pg8::Unit&) const {}
    __device__ __forceinline__ void done(const pg8::Unit&) const {}
};
struct MoeOrder2 {
    int G, c, nunits; const LAS int* ptab; const bf16* B2;
    __device__ __forceinline__ bool next(int i, pg8::Unit& u) const { const int L = i * G + c; if (L >= nunits) return false; u.pm = L >> 2; u.pn = L & 3; u.aux = __builtin_amdgcn_readfirstlane(ptab[u.pm]); return true; }
    __device__ __forceinline__ const char* aptr(const pg8::Gemm& g, const pg8::Unit& u, size_t tstep) const { return (const char*)g.A + (size_t)u.pm * tstep; }
    __device__ __forceinline__ const char* bptr(const pg8::Gemm& g, const pg8::Unit& u, size_t tstep) const { return (const char*)(B2 + ((size_t)u.aux * 1024 + (size_t)u.pn * 256) * 512); }
    __device__ __forceinline__ void a_ready(const pg8::Unit&) const {}
    __device__ __forceinline__ void done(const pg8::Unit&) const {}
};

__global__ void __launch_bounds__(NWAVES * 64, 2) fwd_kernel(Args args) {
    extern __shared__ __attribute__((aligned(16))) unsigned char lds[];
    Frame F;
    F.lds = (LAS unsigned char*)lds; F.ws = args.ws;
    F.tid = threadIdx.x; F.lane = F.tid & 63; F.wave = __builtin_amdgcn_readfirstlane(F.tid >> 6);
    F.G = gridDim.x; { const int bx = blockIdx.x; F.vcu = (F.G % 8 == 0) ? (bx % 8) * (F.G / 8) + bx / 8 : bx; }
    for (int u = F.tid; u < (LDS_BYTES - LDSCTL_OFF) / 4; u += NWAVES * 64) ((LAS unsigned*)(F.lds + LDSCTL_OFF))[u] = 0u;
    __syncthreads();
    volatile LAS unsigned* MISC = (volatile LAS unsigned*)(F.lds + MISC_OFF);
    unsigned* ctl = (unsigned*)(args.ws + WS_CTL);
    XcdBarrier bar; bar.bar = ctl + CW_BAR; bar.x = 0; bar.st = nullptr;
    if (args.use_bar) bar = xcd_barrier_post(ctl + CW_BAR, MISC + 8);
    const int lo = args.ph_lo, hi = args.ph_hi;
#ifdef ONLYPH
#define IN(k) ((k) == ONLYPH && lo <= (k) && (k) < hi)
#else
#define IN(k) (lo <= (k) && (k) < hi)
#endif
#define SEAM(k) do { if (IN(k) && IN((k) + 1)) xcd_barrier(bar); } while (0)
    float* R = args.out;
    bf16* ABF = (bf16*)(args.ws + WS_ABF); bf16* OB = (bf16*)(args.ws + WS_O); bf16* QKV = (bf16*)(args.ws + WS_QKV);
    bf16* XS = (bf16*)(args.ws + WS_XS); bf16* HB = (bf16*)(args.ws + WS_H);

    if (IN(0)) { p0_prologue(F, args); } SEAM(0);
    if (IN(1)) { pg8::Gemm g{ABF, (const bf16*)(args.ws + WS_WIN0), NTOK, 3072, DM}; pg8::StaticOrder S; S.init(NTOK, 3072, F.G, (int)blockIdx.x);
        pg8::EpiProj0 E{QKV, (float*)(args.ws + WS_GATES), (const float*)(args.ws + WS_COS), (const float*)(args.ws + WS_SIN)};
        pg8::gemm_phase<pg8::EpiProj0, pg8::StaticOrder, true, true>(F.lds, g, S, E); } SEAM(1);
    if (IN(2)) { p2_compress(F, args); } SEAM(2);
    if (IN(3)) { p3_nsa_naive(F, args); p3_moba_naive(F, args); } SEAM(3);
    if (IN(4)) { pg8::Gemm g{OB, (const bf16*)(args.ws + WS_WOUT0), NTOK, DM, DM}; pg8::StaticOrder S; S.init(NTOK, DM, F.G, (int)blockIdx.x);
        pg8::EpiRes E{args.in[0], R, ALPHA};
        pg8::gemm_phase<pg8::EpiRes, pg8::StaticOrder, true, true>(F.lds, g, S, E); } SEAM(4);
    if (IN(5)) { ln_phase<true, false>(F, args, 0, args.in[12], args.in[13], R, nullptr); } SEAM(5);
    if (IN(6)) { scatter_phase(F, R); } SEAM(6);
    if (IN(7)) { const int np = build_ptab(F, 0); pg8::Gemm g{XS, nullptr, MAXROWS, 1024, DM};
        MoeOrder1 S{F.G, (int)blockIdx.x, np * 4, (const LAS int*)(F.lds + PTAB_OFF), (const bf16*)(args.ws + WS_W1E)};
        pg8::EpiMoe1 E{HB, (const float*)(args.ws + WS_WROW)};
        pg8::gemm_phase<pg8::EpiMoe1, MoeOrder1, true, true>(F.lds, g, S, E); } SEAM(7);
    if (IN(8)) { const int np = build_ptab(F, 0); pg8::Gemm g{HB, nullptr, MAXROWS, 1024, 512};
        MoeOrder2 S{F.G, (int)blockIdx.x, np * 4, (const LAS int*)(F.lds + PTAB_OFF), (const bf16*)(args.ws + WS_B2)};
        pg8::EpiMoe2 E{R, (const int*)(args.ws + WS_ROWMAP), ALPHA};
        pg8::gemm_phase<pg8::EpiMoe2, MoeOrder2, true, true>(F.lds, g, S, E); } SEAM(8);
    if (IN(9)) { ln_phase<false, true>(F, args, 0, args.in[14], args.in[15], R, ABF); } SEAM(9);
    if (IN(10)) { pg8::Gemm g{ABF, (const bf16*)(args.ws + WS_WIN1), NTOK, 3072, DM}; pg8::StaticOrder S; S.init(NTOK, 3072, F.G, (int)blockIdx.x);
        pg8::EpiProj1 E{QKV};
        pg8::gemm_phase<pg8::EpiProj1, pg8::StaticOrder, true, true>(F.lds, g, S, E); } SEAM(10);
    if (IN(11)) { p11_sb_naive(F, args); } SEAM(11);
    if (IN(12)) { pg8::Gemm g{OB, (const bf16*)(args.ws + WS_WOUT1), NTOK, DM, DM}; pg8::StaticOrder S; S.init(NTOK, DM, F.G, (int)blockIdx.x);
        pg8::EpiRes E{R, R, ALPHA};
        pg8::gemm_phase<pg8::EpiRes, pg8::StaticOrder, true, true>(F.lds, g, S, E); } SEAM(12);
    if (IN(13)) { ln_phase<true, false>(F, args, 1, args.in[12] + DM, args.in[13] + DM, R, nullptr); } SEAM(13);
    if (IN(14)) { scatter_phase(F, R); } SEAM(14);
    if (IN(15)) { const int np = build_ptab(F, 0); pg8::Gemm g{XS, nullptr, MAXROWS, 1024, DM};
        MoeOrder1 S{F.G, (int)blockIdx.x, np * 4, (const LAS int*)(F.lds + PTAB_OFF), (const bf16*)(args.ws + WS_W1E) + (size_t)16 * 512 * 1024};
        pg8::EpiMoe1 E{HB, (const float*)(args.ws + WS_WROW)};
        pg8::gemm_phase<pg8::EpiMoe1, MoeOrder1, true, true>(F.lds, g, S, E); } SEAM(15);
    if (IN(16)) { const int np = build_ptab(F, 0); pg8::Gemm g{HB, nullptr, MAXROWS, 1024, 512};
        MoeOrder2 S{F.G, (int)blockIdx.x, np * 4, (const LAS int*)(F.lds + PTAB_OFF), (const bf16*)(args.ws + WS_B2) + (size_t)24 * 1024 * 512};
        pg8::EpiMoe2 E{R, (const int*)(args.ws + WS_ROWMAP), ALPHA};
        pg8::gemm_phase<pg8::EpiMoe2, MoeOrder2, true, true>(F.lds, g, S, E); } SEAM(16);
    if (IN(17)) { ln_phase<false, false>(F, args, 1, args.in[14] + DM, args.in[15] + DM, R, nullptr); }
#undef IN
#undef SEAM
}

extern "C" void kernel_launch(void* const* d_in, const int* in_sizes, int n_in, void* d_out, int out_size, void* d_ws, size_t ws_size, hipStream_t stream) {
    static int grid = 0;
    if (grid == 0) {
        if (n_in != 23 || in_sizes[0] != NTOK * DM || out_size != NTOK * DM || ws_size < WS_END) { fprintf(stderr, "kernel_launch: unexpected shapes (n_in %d, in0 %d, out %d, ws %zu); nothing launched\n", n_in, n_in > 0 ? in_sizes[0] : -1, out_size, ws_size); grid = -1; return; }
        int dev = 0, cus = 0, per_cu = 0;
        if (hipGetDevice(&dev) != hipSuccess || hipDeviceGetAttribute(&cus, hipDeviceAttributeMultiprocessorCount, dev) != hipSuccess) { grid = -1; return; }
        if (hipFuncSetAttribute((const void*)fwd_kernel, hipFuncAttributeMaxDynamicSharedMemorySize, LDS_BYTES) != hipSuccess) { fprintf(stderr, "kernel_launch: hipFuncSetAttribute failed\n"); grid = -1; return; }
        if (hipOccupancyMaxActiveBlocksPerMultiprocessor(&per_cu, (const void*)fwd_kernel, NWAVES * 64, LDS_BYTES) != hipSuccess || per_cu < 1) { fprintf(stderr, "kernel_launch: occupancy query reports %d workgroups per CU\n", per_cu); }
        (void)hipGetLastError();
        grid = cus;
    }
    if (grid < 0) return;
    if (hipMemsetAsync((char*)d_ws + WS_CTL, 0, CTL_ZERO_BYTES, stream) != hipSuccess) return;
    Args a{};
    for (int i = 0; i < 23; ++i) a.in[i] = (const float*)d_in[i];
    a.out = (float*)d_out; a.ws = (unsigned char*)d_ws; a.pad = 0;
#if MK_N_LAUNCHES == 1
    a.ph_lo = 0; a.ph_hi = NPH; a.use_bar = 1;
    hipLaunchKernelGGL(fwd_kernel, dim3(grid), dim3(NWAVES * 64), LDS_BYTES, stream, a);
#else
    for (int p = 0; p < NPH; ++p) { a.ph_lo = p; a.ph_hi = p + 1; a.use_bar = 0;
        hipLaunchKernelGGL(fwd_kernel, dim3(grid), dim3(NWAVES * 64), LDS_BYTES, stream, a); }
#endif
}
```

```cpp
#include <hip/hip_runtime.h>
#include <cstdio>
#include <cstdint>
#include <cmath>

#ifndef MK_N_LAUNCHES
#define MK_N_LAUNCHES 1
#endif

namespace pg8 {
#define PG8_LAS __attribute__((address_space(3)))
typedef unsigned short bf16_t;
typedef short bf16x8 __attribute__((ext_vector_type(8)));
typedef float f32x4 __attribute__((ext_vector_type(4)));
typedef unsigned u32x4 __attribute__((ext_vector_type(4)));
constexpr int BM = 256, BK = 64, HALF = 128, HTB = HALF * BK * 2  , STAGE_BYTES = 8 * HTB, NXCD = 8, WGM = 8;

__host__ __device__ __forceinline__ int lds_byte(int r, int c) { const int st = (r >> 4) * 2 + (c >> 5), rr = r & 15, cc = c & 31, ob = rr * 64 + cc * 2; return st * 1024 + (ob ^ (((ob >> 9) & 1) << 5)); }
__host__ __device__ __forceinline__ void stage_rc(int b, int& R, int& C) { const int st = b / 1024, sb = b % 1024, swz = sb ^ (((sb >> 9) & 1) << 5); R = (st >> 1) * 16 + swz / 64; C = (st & 1) * 32 + (swz % 64) / 2; }
__host__ __device__ __forceinline__ int perm32(int rho) { const int n = rho >> 4, i = rho & 15; return 8 * (i >> 2) + 4 * n + (i & 3); }

struct Unit { int pm, pn, aux; };
struct Gemm { const bf16_t* A; const bf16_t* Bt; int M, N, K; };

struct StaticOrder {
    static constexpr bool GATHER = false;
    int nM, nN, nwg, G, c;
    __host__ __device__ void init(int M, int N, int G_, int c_) { nM = M / BM; nN = N / BM; nwg = nM * nN; G = G_; c = c_; }
    __host__ __device__ bool next(int i, Unit& u) const {
        const long L = (long)i * G + c; if (L >= nwg) return false;
        int wgid = (int)L; { const int q = nwg / NXCD, r = nwg % NXCD, xcd = wgid % NXCD, off = wgid / NXCD; wgid = (xcd < r ? xcd * (q + 1) : r * (q + 1) + (xcd - r) * q) + off; }
        const int nig = WGM * nN, gid = wgid / nig, fm = gid * WGM, gsz = (nM - fm) < WGM ? (nM - fm) : WGM;
        u.pm = fm + ((wgid % nig) % gsz); u.pn = (wgid % nig) / gsz; u.aux = 0; return true;
    }
    __device__ __forceinline__ const char* aptr(const Gemm& g, const Unit& u, size_t tstep) const { return (const char*)g.A + (size_t)u.pm * tstep; }
    __device__ __forceinline__ const char* bptr(const Gemm& g, const Unit& u, size_t tstep) const { return (const char*)g.Bt + (size_t)u.pn * tstep; }
    __device__ __forceinline__ int arow(const Unit&, int) const { return 0; }
    __device__ __forceinline__ void a_ready(const Unit&) const {}
    __device__ __forceinline__ void done(const Unit&) const {}
};

__device__ __forceinline__ unsigned cvt_pk_bf16(float lo, float hi) { unsigned r; asm volatile("v_cvt_pk_bf16_f32 %0, %1, %2" : "=v"(r) : "v"(lo), "v"(hi)); return r; }
typedef unsigned u32x2 __attribute__((ext_vector_type(2)));
constexpr int SEQ_ = 8192;
constexpr float QLOG2 = 0.125f * 1.4426950408889634f;
constexpr size_t E_QA = 0, E_KCMP = 16777216, E_KSLC = 20971520, E_KWIN = 25165824, E_VCMP = 29360128, E_VSLC = 33554432, E_VWIN = 37748736,
                 E_QM = 41943040, E_KM = 58720256, E_VM = 75497472;

struct EpiProj0 {
    static constexpr bool PERM = true, AFTER_DRAIN = false;
    bf16_t* qkv; float* gates; const float* cosT; const float* sinT;
    __device__ __forceinline__ void operator()(const f32x4 (&acc)[2][2][4][2], const Unit& u, int wr, int wc, int fr, int fq) const {
        const int row0 = u.pm * BM + wr * 64 + fr;
#pragma unroll
        for (int bj = 0; bj < 2; ++bj) {
            const int hs = u.pn * 4 + bj * 2 + (wc >> 1);
            const int p0 = 32 * (wc & 1) + 8 * fq;
            if (hs < 44) {
                const bool rope = (hs < 14) || (hs >= 20 && hs < 36), isq = hs < 8 || (hs >= 20 && hs < 28);
                size_t base; int nh, hh;
                if (hs < 8) { base = E_QA; nh = 8; hh = hs; }
                else if (hs < 20) { base = E_KCMP + (size_t)((hs - 8) >> 1) * 4194304; nh = 2; hh = (hs - 8) & 1; }
                else { base = E_QM + (size_t)((hs - 20) >> 3) * 16777216; nh = 8; hh = (hs - 20) & 7; }
#pragma unroll
                for (int ai = 0; ai < 2; ++ai)
#pragma unroll
                    for (int m = 0; m < 4; ++m) {
                        const int r = row0 + ai * HALF + m * 16, b = r >> 13, s = r & (SEQ_ - 1);
                        f32x4 v0 = acc[ai][bj][m][0], v1 = acc[ai][bj][m][1];
                        if (rope) {
                            const f32x4 c4 = *(const f32x4*)(cosT + (size_t)r * 32 + (p0 >> 1)), s4 = *(const f32x4*)(sinT + (size_t)r * 32 + (p0 >> 1));
                            const f32x4 w0 = v0, w1 = v1;
                            v0[0] = w0[0] * c4[0] - w0[1] * s4[0]; v0[1] = w0[1] * c4[0] + w0[0] * s4[0];
                            v0[2] = w0[2] * c4[1] - w0[3] * s4[1]; v0[3] = w0[3] * c4[1] + w0[2] * s4[1];
                            v1[0] = w1[0] * c4[2] - w1[1] * s4[2]; v1[1] = w1[1] * c4[2] + w1[0] * s4[2];
                            v1[2] = w1[2] * c4[3] - w1[3] * s4[3]; v1[3] = w1[3] * c4[3] + w1[2] * s4[3];
                        }
                        if (isq) { v0 = v0 * QLOG2; v1 = v1 * QLOG2; }
                        u32x4 w; w.x = cvt_pk_bf16(v0[0], v0[1]); w.y = cvt_pk_bf16(v0[2], v0[3]); w.z = cvt_pk_bf16(v1[0], v1[1]); w.w = cvt_pk_bf16(v1[2], v1[3]);
                        *(u32x4*)(qkv + base + ((size_t)(b * nh + hh) * SEQ_ + s) * 64 + p0) = w;
                    }
            } else if (hs == 44) {
                if ((wc & 1) == 0 && fq < 3) {
#pragma unroll
                    for (int ai = 0; ai < 2; ++ai)
#pragma unroll
                        for (int m = 0; m < 4; ++m) {
                            const int r = row0 + ai * HALF + m * 16;
                            f32x4 v0 = acc[ai][bj][m][0], v1 = acc[ai][bj][m][1];
#pragma unroll
                            for (int e = 0; e < 4; ++e) { v0[e] = 1.0f / (1.0f + __expf(-v0[e])); v1[e] = 1.0f / (1.0f + __expf(-v1[e])); }
                            *(f32x4*)(gates + (size_t)r * 24 + p0) = v0; *(f32x4*)(gates + (size_t)r * 24 + p0 + 4) = v1;
                        }
                }
            }
        }
    }
};
struct EpiProj1 {
    static constexpr bool PERM = true, AFTER_DRAIN = false;
    bf16_t* qkv;
    __device__ __forceinline__ void operator()(const f32x4 (&acc)[2][2][4][2], const Unit& u, int wr, int wc, int fr, int fq) const {
        const int row0 = u.pm * BM + wr * 64 + fr;
#pragma unroll
        for (int bj = 0; bj < 2; ++bj) {
            const int hs = u.pn * 4 + bj * 2 + (wc >> 1), p0 = 32 * (wc & 1) + 8 * fq, hh = hs & 15;
            const size_t base = (size_t)(hs >> 4) * 33554432;
#pragma unroll
            for (int ai = 0; ai < 2; ++ai)
#pragma unroll
                for (int m = 0; m < 4; ++m) {
                    const int r = row0 + ai * HALF + m * 16, b = r >> 13, s = r & (SEQ_ - 1);
                    f32x4 v0 = acc[ai][bj][m][0], v1 = acc[ai][bj][m][1];
                    if (hs < 16) { v0 = v0 * QLOG2; v1 = v1 * QLOG2; }
                    u32x4 w; w.x = cvt_pk_bf16(v0[0], v0[1]); w.y = cvt_pk_bf16(v0[2], v0[3]); w.z = cvt_pk_bf16(v1[0], v1[1]); w.w = cvt_pk_bf16(v1[2], v1[3]);
                    *(u32x4*)(qkv + base + ((size_t)(b * 16 + hh) * SEQ_ + s) * 64 + p0) = w;
                }
        }
    }
};
struct EpiRes {
    static constexpr bool PERM = false, AFTER_DRAIN = false;
    const float* resid; float* out; float alpha;
    __device__ __forceinline__ void operator()(const f32x4 (&acc)[2][2][4][2], const Unit& u, int wr, int wc, int fr, int fq) const {
        const int row0 = u.pm * BM + wr * 64 + fr, col0 = u.pn * BM + wc * 32 + 4 * fq;
#pragma unroll
        for (int ai = 0; ai < 2; ++ai)
#pragma unroll
            for (int m = 0; m < 4; ++m) { const size_t off = (size_t)(row0 + ai * HALF + m * 16) * 1024 + col0;
#pragma unroll
                for (int bj = 0; bj < 2; ++bj)
#pragma unroll
                    for (int n = 0; n < 2; ++n) { const f32x4 bs = *(const f32x4*)(resid + off + bj * HALF + n * 16); *(f32x4*)(out + off + bj * HALF + n * 16) = bs * alpha + acc[ai][bj][m][n]; } }
    }
};
struct EpiMoe1 {
    static constexpr bool PERM = true, AFTER_DRAIN = false;
    bf16_t* H; const float* wrow;
    __device__ __forceinline__ void operator()(const f32x4 (&acc)[2][2][4][2], const Unit& u, int wr, int wc, int fr, int fq) const {
        const int row0 = u.pm * BM + wr * 64 + fr, slot = u.pn >> 1;
#pragma unroll
        for (int ai = 0; ai < 2; ++ai)
#pragma unroll
            for (int m = 0; m < 4; ++m) { const int prow = row0 + ai * HALF + m * 16; const float w = wrow[(size_t)prow * 2 + slot];
#pragma unroll
                for (int bj = 0; bj < 2; ++bj) { const f32x4 g = acc[ai][bj][m][0], up = acc[ai][bj][m][1]; float hv[4];
#pragma unroll
                    for (int e = 0; e < 4; ++e) hv[e] = g[e] / (1.0f + __expf(-g[e])) * up[e] * w;
                    u32x2 o; o.x = cvt_pk_bf16(hv[0], hv[1]); o.y = cvt_pk_bf16(hv[2], hv[3]);
                    *(u32x2*)(H + (size_t)prow * 512 + u.pn * 128 + bj * 64 + wc * 16 + 4 * fq) = o; } }
    }
};
struct EpiMoe2 {
    static constexpr bool PERM = false, AFTER_DRAIN = false;
    float* R; const int* rowmap; float alpha;
    __device__ __forceinline__ void operator()(const f32x4 (&acc)[2][2][4][2], const Unit& u, int wr, int wc, int fr, int fq) const {
        const int row0 = u.pm * BM + wr * 64 + fr, col0 = u.pn * BM + wc * 32 + 4 * fq;
#pragma unroll
        for (int ai = 0; ai < 2; ++ai)
#pragma unroll
            for (int m = 0; m < 4; ++m) { const int tok = rowmap[row0 + ai * HALF + m * 16];
                if (tok >= 0) { const size_t off = (size_t)tok * 1024 + col0;
#pragma unroll
                    for (int bj = 0; bj < 2; ++bj)
#pragma unroll
                        for (int n = 0; n < 2; ++n) { const f32x4 bs = *(const f32x4*)(R + off + bj * HALF + n * 16); *(f32x4*)(R + off + bj * HALF + n * 16) = bs * alpha + acc[ai][bj][m][n]; } } }
    }
};

template <class Epi, class Sched, bool ALIGN_EPI = false, bool SP2 = false>
__device__ __forceinline__ void gemm_phase(PG8_LAS unsigned char* lds, const Gemm g, const Sched& S, const Epi& E) {
    const int tid = threadIdx.x, wid = __builtin_amdgcn_readfirstlane(tid >> 6), lane = tid & 63, wr = wid >> 2, wc = wid & 3, fr = lane & 15, fq = lane >> 4;
    const int K = g.K, nt = K / BK;
    unsigned voffA[2], voffB[2]; int Rv[2], Cv[2];
#pragma unroll
    for (int i = 0; i < 2; ++i) { int R, C; stage_rc(tid * 16 + i * 8192, R, C); const int Rb = Epi::PERM ? ((R & ~31) + perm32(R & 31)) : R; Rv[i] = R; Cv[i] = C;
        voffA[i] = (unsigned)(R * K + C) * 2u; voffB[i] = (unsigned)(Rb * K + C) * 2u; }
    constexpr bool GATHER = Sched::GATHER; static_assert(!GATHER || SP2, "gather is wired into the SP2 loop only");
    unsigned gA[2][2], gN[2][2];
#define PG8_SETG(G_, U_) do { _Pragma("unroll") for (int _h = 0; _h < 2; ++_h) _Pragma("unroll") for (int _i = 0; _i < 2; ++_i) G_[_h][_i] = GATHER ? (unsigned)S.arow(U_, _h * HALF + Rv[_i]) * (unsigned)(K * 2) + (unsigned)(Cv[_i] * 2) : voffA[_i]; } while (0)
#define PG8_SELG(dst, h_, nx_) unsigned dst[2] = { (nx_) ? gN[h_][0] : gA[h_][0], (nx_) ? gN[h_][1] : gA[h_][1] }
    const size_t kstep = (size_t)(BK * 2);
    const size_t hstep = (size_t)HALF * K * 2;
    const size_t hstepA = GATHER ? (size_t)0 : hstep;
    const size_t tstep = 2 * hstep;
    const unsigned ldsw = (unsigned)wid * 1024u;
    const int aoff = lds_byte(wr * 64 + fr, fq * 8), boff = lds_byte(wc * 32 + fr, fq * 8);
#define PG8_SA(b, h) (((b) * 2 + (h)) * HTB)
#define PG8_SB(b, h) ((4 + (b) * 2 + (h)) * HTB)
#define PG8_STAGE(bufoff, gbase, voff) do { _Pragma("unroll") for (int _i = 0; _i < 2; ++_i) \
        __builtin_amdgcn_global_load_lds((const unsigned*)((const char*)(gbase) + (voff)[_i]), (PG8_LAS unsigned*)(lds + (bufoff) + ldsw + _i * 8192), 16, 0, 0); } while (0)
#define PG8_LDA(dst, b, h) do { _Pragma("unroll") for (int m = 0; m < 4; ++m) _Pragma("unroll") for (int k = 0; k < 2; ++k) dst[m][k] = *(const PG8_LAS bf16x8*)(lds + PG8_SA(b, h) + aoff + m * 2048 + k * 1024); } while (0)
#define PG8_LDB(dst, b, h) do { _Pragma("unroll") for (int n = 0; n < 2; ++n) _Pragma("unroll") for (int k = 0; k < 2; ++k) dst[n][k] = *(const PG8_LAS bf16x8*)(lds + PG8_SB(b, h) + boff + n * 2048 + k * 1024); } while (0)
#define PG8_MMA(ai, bj, At, Bt) do { __builtin_amdgcn_s_setprio(1); _Pragma("unroll") for (int m = 0; m < 4; ++m) _Pragma("unroll") for (int n = 0; n < 2; ++n) _Pragma("unroll") for (int k = 0; k < 2; ++k) \
        acc[ai][bj][m][n] = __builtin_amdgcn_mfma_f32_16x16x32_bf16(Bt[n][k], At[m][k], acc[ai][bj][m][n], 0, 0, 0); __builtin_amdgcn_s_setprio(0); } while (0)
#define PG8_WAIT_V(n) asm volatile("s_waitcnt vmcnt(" #n ")" ::: "memory")
#define PG8_WAIT_L(n) asm volatile("s_waitcnt lgkmcnt(" #n ")" ::: "memory")
#define PG8_BAR __builtin_amdgcn_s_barrier()
#define PG8_SCHED __builtin_amdgcn_sched_barrier(0)
    Unit cur, nxt; int ui = 0;
    if (!S.next(0, cur)) return;
    f32x4 acc[2][2][4][2];
#pragma unroll
    for (int a = 0; a < 2; ++a)
#pragma unroll
        for (int b = 0; b < 2; ++b)
#pragma unroll
            for (int m = 0; m < 4; ++m)
#pragma unroll
                for (int n = 0; n < 2; ++n) acc[a][b][m][n] = (f32x4){0.f, 0.f, 0.f, 0.f};
    bf16x8 At[4][2], B0[2][2], B1[2][2];
    const char* cA = GATHER ? (const char*)g.A : S.aptr(g, cur, tstep); const char* cB = S.bptr(g, cur, tstep);
    S.a_ready(cur);
    PG8_SETG(gA, cur);
    if constexpr (SP2) {
        PG8_STAGE(PG8_SB(0, 0), cB, voffB); PG8_STAGE(PG8_SB(0, 1), cB + hstep, voffB); PG8_STAGE(PG8_SA(0, 0), cA, gA[0]); PG8_STAGE(PG8_SA(0, 1), cA + hstepA, gA[1]);
        if (wr == 1) PG8_BAR;
        PG8_WAIT_V(2); PG8_BAR;
        PG8_STAGE(PG8_SB(1, 0), cB + kstep, voffB); PG8_STAGE(PG8_SA(1, 0), cA + kstep, gA[0]); PG8_STAGE(PG8_SB(1, 1), cB + hstep + kstep, voffB);
        PG8_WAIT_V(6); PG8_BAR;
    } else {
        PG8_STAGE(PG8_SB(0, 0), cB, voffB); PG8_STAGE(PG8_SA(0, 0), cA, voffA); PG8_STAGE(PG8_SB(0, 1), cB + hstep, voffB); PG8_STAGE(PG8_SA(0, 1), cA + hstep, voffA);
        if (wr == 1) PG8_BAR;
        PG8_WAIT_V(4); PG8_BAR;
        PG8_STAGE(PG8_SB(1, 0), cB + kstep, voffB); PG8_STAGE(PG8_SA(1, 0), cA + kstep, voffA); PG8_STAGE(PG8_SB(1, 1), cB + hstep + kstep, voffB);
        PG8_WAIT_V(6); PG8_BAR;
    }
    for (;;) {
        const bool has_next = S.next(ui + 1, nxt);
        const char* nA = (has_next && !GATHER) ? S.aptr(g, nxt, tstep) : cA; const char* nB = has_next ? S.bptr(g, nxt, tstep) : cB;
        if (has_next) PG8_SETG(gN, nxt); else { _Pragma("unroll") for (int _h = 0; _h < 2; ++_h) _Pragma("unroll") for (int _i = 0; _i < 2; ++_i) gN[_h][_i] = gA[_h][_i]; }
        for (int t = 0; t < nt; t += 2) {
            const bool last = (t == nt - 2);
            const char* a1 = cA + (size_t)(t + 1) * kstep;
            const char* a2 = last ? nA : cA + (size_t)(t + 2) * kstep; const char* b2 = last ? nB : cB + (size_t)(t + 2) * kstep;
            const char* a3 = a2 + kstep; const char* b3 = b2 + kstep;
            if (last && has_next) S.a_ready(nxt);
            if constexpr (SP2) {
            PG8_LDB(B0, 0, 0); PG8_LDB(B1, 0, 1); PG8_SCHED; PG8_LDA(At, 0, 0); PG8_STAGE(PG8_SA(1, 1), a1 + hstepA, gA[1]);
            PG8_WAIT_V(8); PG8_WAIT_L(0); PG8_BAR; PG8_MMA(0, 0, At, B0); PG8_MMA(0, 1, At, B1); PG8_BAR; PG8_SCHED;
            PG8_LDA(At, 0, 1); PG8_STAGE(PG8_SB(0, 0), b2, voffB); PG8_STAGE(PG8_SB(0, 1), b2 + hstep, voffB); { PG8_SELG(gs_, 0, last); PG8_STAGE(PG8_SA(0, 0), a2, gs_); }
            PG8_WAIT_V(8); PG8_WAIT_L(0); PG8_BAR; PG8_MMA(1, 0, At, B0); PG8_MMA(1, 1, At, B1); PG8_BAR; PG8_SCHED;
            PG8_LDB(B0, 1, 0); PG8_LDB(B1, 1, 1); PG8_SCHED; PG8_LDA(At, 1, 0); { PG8_SELG(gs_, 1, last); PG8_STAGE(PG8_SA(0, 1), a2 + hstepA, gs_); }
            PG8_WAIT_V(8); PG8_WAIT_L(0); PG8_BAR; PG8_MMA(0, 0, At, B0); PG8_MMA(0, 1, At, B1); PG8_BAR; PG8_SCHED;
            PG8_LDA(At, 1, 1); PG8_STAGE(PG8_SB(1, 0), b3, voffB); PG8_STAGE(PG8_SB(1, 1), b3 + hstep, voffB); { PG8_SELG(gs_, 0, last); PG8_STAGE(PG8_SA(1, 0), a3, gs_); }
            PG8_WAIT_V(8); PG8_WAIT_L(0); PG8_BAR; PG8_MMA(1, 0, At, B0); PG8_MMA(1, 1, At, B1); PG8_BAR; PG8_SCHED;
            } else {
            PG8_LDB(B0, 0, 0); PG8_SCHED; PG8_LDA(At, 0, 0); PG8_STAGE(PG8_SA(1, 1), a1 + hstep, voffA);
            PG8_WAIT_L(8); PG8_BAR; PG8_WAIT_L(0); PG8_MMA(0, 0, At, B0); PG8_BAR; PG8_SCHED;
            PG8_LDB(B1, 0, 1); PG8_STAGE(PG8_SB(0, 0), b2, voffB);
            PG8_BAR; PG8_WAIT_L(0); PG8_MMA(0, 1, At, B1); PG8_BAR;
            PG8_LDA(At, 0, 1); PG8_STAGE(PG8_SA(0, 0), a2, voffA);
            PG8_BAR; PG8_WAIT_L(0); PG8_MMA(1, 0, At, B0); PG8_BAR; PG8_SCHED;
            PG8_STAGE(PG8_SB(0, 1), b2 + hstep, voffB);
            PG8_WAIT_V(6); PG8_BAR; PG8_MMA(1, 1, At, B1); PG8_BAR;
            PG8_LDB(B0, 1, 0); PG8_SCHED; PG8_LDA(At, 1, 0); PG8_STAGE(PG8_SA(0, 1), a2 + hstep, voffA);
            PG8_WAIT_L(8); PG8_BAR; PG8_WAIT_L(0); PG8_MMA(0, 0, At, B0); PG8_BAR; PG8_SCHED;
            PG8_LDB(B1, 1, 1); PG8_STAGE(PG8_SB(1, 0), b3, voffB);
            PG8_BAR; PG8_WAIT_L(0); PG8_MMA(0, 1, At, B1); PG8_BAR;
            PG8_LDA(At, 1, 1); PG8_STAGE(PG8_SA(1, 0), a3, voffA);
            PG8_BAR; PG8_WAIT_L(0); PG8_MMA(1, 0, At, B0); PG8_BAR; PG8_SCHED;
            PG8_STAGE(PG8_SB(1, 1), b3 + hstep, voffB);
            PG8_WAIT_V(6); PG8_BAR; PG8_MMA(1, 1, At, B1); PG8_BAR;
            }
        }
        if constexpr (ALIGN_EPI) { if (wr == 0) PG8_BAR; }
        if constexpr (!Epi::AFTER_DRAIN) { E(acc, cur, wr, wc, fr, fq); S.done(cur); }
        if (!has_next) break;
#pragma unroll
        for (int a = 0; a < 2; ++a)
#pragma unroll
            for (int b = 0; b < 2; ++b)
#pragma unroll
                for (int m = 0; m < 4; ++m)
#pragma unroll
                    for (int n = 0; n < 2; ++n) acc[a][b][m][n] = (f32x4){0.f, 0.f, 0.f, 0.f};
        cur = nxt; cA = nA; cB = nB; ++ui;
#pragma unroll
        for (int _h = 0; _h < 2; ++_h)
#pragma unroll
            for (int _i = 0; _i < 2; ++_i) gA[_h][_i] = gN[_h][_i];
        if constexpr (ALIGN_EPI) { if (wr == 1) PG8_BAR; }
    }
    PG8_WAIT_V(0);
    if constexpr (!ALIGN_EPI) { if (wr == 0) PG8_BAR; }
    PG8_BAR;
    if constexpr (Epi::AFTER_DRAIN) { E.fused(acc, cur, wr, wc, fr, fq, lds, wid, lane); S.done(cur); }
#undef PG8_SETG
#undef PG8_SELG
#undef PG8_SA
#undef PG8_SB
#undef PG8_STAGE
#undef PG8_LDA
#undef PG8_LDB
#undef PG8_MMA
#undef PG8_WAIT_V
#undef PG8_WAIT_L
#undef PG8_BAR
#undef PG8_SCHED
}
}

constexpr int NWAVES = 8;
constexpr int BATCH = 4, SEQ = 8192, DM = 1024, NTOK = BATCH * SEQ;
constexpr int NPH = 18;
constexpr float LN_EPS = 1e-5f;
constexpr float ALPHA = 1.4142135623730951f;
constexpr float QSCALE = 0.125f;
constexpr float NAIVE_SC = 0.6931471805599453f;
constexpr int MAXPAN = 152, MAXROWS = MAXPAN * 256;
constexpr size_t MiB = 1u << 20;
constexpr size_t WS_CTL = 0, CTL_ZERO_BYTES = 1 * MiB;
constexpr size_t WS_POSB = 1 * MiB, WS_KC = 1 * MiB + 4096, WS_VC = WS_KC + 524288, WS_KMEAN = WS_VC + 524288;
constexpr size_t WS_KMH = 2 * MiB + 512 * 1024, WS_KML = 2 * MiB + 768 * 1024;
constexpr size_t WS_W1T = 3 * MiB;
constexpr size_t WS_COS = 4 * MiB, WS_SIN = 8 * MiB;
constexpr size_t WS_TOKI = 12 * MiB, WS_ROWMAP = WS_TOKI + 524288, WS_WROW = WS_ROWMAP + 262144;
constexpr size_t WS_WIN0 = 14 * MiB, WS_WOUT0 = 20 * MiB, WS_WIN1 = 22 * MiB, WS_WOUT1 = 28 * MiB, WS_W1E = 30 * MiB, WS_B2 = 62 * MiB;
constexpr size_t WS_ABF = 110 * MiB, WS_O = 174 * MiB, WS_QKV = 238 * MiB, WS_END = 430 * MiB;
constexpr size_t WS_GATES = WS_QKV + 176 * MiB;
constexpr size_t WS_XS = WS_QKV, WS_H = WS_QKV + 80 * MiB;
static_assert(WS_WROW + (size_t)MAXROWS * 8 <= WS_WIN0 && WS_KMEAN + 262144 <= WS_COS && (size_t)MAXROWS * 2048 <= 80 * MiB && (size_t)MAXROWS * 1024 <= 96 * MiB, "ws map");
constexpr int CW_BAR = 4096;
constexpr int CW_CNT = 16384;
constexpr int RING_BYTES = 131072;
constexpr int LDSCTL_OFF = RING_BYTES, MISC_OFF = LDSCTL_OFF + 320;
constexpr int PTAB_OFF = LDSCTL_OFF + 1024;
constexpr int LDS_BYTES = 147456;

#define GAS __attribute__((address_space(1)))
#define LAS __attribute__((address_space(3)))
typedef unsigned short bf16;
typedef unsigned v4u __attribute__((ext_vector_type(4)));
typedef unsigned v2u __attribute__((ext_vector_type(2)));
typedef float f32x4 __attribute__((ext_vector_type(4)));
typedef GAS unsigned gu32;
#define RLX_AGENT __ATOMIC_RELAXED, __HIP_MEMORY_SCOPE_AGENT
#define LDS_WAIT() asm volatile("s_waitcnt lgkmcnt(0)" ::: "memory")
__device__ __forceinline__ unsigned f2bf(float f) { unsigned u = __builtin_bit_cast(unsigned, f); return (u + 0x7fffu + ((u >> 16) & 1u)) >> 16; }
__device__ __forceinline__ unsigned pk2(float lo, float hi) { return f2bf(lo) | (f2bf(hi) << 16); }
__device__ __forceinline__ float bflo(unsigned u) { return __builtin_bit_cast(float, u << 16); }
__device__ __forceinline__ float bfhi(unsigned u) { return __builtin_bit_cast(float, u & 0xffff0000u); }
__device__ __forceinline__ float bf2f(bf16 h) { return __builtin_bit_cast(float, (unsigned)h << 16); }

#define XB_TMO      128
#define XB_XCNT(j)  (256  + 64 * (j))
#define XB_XSUB(j)  (1280 + 64 * (j))
#define XB_XGEN(j)  (2304 + 64 * (j))
#define XB_TOP      3328
#define XB_TOPGEN   3392
#define XCD_BAR_WORDS 3456
#define XB_SPIN_CAP (1u << 24)
__device__ __forceinline__ unsigned xb_ld(unsigned* p)              { return __hip_atomic_load(p, __ATOMIC_RELAXED, __HIP_MEMORY_SCOPE_AGENT); }
__device__ __forceinline__ unsigned xb_add(unsigned* p, unsigned v) { return __hip_atomic_fetch_add(p, v, __ATOMIC_RELAXED, __HIP_MEMORY_SCOPE_AGENT); }
__device__ __forceinline__ unsigned xb_xcc_id() { return (unsigned)__builtin_amdgcn_s_getreg((3 << 11) | 20) & 0xFu; }
#define XB_SPIN(cond, bar) do { unsigned _sp = 0; while (cond) { __builtin_amdgcn_s_sleep(1); \
    if ((++_sp & 255u) == 0u) { if (xb_ld(&(bar)[XB_TMO])) break; if (_sp > XB_SPIN_CAP) { atomicAdd(&(bar)[XB_TMO], 1u); break; } } } } while (0)
struct XcdBarrier { unsigned* bar; unsigned x; volatile LAS unsigned* st; };
__device__ __forceinline__ XcdBarrier xcd_barrier_post(unsigned* bar, volatile LAS unsigned* st) {
    XcdBarrier b; b.bar = bar; b.x = xb_xcc_id(); b.st = st;
    if (threadIdx.x == 0) (void)xb_add(&bar[XB_XCNT(b.x)], 1u);
    return b;
}
__device__ __forceinline__ void xcd_barrier_complete(unsigned* bar, unsigned x, unsigned& nloc, unsigned& nx) {
    const unsigned G = gridDim.x * gridDim.y * gridDim.z;
    unsigned sum, cnt, mine, sp = 0u;
    for (;;) {
        sum = 0u; cnt = 0u; mine = 0u;
#pragma unroll
        for (unsigned j = 0; j < 16; ++j) { const unsigned c = xb_ld(&bar[XB_XCNT(j)]); sum += c; cnt += (c > 0u) ? 1u : 0u; mine = (j == x) ? c : mine; }
        if (sum == G) break;
        __builtin_amdgcn_s_sleep(1);
        if ((++sp & 255u) == 0u) { if (xb_ld(&bar[XB_TMO])) break; if (sp > XB_SPIN_CAP) { atomicAdd(&bar[XB_TMO], 1u); break; } }
    }
    nloc = mine > 0u ? mine : 1u; nx = cnt > 0u ? cnt : 1u;
}
__device__ __forceinline__ void xcd_barrier(const XcdBarrier& b) {
    asm volatile("s_waitcnt vmcnt(0)" ::: "memory");
    __syncthreads();
    if (threadIdx.x == 0) {
        unsigned* bar = b.bar;
        __builtin_amdgcn_s_waitcnt(0);
        unsigned nloc = b.st[0], nx = b.st[1];
        if (nloc == 0u) { xcd_barrier_complete(bar, b.x, nloc, nx); b.st[0] = nloc; b.st[1] = nx; }
        const unsigned old = xb_add(&bar[XB_XSUB(b.x)], 1u);
        const unsigned gen = old / nloc;
        if (old + 1u == (gen + 1u) * nloc) {
            __builtin_amdgcn_fence(__ATOMIC_RELEASE, "agent");
            asm volatile("s_waitcnt vmcnt(0)" ::: "memory");
            const unsigned og = xb_add(&bar[XB_TOP], 1u);
            const unsigned tg = og / nx;
            if (og + 1u == (tg + 1u) * nx) xb_add(&bar[XB_TOPGEN], 1u);
            else XB_SPIN(xb_ld(&bar[XB_TOPGEN]) == tg, bar);
            __builtin_amdgcn_fence(__ATOMIC_ACQUIRE, "agent");
            xb_add(&bar[XB_XGEN(b.x)], 1u);
            asm volatile("s_waitcnt vmcnt(0)" ::: "memory");
        } else {
            XB_SPIN(xb_ld(&bar[XB_XGEN(b.x)]) == gen, bar);
            __builtin_amdgcn_fence(__ATOMIC_ACQUIRE, "agent");
            asm volatile("s_waitcnt vmcnt(0)" ::: "memory");
        }
    }
    __syncthreads();
}

struct Args { const float* in[23]; float* out; unsigned char* ws; int ph_lo, ph_hi, use_bar, pad; };
struct Frame {
    LAS unsigned char* lds;
    unsigned char* ws;
    int tid, lane, wave, vcu, G;
};
__device__ __forceinline__ float wave_sum(float v) {
#pragma unroll
    for (int o = 1; o < 64; o <<= 1) v += __shfl_xor(v, o);
    return v;
}

template <class Map>
__device__ __forceinline__ void tr_item(const float* W, int N, int kb, int nb, bf16* WT, int ldt, int koff, LAS float* scr, int lane, Map map) {
    const int k0 = 64 * kb, n0 = 32 * nb;
#pragma unroll 8
    for (int i = 0; i < 32; ++i) { const int kk = 2 * i + (lane >> 5), n = n0 + (lane & 31); scr[kk * 33 + (lane & 31)] = (n < N) ? W[(size_t)(k0 + kk) * N + n] : 0.f; }
    LDS_WAIT(); asm volatile("" ::: "memory");
    const int c = lane & 7;
#pragma unroll
    for (int j = 0; j < 4; ++j) { const int nl = (lane >> 3) + 8 * j, n = n0 + nl; const LAS float* s = scr + (8 * c) * 33 + nl;
        if (n < N) { const int row = map(n);
            if (row >= 0) { v4u o; o.x = pk2(s[0 * 33], s[1 * 33]); o.y = pk2(s[2 * 33], s[3 * 33]); o.z = pk2(s[4 * 33], s[5 * 33]); o.w = pk2(s[6 * 33], s[7 * 33]);
                *(v4u*)(WT + (size_t)row * ldt + koff + k0 + 8 * c) = o; } } }
    LDS_WAIT(); asm volatile("" ::: "memory");
}
__device__ __forceinline__ int rope_perm(int d) { return d < 32 ? 2 * d : 2 * (d - 32) + 1; }
struct MapIdent { __device__ __forceinline__ int operator()(int n) const { return n; } };
struct MapGU { int up; __device__ __forceinline__ int operator()(int n) const { return (n >> 2) * 8 + up * 4 + (n & 3); } };
struct MapIn0 {
    __device__ __forceinline__ int operator()(int n) const {
        int hs, d; bool rope;
        if (n < 512) { hs = n >> 6; d = n & 63; rope = true; }
        else if (n < 1280) { const int seg = (n - 512) >> 7, w = (n - 512) & 127;
            rope = (seg & 1) == 0; hs = (rope ? 8 : 14) + (seg >> 1) * 2 + (w >> 6); d = w & 63; }
        else if (n < 1304) { return 44 * 64 + (n - 1280); }
        else { const int m = n - 1304, t = m >> 9; hs = 20 + t * 8 + ((m & 511) >> 6); d = m & 63; rope = t < 2; }
        return hs * 64 + (rope ? rope_perm(d) : d);
    }
};
__device__ __forceinline__ void bucket_pair(int pi, int& lo, int& hi) { lo = pi < 3 ? 0 : (pi < 5 ? 1 : 2); hi = pi < 3 ? pi + 1 : (pi < 5 ? pi - 1 : 3); }

__device__ __forceinline__ void p0_prologue(Frame& F, const Args& A) {
    LAS float* scr = (LAS float*)(F.lds + F.wave * 16384);
    const int gw = F.vcu * NWAVES + F.wave, NGW = F.G * NWAVES;
    bf16* WIN0 = (bf16*)(F.ws + WS_WIN0); bf16* WOUT0 = (bf16*)(F.ws + WS_WOUT0); bf16* WIN1 = (bf16*)(F.ws + WS_WIN1); bf16* WOUT1 = (bf16*)(F.ws + WS_WOUT1);
    bf16* W1E = (bf16*)(F.ws + WS_W1E); bf16* B2 = (bf16*)(F.ws + WS_B2);
    constexpr int I_A = 16 * 89, I_B = 16 * 32, I_C = 16 * 96, I_D = 16 * 32, I_E = 64 * 128, I_F = 96 * 128;
    constexpr int NITEMS = I_A + I_B + I_C + I_D + I_E + I_F;
    for (int it = gw; it < NITEMS; it += NGW) {
        int r = it;
        if (r < I_A) { tr_item(A.in[2], 2840, r / 89, r % 89, WIN0, 1024, 0, scr, F.lane, MapIn0()); continue; } r -= I_A;
        if (r < I_B) { tr_item(A.in[3], 1024, r / 32, r % 32, WOUT0, 1024, 0, scr, F.lane, MapIdent()); continue; } r -= I_B;
        if (r < I_C) { tr_item(A.in[10], 3072, r / 96, r % 96, WIN1, 1024, 0, scr, F.lane, MapIdent()); continue; } r -= I_C;
        if (r < I_D) { tr_item(A.in[11], 1024, r / 32, r % 32, WOUT1, 1024, 0, scr, F.lane, MapIdent()); continue; } r -= I_D;
        if (r < I_E) { const int job = r >> 7, sub = r & 127, le = job >> 1, up = job & 1;
            const float* src = (up ? A.in[21] : A.in[20]) + (size_t)le * 1024 * 256; MapGU mp; mp.up = up;
            tr_item(src, 256, sub >> 3, sub & 7, W1E + (size_t)le * 512 * 1024, 1024, 0, scr, F.lane, mp); continue; } r -= I_E;
        { const int job = r >> 7, sub = r & 127, slot = job & 1, lb = job >> 1, layer = lb / 24, bkt = lb % 24, g = bkt / 6; int lo, hi; bucket_pair(bkt % 6, lo, hi);
            const int e = g * 4 + (slot ? hi : lo);
            tr_item(A.in[22] + (size_t)(layer * 16 + e) * 256 * 1024, 1024, sub >> 5, sub & 31, B2 + (size_t)lb * 1024 * 512, 512, slot * 256, scr, F.lane, MapIdent()); }
    }
    { const float* x = A.in[0]; bf16* xb = (bf16*)(F.ws + WS_ABF);
      for (size_t i = (size_t)(F.vcu * 512 + F.tid); i < (size_t)NTOK * DM / 8; i += (size_t)F.G * 512) {
          const f32x4 a = *(const f32x4*)(x + i * 8), b = *(const f32x4*)(x + i * 8 + 4);
          v4u o; o.x = pk2(a[0], a[1]); o.y = pk2(a[2], a[3]); o.z = pk2(b[0], b[1]); o.w = pk2(b[2], b[3]); *(v4u*)(xb + i * 8) = o; } }
    { const int* pos = (const int*)A.in[1]; float* cosT = (float*)(F.ws + WS_COS); float* sinT = (float*)(F.ws + WS_SIN);
      for (int i = F.vcu * 512 + F.tid; i < NTOK * 32; i += F.G * 512) { const int tok = i >> 5, k = i & 31;
          const float inv = powf(10000.0f, -(float)k / 32.0f), ang = (float)pos[tok] * inv; cosT[i] = cosf(ang); sinT[i] = sinf(ang); } }
    { bf16* W1T = (bf16*)(F.ws + WS_W1T);
      for (int i = F.vcu * 512 + F.tid; i < 2 * 2048 * 128; i += F.G * 512) { const int sel = i >> 18, f = (i >> 7) & 2047, j = i & 127;
          const float v = A.in[sel ? 8 : 6][(size_t)f * 128 + j]; const int fp = sel ? f : ((f & ~63) | rope_perm(f & 63));
          W1T[(size_t)sel * 262144 + (size_t)j * 2048 + fp] = (bf16)f2bf(v); } }
    if (F.vcu < 2) { const int sel = F.vcu, j = F.tid & 127, part = F.tid >> 7; const float* pe = A.in[4 + sel]; const float* w1 = A.in[sel ? 8 : 6]; float s = 0.f;
        for (int i = part * 512; i < part * 512 + 512; ++i) s = fmaf(pe[i], w1[(size_t)i * 128 + j], s);
        LAS float* red = (LAS float*)(F.lds + 100000); red[F.tid] = s; __syncthreads();
        if (F.tid < 128) ((float*)(F.ws + WS_POSB))[sel * 128 + F.tid] = (red[F.tid] + red[128 + F.tid]) + (red[256 + F.tid] + red[384 + F.tid]); }
}

__device__ __forceinline__ float gelu_tanh(float x) { const float u = 0.7978845608028654f * (x + 0.044715f * x * x * x); return 0.5f * x * (1.0f + tanhf(u)); }
__device__ __forceinline__ void p2_compress(Frame& F, const Args& A) {
    typedef short bf16x8_ __attribute__((ext_vector_type(8))); typedef float f32x16_ __attribute__((ext_vector_type(16)));
    LAS float* part = (LAS float*)F.lds;
    LAS float* hid = (LAS float*)(F.lds + 32768);
    const bf16* qkv = (const bf16*)(F.ws + WS_QKV); const bf16* W1T = (const bf16*)(F.ws + WS_W1T);
    const float* posb = (const float*)(F.ws + WS_POSB);
    const int lane = F.lane, r32 = lane & 31, hi = lane >> 5, cg = F.wave & 3, kh = F.wave >> 2;
    for (int tile = F.vcu; tile < 256; tile += F.G) {
        const int sel = tile >> 7, bkv = (tile >> 4) & 7, n0 = (tile & 15) * 32;
        const bf16* src = qkv + (sel ? pg8::E_VCMP : pg8::E_KCMP) + (size_t)bkv * SEQ * 64;
        const float* w2 = A.in[sel ? 9 : 7];
        const int nrow = min(n0 + r32, 510);
        const bf16* ap = src + (size_t)nrow * 1024 + kh * 1024 + 8 * hi;
        const bf16* bp = W1T + (size_t)sel * 262144 + (size_t)(32 * cg + r32) * 2048 + kh * 1024 + 8 * hi;
        f32x16_ acc;
#pragma unroll
        for (int r = 0; r < 16; ++r) acc[r] = 0.f;
#pragma unroll 8
        for (int kk = 0; kk < 64; ++kk) { const bf16x8_ a = *(const bf16x8_*)(ap + 16 * kk), bb = *(const bf16x8_*)(bp + 16 * kk);
            acc = __builtin_amdgcn_mfma_f32_32x32x16_bf16(a, bb, acc, 0, 0, 0); }
#pragma unroll
        for (int r = 0; r < 16; ++r) part[kh * 4096 + ((r & 3) + 8 * (r >> 2) + 4 * hi) * 128 + 32 * cg + r32] = acc[r];
        __syncthreads();
        for (int idx = F.tid; idx < 4096; idx += 512) { const float x = part[idx] + part[4096 + idx] + posb[sel * 128 + (idx & 127)]; hid[idx] = gelu_tanh(x); }
        __syncthreads();
        { const int row = F.tid >> 4, c0 = (F.tid & 15) * 4; float y0 = 0.f, y1 = 0.f, y2 = 0.f, y3 = 0.f;
          for (int jj = 0; jj < 128; ++jj) { const float hv = hid[row * 128 + jj]; const f32x4 wv = *(const f32x4*)(w2 + jj * 64 + c0); y0 = fmaf(hv, wv[0], y0); y1 = fmaf(hv, wv[1], y1); y2 = fmaf(hv, wv[2], y2); y3 = fmaf(hv, wv[3], y3); }
          bf16* dst = (bf16*)(F.ws + (sel ? WS_VC : WS_KC)) + ((size_t)bkv * 512 + n0 + row) * 64;
          if (sel) { v2u w; w.x = pk2(y0, y1); w.y = pk2(y2, y3); *(v2u*)(dst + c0) = w; }
          else { dst[rope_perm(c0)] = (bf16)f2bf(y0); dst[rope_perm(c0 + 1)] = (bf16)f2bf(y1); dst[rope_perm(c0 + 2)] = (bf16)f2bf(y2); dst[rope_perm(c0 + 3)] = (bf16)f2bf(y3); } }
        __syncthreads();
    }
    { const bf16* km = qkv + pg8::E_KM; float* kmean = (float*)(F.ws + WS_KMEAN);
      for (int it = F.vcu * NWAVES + F.wave; it < 1024; it += F.G * NWAVES) { const int bh = it >> 5, blk = it & 31; float s = 0.f;
          const bf16* p = km + ((size_t)bh * SEQ + blk * 256) * 64 + F.lane;
          for (int i = 0; i < 256; ++i) s += bf2f(p[(size_t)i * 64]);
          const float mean = s * (1.0f / 256.0f); kmean[(size_t)it * 64 + F.lane] = mean;
          const unsigned hb = f2bf(mean); const float hf = __builtin_bit_cast(float, hb << 16);
          ((bf16*)(F.ws + WS_KMH))[(size_t)it * 64 + F.lane] = (bf16)hb; ((bf16*)(F.ws + WS_KML))[(size_t)it * 64 + F.lane] = (bf16)f2bf(mean - hf); } }
}

__device__ __forceinline__ void ldrow(const bf16* p, unsigned (&r)[32]) {
#pragma unroll
    for (int i = 0; i < 8; ++i) { const v4u t = *(const v4u*)(p + 8 * i); r[4 * i] = t.x; r[4 * i + 1] = t.y; r[4 * i + 2] = t.z; r[4 * i + 3] = t.w; }
}
__device__ __forceinline__ float dot64(const unsigned (&q)[32], const unsigned (&k)[32]) {
    float s0 = 0.f, s1 = 0.f;
#pragma unroll
    for (int i = 0; i < 32; ++i) { s0 = fmaf(bflo(q[i]), bflo(k[i]), s0); s1 = fmaf(bfhi(q[i]), bfhi(k[i]), s1); }
    return s0 + s1;
}
__device__ __forceinline__ void osm_step(bool ok, float s, float& m, float& l, float (&o)[64], const unsigned (&v)[32]) {
    if (ok) {
        if (s > m) { const float f = __expf(m - s); l *= f;
#pragma unroll
            for (int i = 0; i < 64; ++i) o[i] *= f;
            m = s; }
        const float p = __expf(s - m); l += p;
#pragma unroll
        for (int i = 0; i < 32; ++i) { o[2 * i] = fmaf(p, bflo(v[i]), o[2 * i]); o[2 * i + 1] = fmaf(p, bfhi(v[i]), o[2 * i + 1]); }
    }
}

__device__ __forceinline__ void p3_nsa_naive(Frame& F, const Args& A, bf16* O) {
    LAS float* imp = (LAS float*)F.lds;
    const bf16* qkv = (const bf16*)(F.ws + WS_QKV);
    const float* gates = (const float*)(F.ws + WS_GATES);
    const bf16* KC = (const bf16*)(F.ws + WS_KC); const bf16* VC = (const bf16*)(F.ws + WS_VC);
    for (int item = F.vcu; item < 512; item += F.G) {
        const int b = item >> 7, kv = (item >> 6) & 1, qt = item & 63;
        const int ql = F.tid >> 2, g = F.tid & 3, t = qt * 128 + ql, h = kv * 4 + g, tok = b * SEQ + t;
        unsigned q[32]; ldrow(qkv + pg8::E_QA + ((size_t)(b * 8 + h) * SEQ + t) * 64, q);
        float o[64]; float* otp = (float*)(F.ws + WS_ABF) + (size_t)tok * 512 + h * 64;
        for (int i = F.tid; i < 128 * 129; i += 512) imp[i] = 0.f;
        __syncthreads();
        const float g0 = gates[(size_t)tok * 24 + h * 3 + 0], g1 = gates[(size_t)tok * 24 + h * 3 + 1], g2 = gates[(size_t)tok * 24 + h * 3 + 2];
        const int nvis = t >= 31 ? min((t - 31) / 16 + 1, 511) : 0;
        const int nbound = min((qt * 128 + 127 - 31) / 16 + 1, 511);
        const bf16* kcp = KC + (size_t)(b * 2 + kv) * 512 * 64; const bf16* vcp = VC + (size_t)(b * 2 + kv) * 512 * 64;
        float m = -1e30f, l = 0.f;
#pragma unroll
        for (int i = 0; i < 64; ++i) o[i] = 0.f;
        for (int n = 0; n < nbound; ++n) { unsigned kr[32]; ldrow(kcp + (size_t)n * 64, kr);
            const float s = dot64(q, kr) * NAIVE_SC; asm volatile("" ::: "memory"); ldrow(vcp + (size_t)n * 64, kr); osm_step(n < nvis, s, m, l, o, kr); }
        float linv = 1.0f / fmaxf(l, 1e-30f);
#pragma unroll
        for (int i = 0; i < 16; ++i) { f32x4 w; w[0] = g0 * linv * o[4 * i]; w[1] = g0 * linv * o[4 * i + 1]; w[2] = g0 * linv * o[4 * i + 2]; w[3] = g0 * linv * o[4 * i + 3]; *(f32x4*)(otp + 4 * i) = w; }
        { float acc = 0.f;
          for (int n = 0; n < nbound; ++n) { unsigned kr[32]; ldrow(kcp + (size_t)n * 64, kr);
              const float s = dot64(q, kr) * NAIVE_SC; float p = (n < nvis) ? __expf(s - m) * linv : 0.f;
              p += __shfl_xor(p, 1); p += __shfl_xor(p, 2); acc += p;
              if ((n & 3) == 3) { if (g == 0) imp[ql * 129 + (n >> 2)] = acc; acc = p; } } }
        __syncthreads();
        const int cur = t >> 6; unsigned m0 = 0u, m1 = 0u, m2 = 0u, m3 = 0u;
#define SETBIT(j) do { const unsigned _b = 1u << ((j) & 31); const int _w = (j) >> 5; m0 |= _w == 0 ? _b : 0u; m1 |= _w == 1 ? _b : 0u; m2 |= _w == 2 ? _b : 0u; m3 |= _w == 3 ? _b : 0u; } while (0)
        if (cur < 16) { m0 = (1u << (cur + 1)) - 1u; }
        else { SETBIT(0); SETBIT(cur - 1); SETBIT(cur);
            for (int r = 0; r < 13; ++r) { float best = -0.5f; int bj = 1;
                for (int j = 1; j <= cur - 2; ++j) { const float v = imp[ql * 129 + j]; if (v > best) { best = v; bj = j; } }
                imp[ql * 129 + bj] = -1.0f; SETBIT(bj); } }
        m = -1e30f; l = 0.f;
#pragma unroll
        for (int i = 0; i < 64; ++i) o[i] = 0.f;
        { const bf16* kb = qkv + pg8::E_KSLC + (size_t)(b * 2 + kv) * SEQ * 64; const bf16* vb = qkv + pg8::E_VSLC + (size_t)(b * 2 + kv) * SEQ * 64;
          for (int it = 0; it < 16; ++it) {
              const bool have = (m0 | m1 | m2 | m3) != 0u; int j = 0;
              if (m0) { j = __builtin_ctz(m0); m0 &= m0 - 1u; } else if (m1) { j = 32 + __builtin_ctz(m1); m1 &= m1 - 1u; }
              else if (m2) { j = 64 + __builtin_ctz(m2); m2 &= m2 - 1u; } else if (m3) { j = 96 + __builtin_ctz(m3); m3 &= m3 - 1u; }
              for (int kk = 0; kk < 64; ++kk) { const int row = j * 64 + kk; unsigned kr[32]; ldrow(kb + (size_t)row * 64, kr);
                  const float s = dot64(q, kr) * NAIVE_SC; asm volatile("" ::: "memory"); ldrow(vb + (size_t)row * 64, kr); osm_step(have && row <= t, s, m, l, o, kr); } } }
        linv = 1.0f / fmaxf(l, 1e-30f);
#pragma unroll
        for (int i = 0; i < 16; ++i) { f32x4 w = *(const f32x4*)(otp + 4 * i); w[0] = fmaf(g1 * linv, o[4 * i], w[0]); w[1] = fmaf(g1 * linv, o[4 * i + 1], w[1]); w[2] = fmaf(g1 * linv, o[4 * i + 2], w[2]); w[3] = fmaf(g1 * linv, o[4 * i + 3], w[3]); *(f32x4*)(otp + 4 * i) = w; }
        m = -1e30f; l = 0.f;
#pragma unroll
        for (int i = 0; i < 64; ++i) o[i] = 0.f;
        { const bf16* kb = qkv + pg8::E_KWIN + (size_t)(b * 2 + kv) * SEQ * 64; const bf16* vb = qkv + pg8::E_VWIN + (size_t)(b * 2 + kv) * SEQ * 64;
          const int shi = qt * 128 + 127, slo = max(qt * 128 - 511, 0);
          for (int s_ = shi; s_ >= slo; --s_) { unsigned kr[32]; ldrow(kb + (size_t)s_ * 64, kr);
              const float s = dot64(q, kr) * NAIVE_SC; asm volatile("" ::: "memory"); ldrow(vb + (size_t)s_ * 64, kr); osm_step(s_ <= t && s_ > t - 512, s, m, l, o, kr); } }
        linv = 1.0f / fmaxf(l, 1e-30f);
        { bf16* op = O + (size_t)tok * 1024 + h * 64;
#pragma unroll
          for (int i = 0; i < 8; ++i) { const f32x4 a0 = *(const f32x4*)(otp + 8 * i), a1 = *(const f32x4*)(otp + 8 * i + 4); const float gl = g2 * linv; v4u w;
              w.x = pk2(fmaf(gl, o[8 * i], a0[0]), fmaf(gl, o[8 * i + 1], a0[1])); w.y = pk2(fmaf(gl, o[8 * i + 2], a0[2]), fmaf(gl, o[8 * i + 3], a0[3]));
              w.z = pk2(fmaf(gl, o[8 * i + 4], a1[0]), fmaf(gl, o[8 * i + 5], a1[1])); w.w = pk2(fmaf(gl, o[8 * i + 6], a1[2]), fmaf(gl, o[8 * i + 7], a1[3])); *(v4u*)(op + 8 * i) = w; } }
        __syncthreads();
    }
}

__device__ __forceinline__ void p3_moba_naive(Frame& F, const Args& A, bf16* O) {
    const bf16* qkv = (const bf16*)(F.ws + WS_QKV);
    const float* kmean = (const float*)(F.ws + WS_KMEAN);
    for (int item = F.vcu; item < 512; item += F.G) {
        const int bh = item >> 4, tile = item & 15, b = bh >> 3, h = bh & 7, t = tile * 512 + F.tid, tok = b * SEQ + t, cur = t >> 8;
        unsigned q[32]; ldrow(qkv + pg8::E_QM + ((size_t)bh * SEQ + t) * 64, q);
        float v0 = -3e38f, v1 = -3e38f, v2 = -3e38f; int i0 = -1, i1 = -1, i2 = -1;
        for (int n = 0; n < cur; ++n) { const float* kmp = kmean + ((size_t)bh * 32 + n) * 64; float gs = 0.f;
#pragma unroll
            for (int i = 0; i < 32; ++i) { gs = fmaf(bflo(q[i]), kmp[2 * i], gs); gs = fmaf(bfhi(q[i]), kmp[2 * i + 1], gs); }
            if (gs > v0) { v2 = v1; i2 = i1; v1 = v0; i1 = i0; v0 = gs; i0 = n; } else if (gs > v1) { v2 = v1; i2 = i1; v1 = gs; i1 = n; } else if (gs > v2) { v2 = gs; i2 = n; } }
        float o[64], m = -1e30f, l = 0.f;
#pragma unroll
        for (int i = 0; i < 64; ++i) o[i] = 0.f;
        const bf16* kb = qkv + pg8::E_KM + (size_t)bh * SEQ * 64; const bf16* vb = qkv + pg8::E_VM + (size_t)bh * SEQ * 64;
        for (int si = 0; si < 3; ++si) { const int j = si == 0 ? i0 : (si == 1 ? i1 : i2); const bool have = j >= 0; const int jj = have ? j : 0;
            for (int kk = 0; kk < 256; ++kk) { const int row = jj * 256 + kk; unsigned kr[32], vr[32]; ldrow(kb + (size_t)row * 64, kr); ldrow(vb + (size_t)row * 64, vr);
                const float s = dot64(q, kr) * NAIVE_SC; osm_step(have, s, m, l, o, vr); } }
        { const int r0 = (tile * 512 + (F.tid & ~63)) & ~255, r1 = tile * 512 + (F.tid | 63);
          for (int row = r0; row <= r1; ++row) { unsigned kr[32], vr[32]; ldrow(kb + (size_t)row * 64, kr); ldrow(vb + (size_t)row * 64, vr);
              const float s = dot64(q, kr) * NAIVE_SC; osm_step(row <= t, s, m, l, o, vr); } }
        const float linv = 1.0f / fmaxf(l, 1e-30f);
        { bf16* op = O + (size_t)tok * 1024 + 512 + h * 64;
#pragma unroll
          for (int i = 0; i < 8; ++i) { v4u w; w.x = pk2(o[8 * i] * linv, o[8 * i + 1] * linv); w.y = pk2(o[8 * i + 2] * linv, o[8 * i + 3] * linv); w.z = pk2(o[8 * i + 4] * linv, o[8 * i + 5] * linv); w.w = pk2(o[8 * i + 6] * linv, o[8 * i + 7] * linv); *(v4u*)(op + 8 * i) = w; } }
    }
}

__device__ __forceinline__ void p11_sb_naive(Frame& F, const Args& A) {
    const bf16* qkv = (const bf16*)(F.ws + WS_QKV);
    bf16* O = (bf16*)(F.ws + WS_O);
    for (int item = F.vcu; item < 1024; item += F.G) {
        const int bh = item >> 4, tile = item & 15, b = bh >> 4, h = bh & 15, t = tile * 512 + F.tid, tok = b * SEQ + t;
        unsigned q[32]; ldrow(qkv + ((size_t)bh * SEQ + t) * 64, q);
        const bf16* kb = qkv + (size_t)33554432 + (size_t)bh * SEQ * 64; const bf16* vb = qkv + (size_t)67108864 + (size_t)bh * SEQ * 64;
        float o[64], C = 0.f;
#pragma unroll
        for (int i = 0; i < 64; ++i) o[i] = 0.f;
        for (int s_ = tile * 512 + (F.tid | 63) - 1; s_ >= 0; --s_) {
            if (!__any(C > -120.f)) break;
            unsigned kr[32], vr[32]; ldrow(kb + (size_t)s_ * 64, kr); ldrow(vb + (size_t)s_ * 64, vr);
            const float z = dot64(q, kr) * NAIVE_SC, sp = fmaxf(z, 0.f) + __logf(1.0f + __expf(-fabsf(z)));
            if (s_ < t && C > -120.f) { const float w = __expf(z - sp + C); C -= sp;
#pragma unroll
                for (int i = 0; i < 32; ++i) { o[2 * i] = fmaf(w, bflo(vr[i]), o[2 * i]); o[2 * i + 1] = fmaf(w, bfhi(vr[i]), o[2 * i + 1]); } } }
        { bf16* op = O + (size_t)tok * 1024 + h * 64;
#pragma unroll
          for (int i = 0; i < 8; ++i) { v4u w; w.x = pk2(o[8 * i], o[8 * i + 1]); w.y = pk2(o[8 * i + 2], o[8 * i + 3]); w.z = pk2(o[8 * i + 4], o[8 * i + 5]); w.w = pk2(o[8 * i + 6], o[8 * i + 7]); *(v4u*)(op + 8 * i) = w; } }
    }
}

template <bool ROUTE, bool WBF>
__device__ __forceinline__ void ln_phase(Frame& F, const Args& A, int layer, const float* gain, const float* bias, float* R, bf16* obf) {
    const int gw = F.vcu * NWAVES + F.wave, NGW = F.G * NWAVES;
    LAS float* WR = (LAS float*)F.lds;
    if (ROUTE) {
        const float* wg = A.in[16] + (size_t)layer * 1024 * 4; const float* wrt = A.in[18] + (size_t)layer * 4 * 1024 * 4;
        for (int i = F.tid; i < 20 * 1024; i += 512) { const int c = i >> 10, k = i & 1023; WR[i] = c < 4 ? wg[k * 4 + c] : wrt[(size_t)((c - 4) >> 2) * 4096 + k * 4 + ((c - 4) & 3)]; }
        int* rowmap = (int*)(F.ws + WS_ROWMAP);
        for (int i = F.vcu * 512 + F.tid; i < MAXROWS; i += F.G * 512) rowmap[i] = -1;
        __syncthreads();
    }
    f32x4 gn[4], bs[4];
#pragma unroll
    for (int j = 0; j < 4; ++j) { gn[j] = *(const f32x4*)(gain + 4 * F.lane + 256 * j); bs[j] = *(const f32x4*)(bias + 4 * F.lane + 256 * j); }
    for (int mrow = gw; mrow < NTOK; mrow += NGW) {
        float* xr = R + (size_t)mrow * DM + 4 * F.lane;
        f32x4 v[4]; float s = 0.f;
#pragma unroll
        for (int j = 0; j < 4; ++j) { v[j] = *(const f32x4*)(xr + 256 * j); s += (v[j][0] + v[j][1]) + (v[j][2] + v[j][3]); }
        const float mean = wave_sum(s) * (1.f / DM); float s2 = 0.f;
#pragma unroll
        for (int j = 0; j < 4; ++j) { v[j] = v[j] - mean; s2 += (v[j][0] * v[j][0] + v[j][1] * v[j][1]) + (v[j][2] * v[j][2] + v[j][3] * v[j][3]); }
        const float rstd = 1.f / sqrtf(wave_sum(s2) * (1.f / DM) + LN_EPS);
#pragma unroll
        for (int j = 0; j < 4; ++j) { v[j] = v[j] * rstd * gn[j] + bs[j]; *(f32x4*)(xr + 256 * j) = v[j]; }
        if (WBF) { bf16* orow = obf + (size_t)mrow * DM + 4 * F.lane;
#pragma unroll
            for (int j = 0; j < 4; ++j) { v2u w; w.x = pk2(v[j][0], v[j][1]); w.y = pk2(v[j][2], v[j][3]); *(v2u*)(orow + 256 * j) = w; } }
        if (ROUTE) {
            float lg[4];
#pragma unroll
            for (int c = 0; c < 4; ++c) { float p = 0.f;
#pragma unroll
                for (int j = 0; j < 4; ++j) { const f32x4 w = *(const LAS f32x4*)(WR + c * 1024 + 4 * F.lane + 256 * j); p += (v[j][0] * w[0] + v[j][1] * w[1]) + (v[j][2] * w[2] + v[j][3] * w[3]); }
                lg[c] = wave_sum(p) + A.in[17][layer * 4 + c]; }
            int g = 0; float gm = lg[0];
#pragma unroll
            for (int c = 1; c < 4; ++c) if (lg[c] > gm) { gm = lg[c]; g = c; }
            const float wgp = 1.0f / ((__expf(lg[0] - gm) + __expf(lg[1] - gm)) + (__expf(lg[2] - gm) + __expf(lg[3] - gm)));
            float le[4];
#pragma unroll
            for (int e = 0; e < 4; ++e) { float p = 0.f;
#pragma unroll
                for (int j = 0; j < 4; ++j) { const f32x4 w = *(const LAS f32x4*)(WR + (4 + g * 4 + e) * 1024 + 4 * F.lane + 256 * j); p += (v[j][0] * w[0] + v[j][1] * w[1]) + (v[j][2] * w[2] + v[j][3] * w[3]); }
                le[e] = wave_sum(p) + A.in[19][layer * 16 + g * 4 + e]; }
            int i1 = 0; float e1 = le[0];
#pragma unroll
            for (int e = 1; e < 4; ++e) if (le[e] > e1) { e1 = le[e]; i1 = e; }
            int i2 = -1; float e2 = -3e38f;
#pragma unroll
            for (int e = 0; e < 4; ++e) if (e != i1 && le[e] > e2) { e2 = le[e]; i2 = e; }
            const float w1 = 1.0f / (1.0f + __expf(e2 - e1)), w2 = 1.0f - w1;
            const int lo = min(i1, i2), hi = max(i1, i2), pi = lo == 0 ? hi - 1 : (lo == 1 ? hi + 1 : 5), bkt = g * 6 + pi;
            const float wlo = (i1 < i2 ? w1 : w2) * wgp, whi = (i1 < i2 ? w2 : w1) * wgp;
            if (F.lane == 0) { f32x4 ti; ti[0] = __builtin_bit_cast(float, bkt); ti[1] = 0.f; ti[2] = wlo; ti[3] = whi; *(f32x4*)(F.ws + WS_TOKI + (size_t)mrow * 16) = ti; }
        }
    }
}
__device__ __forceinline__ int build_ptab(Frame& F, int tok_lo) {
    LAS int* ptab = (LAS int*)(F.lds + PTAB_OFF); LAS int* pstart = (LAS int*)(F.lds + PTAB_OFF + 1024);
    LAS int* cnt = (LAS int*)(F.lds + PTAB_OFF + 1280); LAS int* lt = (LAS int*)(F.lds + PTAB_OFF + 1408);
    __syncthreads();
    if (F.tid < 24) { cnt[F.tid] = 0; lt[F.tid] = 0; }
    __syncthreads();
    for (int tk = F.tid; tk < NTOK; tk += 512) { const int bkt = *(const int*)(F.ws + WS_TOKI + (size_t)tk * 16);
        __hip_atomic_fetch_add(cnt + bkt, 1, __ATOMIC_RELAXED, __HIP_MEMORY_SCOPE_WORKGROUP); if (tk < tok_lo) __hip_atomic_fetch_add(lt + bkt, 1, __ATOMIC_RELAXED, __HIP_MEMORY_SCOPE_WORKGROUP); }
    __syncthreads();
    if (F.tid == 0) { int p = 0;
        for (int bkt = 0; bkt < 24; ++bkt) { const int np = (cnt[bkt] + 255) >> 8;
            pstart[bkt] = p; for (int i = 0; i < np && p < MAXPAN; ++i) ptab[p++] = bkt; }
        pstart[24] = p; }
    __syncthreads();
    return pstart[24];
}
__device__ __forceinline__ void scatter_phase(Frame& F, const float* R) {
    const int TPW = (NTOK + F.G - 1) / F.G, tok_lo = F.vcu * TPW;
    build_ptab(F, tok_lo);
    LAS int* pstart = (LAS int*)(F.lds + PTAB_OFF + 1024); LAS int* lt = (LAS int*)(F.lds + PTAB_OFF + 1408);
    LAS int* dstl = (LAS int*)F.lds;
    LAS int* bkl = (LAS int*)(F.lds + 4096);
    for (int i = F.tid; i < TPW && tok_lo + i < NTOK; i += 512) bkl[i] = *(const int*)(F.ws + WS_TOKI + (size_t)(tok_lo + i) * 16);
    __syncthreads();
    if (F.tid == 0) { for (int i = 0; i < TPW && tok_lo + i < NTOK; ++i) { const int bkt = bkl[i]; dstl[i] = pstart[bkt] * 256 + lt[bkt]; lt[bkt] = lt[bkt] + 1; } }
    __syncthreads();
    int* rowmap = (int*)(F.ws + WS_ROWMAP); float* wrow = (float*)(F.ws + WS_WROW);
    for (int i = F.tid; i < TPW && tok_lo + i < NTOK; i += 512) {
        const int mrow = tok_lo + i, dst = dstl[i];
        const f32x4 ti = *(const f32x4*)(F.ws + WS_TOKI + (size_t)mrow * 16);
        rowmap[dst] = mrow; wrow[(size_t)dst * 2] = ti[2]; wrow[(size_t)dst * 2 + 1] = ti[3];
    }
    __syncthreads();
}
struct MoeOrder1 {
    static constexpr bool GATHER = true;
    int G, c, nunits; const LAS int* ptab; const bf16* W1E; const int* rowmap;
    __device__ __forceinline__ int arow(const pg8::Unit& u, int r) const { const int t = rowmap[u.pm * 256 + r]; return t < 0 ? 0 : t; }
    __device__ __forceinline__ bool next(int i, pg8::Unit& u) const { const int L = i * G + c; if (L >= nunits) return false; u.pm = L >> 2; u.pn = L & 3; u.aux = __builtin_amdgcn_readfirstlane(ptab[u.pm]); return true; }
    __device__ __forceinline__ const char* aptr(const pg8::Gemm& g, const pg8::Unit& u, size_t tstep) const { return (const char*)g.A + (size_t)u.pm * tstep; }
    __device__ __forceinline__ const char* bptr(const pg8::Gemm& g, const pg8::Unit& u, size_t tstep) const {
        const int grp = u.aux / 6; int lo, hi; bucket_pair(u.aux % 6, lo, hi); const int e = grp * 4 + ((u.pn >> 1) ? hi : lo);
        return (const char*)(W1E + ((size_t)e * 512 + (size_t)(u.pn & 1) * 256) * 1024); }
    __device__ __forceinline__ void a_ready(const pg8::Unit&) const {}
    __device__ __forceinline__ void done(const pg8::Unit&) const {}
};
struct MoeOrder2 {
    static constexpr bool GATHER = false;
    __device__ __forceinline__ int arow(const pg8::Unit&, int) const { return 0; }
    int G, c, nunits; const LAS int* ptab; const bf16* B2;
    __device__ __forceinline__ bool next(int i, pg8::Unit& u) const { const int L = i * G + c; if (L >= nunits) return false; u.pm = L >> 2; u.pn = L & 3; u.aux = __builtin_amdgcn_readfirstlane(ptab[u.pm]); return true; }
    __device__ __forceinline__ const char* aptr(const pg8::Gemm& g, const pg8::Unit& u, size_t tstep) const { return (const char*)g.A + (size_t)u.pm * tstep; }
    __device__ __forceinline__ const char* bptr(const pg8::Gemm& g, const pg8::Unit& u, size_t tstep) const { return (const char*)(B2 + ((size_t)u.aux * 1024 + (size_t)u.pn * 256) * 512); }
    __device__ __forceinline__ void a_ready(const pg8::Unit&) const {}
    __device__ __forceinline__ void done(const pg8::Unit&) const {}
};

#define KOFF(i) (32 * ((i) >> 4) + 8 * (((i) & 15) >> 2) + ((i) & 3))
typedef short bf16x8 __attribute__((ext_vector_type(8)));
typedef short s16x4 __attribute__((ext_vector_type(4)));
typedef float f32x16 __attribute__((ext_vector_type(16)));
#define MFMA32(a, b, c) __builtin_amdgcn_mfma_f32_32x32x16_bf16(a, b, c, 0, 0, 0)
#ifndef SB_EXIT
#define SB_EXIT 1
#endif
constexpr float L2E = 1.4426950408889634f, LN2 = 0.6931471805599453f;
__device__ __forceinline__ int crow(int r, int hi) { return (r & 3) + 8 * (r >> 2) + 4 * hi; }
typedef __bf16 bf16x2_t __attribute__((ext_vector_type(2)));
__device__ __forceinline__ unsigned cvtpk(float lo, float hi) { bf16x2_t v; v[0] = (__bf16)lo; v[1] = (__bf16)hi; return __builtin_bit_cast(unsigned, v); }
__device__ __forceinline__ void swap32(float v, float& r0, float& r1) { unsigned a = __builtin_bit_cast(unsigned, v), b = a;
    asm volatile("v_nop\n\tv_nop\n\tv_permlane32_swap_b32 %0, %1" : "+v"(a), "+v"(b)); r0 = __builtin_bit_cast(float, a); r1 = __builtin_bit_cast(float, b); }
__device__ __forceinline__ float swap_sum(float v) { float r0, r1; swap32(v, r0, r1); return r0 + r1; }
__device__ __forceinline__ float swap_max(float v) { float r0, r1; swap32(v, r0, r1); return fmaxf(r0, r1); }
__device__ __forceinline__ float swap_other(float v, int hi) { float r0, r1; swap32(v, r0, r1); return hi ? r0 : r1; }
__device__ __forceinline__ void kv_issue(const bf16* Kt, const bf16* Vt, int wave, int lane, v4u& kr, v4u& vr) {
    kr = *(const v4u*)(Kt + (size_t)lane * 64 + wave * 8);
    vr = *(const v4u*)(Vt + (size_t)(16 * (wave & 3) + (lane >> 2)) * 64 + (wave >> 2) * 32 + (lane & 3) * 8);
}
__device__ __forceinline__ void kv_commit(LAS unsigned char* kbuf, LAS unsigned char* vbuf, int wave, int lane, const v4u& kr, const v4u& vr) {
    *(LAS v4u*)(kbuf + wave * 1024 + lane * 16) = kr; *(LAS v4u*)(vbuf + wave * 1024 + lane * 16) = vr;
}
__device__ __forceinline__ void qk_tile(const LAS unsigned char* kbuf, const bf16x8 (&qr)[4], int r32, int hi, f32x16& p0, f32x16& p1) {
#pragma unroll
    for (int r = 0; r < 16; ++r) { p0[r] = 0.f; p1[r] = 0.f; }
#pragma unroll
    for (int d0 = 0; d0 < 4; ++d0) { const LAS unsigned char* kp = kbuf + (2 * d0 + hi) * 1024 + r32 * 16;
        const bf16x8 k0 = *(const LAS bf16x8*)kp, k1 = *(const LAS bf16x8*)(kp + 512);
        p0 = MFMA32(k0, qr[d0], p0); p1 = MFMA32(k1, qr[d0], p1); }
}
__device__ __forceinline__ s16x4 vtr(const LAS unsigned char* p) { return __builtin_bit_cast(s16x4, __builtin_amdgcn_ds_read_tr16_b64_v4i16((LAS s16x4*)p)); }
__device__ __forceinline__ void pv_tile(const LAS unsigned char* vbuf, const f32x16& p0, const f32x16& p1, f32x16 (&o)[2], int lane, int hi) {
    const LAS unsigned char* vp0 = vbuf + ((lane >> 4) & 1) * 32 + (lane & 3) * 8 + (4 * hi + ((lane & 15) >> 2)) * 64;
#pragma unroll
    for (int s = 0; s < 4; ++s) { const int rb = 8 * (s & 1); v4u w;
        if (s < 2) { w.x = cvtpk(p0[rb], p0[rb + 1]); w.y = cvtpk(p0[rb + 2], p0[rb + 3]); w.z = cvtpk(p0[rb + 4], p0[rb + 5]); w.w = cvtpk(p0[rb + 6], p0[rb + 7]); }
        else       { w.x = cvtpk(p1[rb], p1[rb + 1]); w.y = cvtpk(p1[rb + 2], p1[rb + 3]); w.z = cvtpk(p1[rb + 4], p1[rb + 5]); w.w = cvtpk(p1[rb + 6], p1[rb + 7]); }
        const bf16x8 pb = __builtin_bit_cast(bf16x8, w);
#pragma unroll
        for (int dh = 0; dh < 2; ++dh) {
#ifdef DBG_SAFE_TR
            bf16x8 a;
#pragma unroll
            for (int j = 0; j < 8; ++j) { const int key = 16 * s + 8 * (j >> 2) + 4 * hi + (j & 3); a[j] = *(const LAS short*)(vbuf + dh * 4096 + key * 64 + (lane & 31) * 2); }
#else
            const s16x4 lo = vtr(vp0 + dh * 4096 + s * 1024), hi4 = vtr(vp0 + dh * 4096 + s * 1024 + 512);
            bf16x8 a; a[0] = lo[0]; a[1] = lo[1]; a[2] = lo[2]; a[3] = lo[3]; a[4] = hi4[0]; a[5] = hi4[1]; a[6] = hi4[2]; a[7] = hi4[3];
#endif
            o[dh] = MFMA32(a, pb, o[dh]); }
        __builtin_amdgcn_sched_barrier(0); }
}
__device__ __forceinline__ void store_o(bf16* orow, const f32x16 (&o)[2], int hi, float sc) {
#pragma unroll
    for (int dh = 0; dh < 2; ++dh)
#pragma unroll
        for (int g = 0; g < 4; ++g) { v2u w; w.x = pk2(o[dh][4 * g] * sc, o[dh][4 * g + 1] * sc); w.y = pk2(o[dh][4 * g + 2] * sc, o[dh][4 * g + 3] * sc);
            *(v2u*)(orow + 32 * dh + 8 * g + 4 * hi) = w; }
}

__device__ __forceinline__ void sb_process(f32x16& p0, f32x16& p1, int thr, int hi, float& A) {
    float sp[32], T[8];
#pragma unroll
    for (int i = 0; i < 32; ++i) { const float z = i < 16 ? p0[i] : p1[i - 16];
        const float e = __builtin_amdgcn_exp2f(-fabsf(z)), spv = fmaxf(z, 0.f) + __builtin_amdgcn_logf(1.0f + e);
        const bool valid = KOFF(i) < thr; sp[i] = valid ? spv : 0.f; const float zz = valid ? (z - spv) : -1e30f;
        if (i < 16) p0[i] = zz; else p1[i - 16] = zz; }
#pragma unroll
    for (int u = 0; u < 8; ++u) T[u] = (sp[4 * u] + sp[4 * u + 1]) + (sp[4 * u + 2] + sp[4 * u + 3]);
    float after = A;
#pragma unroll
    for (int u = 7; u >= 0; --u) { const float pt = swap_sum(T[u]); const float hb = after + (hi ? 0.f : (pt - T[u]));
        float inrun = 0.f;
#pragma unroll
        for (int e = 3; e >= 0; --e) { const int i = 4 * u + e; const float zz = i < 16 ? p0[i] : p1[i - 16];
            const float w = __builtin_amdgcn_exp2f(zz - hb - inrun); if (i < 16) p0[i] = w; else p1[i - 16] = w; inrun += sp[i]; }
        after += pt; }
    A = after;
}
__device__ __forceinline__ void p11_sb_mfma(Frame& F) {
    const bf16* Qg = (const bf16*)(F.ws + WS_QKV); const bf16* Kg = Qg + (size_t)33554432; const bf16* Vg = Qg + (size_t)67108864;
    bf16* O = (bf16*)(F.ws + WS_O);
    LAS unsigned char* L = F.lds; volatile LAS unsigned* flag = (volatile LAS unsigned*)(F.lds + 32768);
    const int lane = F.lane, r32 = lane & 31, hi = lane >> 5, w = F.wave;
    for (int unit = F.vcu; unit < 2048; unit += F.G) {
        const int bh = unit >> 5, qb = unit & 31, b = bh >> 4, h = bh & 15, Q0 = qb * 256, tq = Q0 + 32 * w + r32;
        const bf16* Kh = Kg + (size_t)bh * SEQ * 64; const bf16* Vh = Vg + (size_t)bh * SEQ * 64;
        bf16x8 qr[4];
#pragma unroll
        for (int d0 = 0; d0 < 4; ++d0) qr[d0] = *(const bf16x8*)(Qg + ((size_t)bh * SEQ + tq) * 64 + 16 * d0 + 8 * hi);
        f32x16 o[2];
#pragma unroll
        for (int r = 0; r < 16; ++r) { o[0][r] = 0.f; o[1][r] = 0.f; }
        float A = 0.f; const int kt_top = (Q0 >> 6) + 3, my_top = (Q0 >> 6) + (w >> 1);
        bool done = false;
        if (F.tid == 0) { flag[0] = 0u; flag[1] = 0u; flag[2] = 0u; }
        { v4u kr, vr; kv_issue(Kh + (size_t)kt_top * 4096, Vh + (size_t)kt_top * 4096, w, lane, kr, vr); kv_commit(L, L + 16384, w, lane, kr, vr); }
        __syncthreads();
        for (int i = 0, kt = kt_top; kt >= 0; ++i, --kt) {
            const int cb = i & 1; v4u kr, vr;
            if (kt > 0) kv_issue(Kh + (size_t)(kt - 1) * 4096, Vh + (size_t)(kt - 1) * 4096, w, lane, kr, vr);
            if (!done && kt <= my_top) {
                f32x16 p0, p1; qk_tile(L + cb * 8192, qr, r32, hi, p0, p1);
                sb_process(p0, p1, tq - 64 * kt - 4 * hi, hi, A);
                pv_tile(L + 16384 + cb * 8192, p0, p1, o, lane, hi);
                if (SB_EXIT && __all(A > 174.f)) done = true;
            }
            const int fi = i % 3; if (F.tid == 0) flag[(i + 1) % 3] = 0u;
            if (done && lane == 0) __hip_atomic_fetch_or((LAS unsigned*)(F.lds + 32768) + fi, 1u << w, __ATOMIC_RELAXED, __HIP_MEMORY_SCOPE_WORKGROUP);
            if (kt > 0) kv_commit(L + (cb ^ 1) * 8192, L + 16384 + (cb ^ 1) * 8192, w, lane, kr, vr);
            __syncthreads();
            if (flag[fi] == 0xFFu) break;
        }
        store_o(O + (size_t)(b * SEQ + tq) * 1024 + h * 64, o, hi, 1.0f);
        __syncthreads();
    }
}

struct TileMask { int lo, hi_; bool on; };
__device__ __forceinline__ void sm_process(f32x16& p0, f32x16& p1, float& m, float& l, f32x16 (&o)[2], const TileMask tm) {
    float mx = -1e30f;
    if (__all(tm.on && tm.lo < 0 && tm.hi_ >= 63)) {
#pragma unroll
        for (int i = 0; i < 32; ++i) { const float x = i < 16 ? p0[i] : p1[i - 16]; mx = fmaxf(mx, x); }
    } else {
        const int lo = tm.on ? tm.lo : 1000, hi_ = tm.hi_;
#pragma unroll
        for (int i = 0; i < 32; ++i) { const float s = i < 16 ? p0[i] : p1[i - 16]; const float x = (KOFF(i) > lo && KOFF(i) <= hi_) ? s : -INFINITY; if (i < 16) p0[i] = x; else p1[i - 16] = x; mx = fmaxf(mx, x); }
    }
    mx = swap_max(mx);
    const float mnew = fmaxf(m, mx), alpha = __builtin_amdgcn_exp2f(m - mnew);
    float ls = 0.f;
#pragma unroll
    for (int i = 0; i < 32; ++i) { const float x = i < 16 ? p0[i] : p1[i - 16]; const float pv = __builtin_amdgcn_exp2f(x - mnew); if (i < 16) p0[i] = pv; else p1[i - 16] = pv; ls += pv; }
    l = l * alpha + ls; m = mnew;
    if (!__all(alpha == 1.0f)) {
#pragma unroll
        for (int r = 0; r < 16; ++r) { o[0][r] *= alpha; o[1][r] *= alpha; } }
}
template <class Act, class Mask>
__device__ __forceinline__ void sm_stream(Frame& F, const bf16* Kh, const bf16* Vh, int t0, int t1, const bf16x8 (&qr)[4], float& m, float& l, f32x16 (&o)[2], Act act, Mask mask) {
    if (t0 >= t1) return;
    LAS unsigned char* L = F.lds; const int lane = F.lane, r32 = lane & 31, hi = lane >> 5, w = F.wave;
    { v4u kr, vr; kv_issue(Kh + (size_t)t0 * 4096, Vh + (size_t)t0 * 4096, w, lane, kr, vr); kv_commit(L, L + 16384, w, lane, kr, vr); }
    __syncthreads();
    for (int t = t0; t < t1; ++t) {
        const int cb = (t - t0) & 1; v4u kr, vr;
        if (t + 1 < t1) kv_issue(Kh + (size_t)(t + 1) * 4096, Vh + (size_t)(t + 1) * 4096, w, lane, kr, vr);
        if (act(t)) { f32x16 p0, p1; qk_tile(L + cb * 8192, qr, r32, hi, p0, p1);
            __builtin_amdgcn_sched_barrier(0);
            sm_process(p0, p1, m, l, o, mask(t));
            __builtin_amdgcn_sched_barrier(0);
            pv_tile(L + 16384 + cb * 8192, p0, p1, o, lane, hi); }
        if (t + 1 < t1) kv_commit(L + (cb ^ 1) * 8192, L + 16384 + (cb ^ 1) * 8192, w, lane, kr, vr);
        __syncthreads();
    }
}

constexpr size_t MB_CNT = 0, MB_SELP = 1 * MiB, MB_SEG = 2 * MiB;
constexpr size_t MB_PARTO = 0, MB_PARTML = 96 * MiB;
__device__ __forceinline__ bool better(float va, int ia, float vb, int ib) { return va > vb || (va == vb && ia < ib); }
__device__ __forceinline__ void top3_insert(float gv, int n, float& v0, int& i0, float& v1, int& i1, float& v2, int& i2) {
    const bool b0 = better(gv, n, v0, i0), b1 = better(gv, n, v1, i1), b2 = better(gv, n, v2, i2);
    const float nv2 = b1 ? v1 : (b2 ? gv : v2), nv1 = b0 ? v0 : (b1 ? gv : v1), nv0 = b0 ? gv : v0;
    const int ni2 = b1 ? i1 : (b2 ? n : i2), ni1 = b0 ? i0 : (b1 ? n : i1), ni0 = b0 ? n : i0;
    v0 = nv0; v1 = nv1; v2 = nv2; i0 = ni0; i1 = ni1; i2 = ni2;
}
__device__ __forceinline__ void moba_gate(Frame& F) {
    const bf16* qkv = (const bf16*)(F.ws + WS_QKV);
    const bf16* KMH = (const bf16*)(F.ws + WS_KMH); const bf16* KML = (const bf16*)(F.ws + WS_KML);
    int* cnt = (int*)(F.ws + WS_ABF + MB_CNT); unsigned* selp = (unsigned*)(F.ws + WS_ABF + MB_SELP); unsigned short* seg = (unsigned short*)(F.ws + WS_ABF + MB_SEG);
    LAS int* wc = (LAS int*)F.lds;
    const int lane = F.lane, r32 = lane & 31, hi = lane >> 5, w = F.wave;
    for (int it = 0; it < 4; ++it) {
        const int u = it * F.G + F.vcu; if (u >= 1024) break;
        const int bh = u >> 5, cur = u & 31, tq = cur * 256 + 32 * w + r32;
        bf16x8 qr[4];
#pragma unroll
        for (int d0 = 0; d0 < 4; ++d0) qr[d0] = *(const bf16x8*)(qkv + pg8::E_QM + ((size_t)bh * SEQ + tq) * 64 + 16 * d0 + 8 * hi);
        f32x16 gt;
#pragma unroll
        for (int r = 0; r < 16; ++r) gt[r] = 0.f;
#pragma unroll
        for (int d0 = 0; d0 < 4; ++d0) { const bf16x8 kh = *(const bf16x8*)(KMH + ((size_t)bh * 32 + r32) * 64 + 16 * d0 + 8 * hi), kl = *(const bf16x8*)(KML + ((size_t)bh * 32 + r32) * 64 + 16 * d0 + 8 * hi);
            gt = MFMA32(kh, qr[d0], gt); gt = MFMA32(kl, qr[d0], gt); }
        float v0 = -INFINITY, v1 = -INFINITY, v2 = -INFINITY; int i0 = 99, i1 = 99, i2 = 99;
#pragma unroll
        for (int r = 0; r < 16; ++r) { const int n = crow(r, hi); const float gv = n < cur ? gt[r] : -INFINITY; top3_insert(gv, n, v0, i0, v1, i1, v2, i2); }
        const float pv0 = swap_other(v0, hi), pv1 = swap_other(v1, hi), pv2 = swap_other(v2, hi);
        const int pi0 = __builtin_bit_cast(int, swap_other(__builtin_bit_cast(float, i0), hi)), pi1 = __builtin_bit_cast(int, swap_other(__builtin_bit_cast(float, i1), hi)), pi2 = __builtin_bit_cast(int, swap_other(__builtin_bit_cast(float, i2), hi));
        top3_insert(pv0, pi0, v0, i0, v1, i1, v2, i2); top3_insert(pv1, pi1, v0, i0, v1, i1, v2, i2); top3_insert(pv2, pi2, v0, i0, v1, i1, v2, i2);
        const int s0 = (i0 < 32 && v0 > -INFINITY) ? i0 : 255, s1 = (i1 < 32 && v1 > -INFINITY) ? i1 : 255, s2 = (i2 < 32 && v2 > -INFINITY) ? i2 : 255;
        if (hi == 0) selp[(size_t)bh * SEQ + tq] = (unsigned)s0 | ((unsigned)s1 << 8) | ((unsigned)s2 << 16);
        for (int j = 0; j < cur; ++j) { const bool sel = (hi == 0) && (s0 == j || s1 == j || s2 == j); const unsigned long long bal = __ballot(sel); if (lane == 0) wc[w * 32 + j] = __popcll(bal); }
        __syncthreads();
        for (int j = 0; j < cur; ++j) { const bool sel = (hi == 0) && (s0 == j || s1 == j || s2 == j); const unsigned long long bal = __ballot(sel);
            int base = 0; for (int ww = 0; ww < w; ++ww) base += wc[ww * 32 + j];
            if (sel) { const int rank = __popcll(bal & ((1ull << r32) - 1ull)), slot = s0 == j ? 0 : (s1 == j ? 1 : 2);
                seg[(((size_t)bh * 32 + cur) * 32 + j) * 256 + base + rank] = (unsigned short)((32 * w + r32) | (slot << 8)); } }
        if (F.tid < 32) { int c = 0; if (F.tid < cur) { for (int ww = 0; ww < 8; ++ww) c += wc[ww * 32 + F.tid]; } cnt[((size_t)bh * 32 + cur) * 32 + F.tid] = c; }
        __syncthreads();
    }
}
__device__ __forceinline__ void moba_part(Frame& F, float* dout) {
    const bf16* qkv = (const bf16*)(F.ws + WS_QKV);
    const int* cnt = (const int*)(F.ws + WS_ABF + MB_CNT); const unsigned short* seg = (const unsigned short*)(F.ws + WS_ABF + MB_SEG);
    bf16* parto = (bf16*)((unsigned char*)dout + MB_PARTO); float* partml = (float*)((unsigned char*)dout + MB_PARTML);
    LAS int* ust = (LAS int*)(F.lds + 36864);
    LAS int* tot = (LAS int*)(F.lds + 45056);
    LAS int* c32 = (LAS int*)(F.lds + 32768);
    const int lane = F.lane, r32 = lane & 31, hi = lane >> 5, w = F.wave;
    __syncthreads();
    for (int p = F.tid; p < 1024; p += 512) { const int bh = p >> 5, j = p & 31; int t = 0; for (int cu = j + 1; cu < 32; ++cu) t += cnt[((size_t)bh * 32 + cu) * 32 + j]; tot[p] = t; }
    __syncthreads();
    if (F.tid == 0) { int a = 0; for (int p = 0; p < 1024; ++p) { ust[p] = a; a += (tot[p] + 255) >> 8; } ust[1024] = a; }
    __syncthreads();
    const int nunits = ust[1024];
    for (int u = F.vcu; u < nunits; u += F.G) {
        int lo = 0, hb = 1024;
        while (hb - lo > 1) { const int mid = (lo + hb) >> 1; if (ust[mid] <= u) lo = mid; else hb = mid; }
        const int p = lo, bh = p >> 5, j = p & 31, k = u - ust[p], total = tot[p];
        if (F.tid < 32) c32[F.tid] = F.tid > j ? cnt[((size_t)bh * 32 + F.tid) * 32 + j] : 0;
        __syncthreads();
        const int ci = 256 * k + 32 * w + r32; const bool valid = ci < total;
        int cu = j + 1, acc = 0;
        if (valid) { for (int c2 = j + 1; c2 < 32; ++c2) { const int n = c32[c2]; if (ci >= acc + n) { acc += n; cu = c2 + 1; } else break; } }
        int ql = 0, slot = 0;
        if (valid) { const unsigned e = seg[(((size_t)bh * 32 + cu) * 32 + j) * 256 + (ci - acc)]; ql = e & 255; slot = e >> 8; } else cu = j + 1;
        const int tq = valid ? cu * 256 + ql : (j + 1) * 256;
        bf16x8 qr[4];
#pragma unroll
        for (int d0 = 0; d0 < 4; ++d0) qr[d0] = *(const bf16x8*)(qkv + pg8::E_QM + ((size_t)bh * SEQ + tq) * 64 + 16 * d0 + 8 * hi);
        const int validi = valid ? 1 : 0;
        float m = -1e30f, l = 0.f; f32x16 o[2];
#pragma unroll
        for (int r = 0; r < 16; ++r) { o[0][r] = 0.f; o[1][r] = 0.f; }
        sm_stream(F, qkv + pg8::E_KM + (size_t)bh * SEQ * 64, qkv + pg8::E_VM + (size_t)bh * SEQ * 64, 4 * j, 4 * j + 4, qr, m, l, o,
            [=](int t) { return __ballot(validi != 0) != 0ull; }, [=](int t) { TileMask tm; tm.lo = -1; tm.hi_ = 63; tm.on = validi != 0; return tm; });
        const float lt = swap_sum(l);
        if (valid) { const size_t pi = ((size_t)bh * SEQ + tq) * 3 + slot;
            store_o(parto + pi * 64, o, hi, 1.0f / lt);
            if (hi == 0) { partml[pi * 2] = m; partml[pi * 2 + 1] = lt; } }
    }
}
__device__ __forceinline__ void moba_merge(Frame& F, const float* dout) {
    const bf16* qkv = (const bf16*)(F.ws + WS_QKV);
    const unsigned* selp = (const unsigned*)(F.ws + WS_ABF + MB_SELP);
    const bf16* parto = (const bf16*)((const unsigned char*)dout + MB_PARTO); const float* partml = (const float*)((const unsigned char*)dout + MB_PARTML);
    bf16* O = (bf16*)(F.ws + WS_O);
    const int lane = F.lane, r32 = lane & 31, hi = lane >> 5, w = F.wave;
    for (int it = 0; it < 4; ++it) {
        const int u = it * F.G + F.vcu; if (u >= 1024) break;
        const int bh = u >> 5, cur = u & 31, b = bh >> 3, h = bh & 7, tq = cur * 256 + 32 * w + r32;
        bf16x8 qr[4];
#pragma unroll
        for (int d0 = 0; d0 < 4; ++d0) qr[d0] = *(const bf16x8*)(qkv + pg8::E_QM + ((size_t)bh * SEQ + tq) * 64 + 16 * d0 + 8 * hi);
        float m = -1e30f, l = 0.f; f32x16 o[2];
#pragma unroll
        for (int r = 0; r < 16; ++r) { o[0][r] = 0.f; o[1][r] = 0.f; }
        const int wmax = cur * 256 + 32 * w + 31;
        sm_stream(F, qkv + pg8::E_KM + (size_t)bh * SEQ * 64, qkv + pg8::E_VM + (size_t)bh * SEQ * 64, 4 * cur, 4 * cur + 4, qr, m, l, o,
            [=](int t) { return 64 * t <= wmax; }, [=](int t) { TileMask tm; tm.lo = -1; tm.hi_ = tq - 64 * t - 4 * hi; tm.on = true; return tm; });
        float L = swap_sum(l);
        const unsigned sp = selp[(size_t)bh * SEQ + tq];
        float ms[3], ls[3]; float M = m;
#pragma unroll
        for (int s = 0; s < 3; ++s) { const bool on = ((sp >> (8 * s)) & 255u) != 255u; const size_t pi = ((size_t)bh * SEQ + tq) * 3 + s;
            ms[s] = on ? partml[pi * 2] : -1e30f; ls[s] = on ? partml[pi * 2 + 1] : 0.f; M = fmaxf(M, ms[s]); }
        const float wo = __builtin_amdgcn_exp2f(m - M); L *= wo;
#pragma unroll
        for (int r = 0; r < 16; ++r) { o[0][r] *= wo; o[1][r] *= wo; }
#pragma unroll
        for (int s = 0; s < 3; ++s) { const float ws_ = ls[s] * __builtin_amdgcn_exp2f(ms[s] - M); L += ws_;
            if (ls[s] > 0.f) { const bf16* po = parto + (((size_t)bh * SEQ + tq) * 3 + s) * 64;
#pragma unroll
                for (int dh = 0; dh < 2; ++dh)
#pragma unroll
                    for (int g = 0; g < 4; ++g) { const v2u pk = *(const v2u*)(po + 32 * dh + 8 * g + 4 * hi);
                        o[dh][4 * g] = fmaf(ws_, bflo(pk.x), o[dh][4 * g]); o[dh][4 * g + 1] = fmaf(ws_, bfhi(pk.x), o[dh][4 * g + 1]);
                        o[dh][4 * g + 2] = fmaf(ws_, bflo(pk.y), o[dh][4 * g + 2]); o[dh][4 * g + 3] = fmaf(ws_, bfhi(pk.y), o[dh][4 * g + 3]); } } }
        store_o(O + (size_t)(b * SEQ + tq) * 1024 + 512 + h * 64, o, hi, 1.0f / fmaxf(L, 1e-30f));
    }
}
constexpr int NSA_IMPG = 32768, NSA_IMPL = NSA_IMPG + 64 * 129 * 4, NSA_SEL = NSA_IMPL + 64 * 129 * 4;
__device__ __forceinline__ void p3_nsa_mfma(Frame& F) {
    const bf16* qkv = (const bf16*)(F.ws + WS_QKV);
    const float* gates = (const float*)(F.ws + WS_GATES);
    const bf16* KC = (const bf16*)(F.ws + WS_KC); const bf16* VC = (const bf16*)(F.ws + WS_VC);
    bf16* O = (bf16*)(F.ws + WS_O);
    LAS float* impG = (LAS float*)(F.lds + NSA_IMPG); LAS float* impL = (LAS float*)(F.lds + NSA_IMPL); LAS unsigned short* sel16 = (LAS unsigned short*)(F.lds + NSA_SEL);
    const int lane = F.lane, r32 = lane & 31, hi = lane >> 5, w = F.wave, ql = 8 * w + (r32 >> 2), g = r32 & 3;
    for (int it = 0; it < 4; ++it) {
        const int u = it * F.G + F.vcu; if (u >= 1024) break;
        const int bkv = u >> 7, craw = u & 127, c = (it & 1) ? 127 - craw : craw, b = bkv >> 1, kv = bkv & 1, h = kv * 4 + g, tq = 64 * c + ql, tok = b * SEQ + tq;
        bf16x8 qr[4];
#pragma unroll
        for (int d0 = 0; d0 < 4; ++d0) qr[d0] = *(const bf16x8*)(qkv + pg8::E_QA + ((size_t)(b * 8 + h) * SEQ + tq) * 64 + 16 * d0 + 8 * hi);
        const float g0 = gates[(size_t)tok * 24 + h * 3 + 0], g1 = gates[(size_t)tok * 24 + h * 3 + 1], g2 = gates[(size_t)tok * 24 + h * 3 + 2];
        f32x16 o[2]; LAS float* otl = (LAS float*)(F.lds + NSA_IMPG) + F.tid;
        for (int i = F.tid; i < 2 * 64 * 129; i += 512) impG[i] = 0.f;
        const int nvis = tq >= 31 ? min((tq - 31) / 16 + 1, 511) : 0, ntc = (4 * c + 66) >> 6;
        const bf16* kcp = KC + (size_t)bkv * 512 * 64; const bf16* vcp = VC + (size_t)bkv * 512 * 64;
        float m = -1e30f, l = 0.f;
#pragma unroll
        for (int r = 0; r < 16; ++r) { o[0][r] = 0.f; o[1][r] = 0.f; }
        sm_stream(F, kcp, vcp, 0, ntc, qr, m, l, o, [=](int t) { return true; }, [=](int t) { TileMask tm; tm.lo = -1; tm.hi_ = nvis - 1 - 64 * t - 4 * hi; tm.on = true; return tm; });
        float linv = 1.0f / fmaxf(swap_sum(l), 1e-30f);
#pragma unroll
        for (int r = 0; r < 16; ++r) { o[0][r] *= g0 * linv; o[1][r] *= g0 * linv; }
        if (c >= 16) {
            LAS unsigned char* L = F.lds;
            for (int t = 0; t < ntc; ++t) {
                { v4u kr, vr; kv_issue(kcp + (size_t)t * 4096, vcp + (size_t)t * 4096, w, lane, kr, vr); kv_commit(L, L + 16384, w, lane, kr, vr); }
                __syncthreads();
                f32x16 p0, p1; qk_tile(L, qr, r32, hi, p0, p1);
#pragma unroll
                for (int uu = 0; uu < 8; ++uu) { float pe[4];
#pragma unroll
                    for (int e = 0; e < 4; ++e) { const int i = 4 * uu + e; const float s = i < 16 ? p0[i] : p1[i - 16]; const int n = 64 * t + 32 * (i >> 4) + crow(i & 15, hi);
                        pe[e] = n < nvis ? __builtin_amdgcn_exp2f(s - m) * linv : 0.f; }
                    float G = (pe[0] + pe[1]) + (pe[2] + pe[3]), Lst = pe[3];
                    G += __shfl_xor(G, 1); G += __shfl_xor(G, 2); Lst += __shfl_xor(Lst, 1); Lst += __shfl_xor(Lst, 2);
                    const int j = 16 * t + 2 * uu + hi;
                    if (g == 0 && j < 128) { impG[ql * 129 + j] = G; impL[ql * 129 + j + 1] = Lst; } }
                __syncthreads();
            }
        }
        __syncthreads();
        { const int qs = F.tid >> 3, k8 = F.tid & 7; unsigned bits = 0u;
          if (c < 16) { if (k8 == 0) bits = (1u << (c + 1)) - 1u; }
          else { float v[16];
#pragma unroll
              for (int e = 0; e < 16; ++e) { const int j = 16 * k8 + e; v[e] = (j >= 1 && j <= c - 2) ? impG[qs * 129 + j] + impL[qs * 129 + j] : -1.0f;
                  if (j == 0 || j == c - 1 || j == c) bits |= 1u << e; }
              for (int rnd = 0; rnd < 13; ++rnd) { float bv = -1.0f; int bj = 999;
#pragma unroll
                  for (int e = 0; e < 16; ++e) { if (v[e] > bv) { bv = v[e]; bj = 16 * k8 + e; } }
#pragma unroll
                  for (int sh = 1; sh < 8; sh <<= 1) { const float ov = __shfl_xor(bv, sh); const int oj = __shfl_xor(bj, sh); if (better(ov, oj, bv, bj)) { bv = ov; bj = oj; } }
#pragma unroll
                  for (int e = 0; e < 16; ++e) { if (bj == 16 * k8 + e) { v[e] = -1.0f; bits |= 1u << e; } } } }
          sel16[qs * 8 + k8] = (unsigned short)bits; }
        __syncthreads();
#pragma unroll
        for (int r = 0; r < 16; ++r) { otl[r * 512] = o[0][r]; otl[(16 + r) * 512] = o[1][r]; }
        m = -1e30f; l = 0.f;
#pragma unroll
        for (int r = 0; r < 16; ++r) { o[0][r] = 0.f; o[1][r] = 0.f; }
        { const LAS unsigned short* myrow = sel16 + ql * 8;
          sm_stream(F, qkv + pg8::E_KSLC + (size_t)bkv * SEQ * 64, qkv + pg8::E_VSLC + (size_t)bkv * SEQ * 64, 0, c + 1, qr, m, l, o,
              [=](int t) { return __ballot((myrow[t >> 4] >> (t & 15)) & 1) != 0ull; },
              [=](int t) { TileMask tm; tm.lo = -1; tm.hi_ = tq - 64 * t - 4 * hi; tm.on = ((myrow[t >> 4] >> (t & 15)) & 1) != 0; return tm; }); }
        linv = 1.0f / fmaxf(swap_sum(l), 1e-30f);
#pragma unroll
        for (int r = 0; r < 16; ++r) { otl[r * 512] = fmaf(g1 * linv, o[0][r], otl[r * 512]); otl[(16 + r) * 512] = fmaf(g1 * linv, o[1][r], otl[(16 + r) * 512]); }
        m = -1e30f; l = 0.f;
#pragma unroll
        for (int r = 0; r < 16; ++r) { o[0][r] = 0.f; o[1][r] = 0.f; }
        sm_stream(F, qkv + pg8::E_KWIN + (size_t)bkv * SEQ * 64, qkv + pg8::E_VWIN + (size_t)bkv * SEQ * 64, max(c - 8, 0), c + 1, qr, m, l, o,
            [=](int t) { return true; }, [=](int t) { TileMask tm; tm.hi_ = tq - 64 * t - 4 * hi; tm.lo = tm.hi_ - 512; tm.on = true; return tm; });
        linv = 1.0f / fmaxf(swap_sum(l), 1e-30f);
#pragma unroll
        for (int r = 0; r < 16; ++r) { o[0][r] = fmaf(g2 * linv, o[0][r], otl[r * 512]); o[1][r] = fmaf(g2 * linv, o[1][r], otl[(16 + r) * 512]); }
        store_o(O + (size_t)tok * 1024 + h * 64, o, hi, 1.0f);
        __syncthreads();
    }
}

__global__ void __launch_bounds__(NWAVES * 64, 2) fwd_kernel(Args args) {
    extern __shared__ __attribute__((aligned(16))) unsigned char lds[];
    Frame F;
    F.lds = (LAS unsigned char*)lds; F.ws = args.ws;
    F.tid = threadIdx.x; F.lane = F.tid & 63; F.wave = __builtin_amdgcn_readfirstlane(F.tid >> 6);
    F.G = gridDim.x; { const int bx = blockIdx.x; F.vcu = (F.G % 8 == 0) ? (bx % 8) * (F.G / 8) + bx / 8 : bx; }
    for (int u = F.tid; u < (LDS_BYTES - LDSCTL_OFF) / 4; u += NWAVES * 64) ((LAS unsigned*)(F.lds + LDSCTL_OFF))[u] = 0u;
    __syncthreads();
    volatile LAS unsigned* MISC = (volatile LAS unsigned*)(F.lds + MISC_OFF);
    unsigned* ctl = (unsigned*)(args.ws + WS_CTL);
    XcdBarrier bar; bar.bar = ctl + CW_BAR + args.pad * XCD_BAR_WORDS; bar.x = 0; bar.st = nullptr;
    if (args.use_bar) bar = xcd_barrier_post(ctl + CW_BAR + args.pad * XCD_BAR_WORDS, MISC + 8);
    const int lo = args.ph_lo, hi = args.ph_hi;
#ifdef ONLYPH
#define IN(k) ((k) == ONLYPH && lo <= (k) && (k) < hi)
#else
#define IN(k) (lo <= (k) && (k) < hi)
#endif
#ifdef PROBE_REP
#define NREP(k) ((k) == PROBE_REP ? 2 : 1)
#else
#define NREP(k) 1
#endif
#define SEAM(k) do { if (IN(k) && IN((k) + 1)) xcd_barrier(bar); } while (0)
    float* R = args.out;
    bf16* ABF = (bf16*)(args.ws + WS_ABF); bf16* OB = (bf16*)(args.ws + WS_O); bf16* QKV = (bf16*)(args.ws + WS_QKV);
    bf16* XS = (bf16*)(args.ws + WS_XS); bf16* HB = (bf16*)(args.ws + WS_H);

    if (IN(0)) { for (int rep = 0; rep < NREP(0); ++rep) p0_prologue(F, args); } SEAM(0);
    if (IN(1)) { pg8::Gemm g{ABF, (const bf16*)(args.ws + WS_WIN0), NTOK, 3072, DM}; pg8::StaticOrder S; S.init(NTOK, 3072, F.G, (int)blockIdx.x);
        pg8::EpiProj0 E{QKV, (float*)(args.ws + WS_GATES), (const float*)(args.ws + WS_COS), (const float*)(args.ws + WS_SIN)};
        for (int rep = 0; rep < NREP(1); ++rep) { pg8::gemm_phase<pg8::EpiProj0, pg8::StaticOrder, true, true>(F.lds, g, S, E); __syncthreads(); } } SEAM(1);
    if (IN(2)) { for (int rep = 0; rep < NREP(2); ++rep) p2_compress(F, args); } SEAM(2);
    if (IN(3)) { moba_gate(F); xcd_barrier(bar);
        for (int rep = 0; rep < NREP(3); ++rep) p3_nsa_mfma(F);
        for (int rep = 0; rep < NREP(33); ++rep) moba_part(F, R);
        xcd_barrier(bar);
        moba_merge(F, R);
    } SEAM(3);
    if (IN(4)) { pg8::Gemm g{OB, (const bf16*)(args.ws + WS_WOUT0), NTOK, DM, DM}; pg8::StaticOrder S; S.init(NTOK, DM, F.G, (int)blockIdx.x);
        pg8::EpiRes E{args.in[0], R, ALPHA};
        for (int rep = 0; rep < NREP(4); ++rep) { pg8::gemm_phase<pg8::EpiRes, pg8::StaticOrder, true, true>(F.lds, g, S, E); __syncthreads(); } } SEAM(4);
    if (IN(5)) { if (NREP(5) > 1) ln_phase<true, true>(F, args, 0, args.in[12], args.in[13], (float*)(args.ws + WS_QKV), ABF);
        ln_phase<true, true>(F, args, 0, args.in[12], args.in[13], R, ABF); } SEAM(5);
    if (IN(6)) { for (int rep = 0; rep < NREP(6); ++rep) scatter_phase(F, R); } SEAM(6);
    if (IN(7)) { const int np = build_ptab(F, 0); pg8::Gemm g{ABF, nullptr, MAXROWS, 1024, DM};
        MoeOrder1 S{F.G, (int)blockIdx.x, np * 4, (const LAS int*)(F.lds + PTAB_OFF), (const bf16*)(args.ws + WS_W1E), (const int*)(args.ws + WS_ROWMAP)};
        pg8::EpiMoe1 E{HB, (const float*)(args.ws + WS_WROW)};
        for (int rep = 0; rep < NREP(7); ++rep) { pg8::gemm_phase<pg8::EpiMoe1, MoeOrder1, true, true>(F.lds, g, S, E); __syncthreads(); } } SEAM(7);
    if (IN(8)) { const int np = build_ptab(F, 0); pg8::Gemm g{HB, nullptr, MAXROWS, 1024, 512};
        MoeOrder2 S{F.G, (int)blockIdx.x, np * 4, (const LAS int*)(F.lds + PTAB_OFF), (const bf16*)(args.ws + WS_B2)};
        pg8::EpiMoe2 E{R, (const int*)(args.ws + WS_ROWMAP), ALPHA};
        pg8::gemm_phase<pg8::EpiMoe2, MoeOrder2, true, true>(F.lds, g, S, E); } SEAM(8);
    if (IN(9)) { if (NREP(9) > 1) ln_phase<false, true>(F, args, 0, args.in[14], args.in[15], (float*)(args.ws + WS_QKV), ABF);
        ln_phase<false, true>(F, args, 0, args.in[14], args.in[15], R, ABF); } SEAM(9);
    if (IN(10)) { pg8::Gemm g{ABF, (const bf16*)(args.ws + WS_WIN1), NTOK, 3072, DM}; pg8::StaticOrder S; S.init(NTOK, 3072, F.G, (int)blockIdx.x);
        pg8::EpiProj1 E{QKV};
        for (int rep = 0; rep < NREP(10); ++rep) { pg8::gemm_phase<pg8::EpiProj1, pg8::StaticOrder, true, true>(F.lds, g, S, E); __syncthreads(); } } SEAM(10);
    if (IN(11)) { for (int rep = 0; rep < NREP(11); ++rep) p11_sb_mfma(F); } SEAM(11);
    if (IN(12)) { pg8::Gemm g{OB, (const bf16*)(args.ws + WS_WOUT1), NTOK, DM, DM}; pg8::StaticOrder S; S.init(NTOK, DM, F.G, (int)blockIdx.x);
        pg8::EpiRes E{R, R, ALPHA};
        pg8::gemm_phase<pg8::EpiRes, pg8::StaticOrder, true, true>(F.lds, g, S, E); } SEAM(12);
    if (IN(13)) { ln_phase<true, true>(F, args, 1, args.in[12] + DM, args.in[13] + DM, R, ABF); } SEAM(13);
    if (IN(14)) { scatter_phase(F, R); } SEAM(14);
    if (IN(15)) { const int np = build_ptab(F, 0); pg8::Gemm g{ABF, nullptr, MAXROWS, 1024, DM};
        MoeOrder1 S{F.G, (int)blockIdx.x, np * 4, (const LAS int*)(F.lds + PTAB_OFF), (const bf16*)(args.ws + WS_W1E) + (size_t)16 * 512 * 1024, (const int*)(args.ws + WS_ROWMAP)};
        pg8::EpiMoe1 E{HB, (const float*)(args.ws + WS_WROW)};
        pg8::gemm_phase<pg8::EpiMoe1, MoeOrder1, true, true>(F.lds, g, S, E); } SEAM(15);
    if (IN(16)) { const int np = build_ptab(F, 0); pg8::Gemm g{HB, nullptr, MAXROWS, 1024, 512};
        MoeOrder2 S{F.G, (int)blockIdx.x, np * 4, (const LAS int*)(F.lds + PTAB_OFF), (const bf16*)(args.ws + WS_B2) + (size_t)24 * 1024 * 512};
        pg8::EpiMoe2 E{R, (const int*)(args.ws + WS_ROWMAP), ALPHA};
        pg8::gemm_phase<pg8::EpiMoe2, MoeOrder2, true, true>(F.lds, g, S, E); } SEAM(16);
    if (IN(17)) { ln_phase<false, false>(F, args, 1, args.in[14] + DM, args.in[15] + DM, R, nullptr); }
#undef IN
#undef SEAM
}


#ifdef PROBE_ATTN
__device__ __forceinline__ void mkframe(Frame& F, const Args& args, unsigned char* lds) { F.lds = (LAS unsigned char*)lds; F.ws = args.ws; F.tid = threadIdx.x; F.lane = F.tid & 63; F.wave = __builtin_amdgcn_readfirstlane(F.tid >> 6);
    F.G = gridDim.x; const int bx = blockIdx.x; F.vcu = (F.G % 8 == 0) ? (bx % 8) * (F.G / 8) + bx / 8 : bx; }
__global__ void __launch_bounds__(NWAVES * 64, 2) probe_naive(Args args) { extern __shared__ __attribute__((aligned(16))) unsigned char lds[]; Frame F; mkframe(F, args, lds);
    p3_nsa_naive(F, args, (bf16*)args.out); p3_moba_naive(F, args, (bf16*)args.out); }
__global__ void __launch_bounds__(NWAVES * 64, 2) probe_cmp(Args args) { extern __shared__ __attribute__((aligned(16))) unsigned char lds[]; Frame F; mkframe(F, args, lds);
    const bf16* o1 = (const bf16*)(args.ws + WS_O); const bf16* o2 = (const bf16*)args.out; float num = 0.f, den = 0.f;
    for (size_t i = (size_t)(F.vcu * 512 + F.tid); i < (size_t)NTOK * 1024; i += (size_t)F.G * 512) { if ((int)((i & 1023) >> 9) != PROBE_ATTN - 1) continue; const float a = bf2f(o1[i]), b = bf2f(o2[i]); num += (a - b) * (a - b); den += b * b; }
    num = wave_sum(num); den = wave_sum(den);
    if (F.lane == 0) { atomicAdd((float*)(args.ws + WS_CTL) + 32768, num); atomicAdd((float*)(args.ws + WS_CTL) + 32769, den); } }
__global__ void __launch_bounds__(NWAVES * 64, 2) probe_scale(Args args) { const float num = ((const float*)(args.ws + WS_CTL))[32768], den = ((const float*)(args.ws + WS_CTL))[32769], sc = 1.0f + 10.0f * sqrtf(num / fmaxf(den, 1e-30f));
    for (size_t i = (size_t)blockIdx.x * 512 + threadIdx.x; i < (size_t)NTOK * DM / 4; i += (size_t)gridDim.x * 512) { f32x4 v = ((const f32x4*)args.out)[i]; v = v * sc; ((f32x4*)args.out)[i] = v; } }
#endif
extern "C" void kernel_launch(void* const* d_in, const int* in_sizes, int n_in, void* d_out, int out_size, void* d_ws, size_t ws_size, hipStream_t stream) {
    static int grid = 0;
    if (grid == 0) {
        if (n_in != 23 || in_sizes[0] != NTOK * DM || out_size != NTOK * DM || ws_size < WS_END) { fprintf(stderr, "kernel_launch: unexpected shapes (n_in %d, in0 %d, out %d, ws %zu); nothing launched\n", n_in, n_in > 0 ? in_sizes[0] : -1, out_size, ws_size); grid = -1; return; }
        int dev = 0, cus = 0, per_cu = 0;
        if (hipGetDevice(&dev) != hipSuccess || hipDeviceGetAttribute(&cus, hipDeviceAttributeMultiprocessorCount, dev) != hipSuccess) { grid = -1; return; }
        if (hipFuncSetAttribute((const void*)fwd_kernel, hipFuncAttributeMaxDynamicSharedMemorySize, LDS_BYTES) != hipSuccess) { fprintf(stderr, "kernel_launch: hipFuncSetAttribute failed\n"); grid = -1; return; }
        if (hipOccupancyMaxActiveBlocksPerMultiprocessor(&per_cu, (const void*)fwd_kernel, NWAVES * 64, LDS_BYTES) != hipSuccess || per_cu < 1) { fprintf(stderr, "kernel_launch: occupancy query reports %d workgroups per CU\n", per_cu); }
        (void)hipGetLastError();
        grid = cus;
    }
    if (grid < 0) return;
    if (hipMemsetAsync((char*)d_ws + WS_CTL, 0, CTL_ZERO_BYTES, stream) != hipSuccess) return;
    Args a{};
    for (int i = 0; i < 23; ++i) a.in[i] = (const float*)d_in[i];
    a.out = (float*)d_out; a.ws = (unsigned char*)d_ws; a.pad = 0;
#if defined(PROBE_ATTN)
    hipFuncSetAttribute((const void*)probe_naive, hipFuncAttributeMaxDynamicSharedMemorySize, LDS_BYTES);
    a.ph_lo = 0; a.ph_hi = 4; a.use_bar = 1; a.pad = 0; hipLaunchKernelGGL(fwd_kernel, dim3(grid), dim3(NWAVES * 64), LDS_BYTES, stream, a);
    hipLaunchKernelGGL(probe_naive, dim3(grid), dim3(NWAVES * 64), LDS_BYTES, stream, a);
    hipLaunchKernelGGL(probe_cmp, dim3(grid), dim3(NWAVES * 64), 0, stream, a);
    a.ph_lo = 4; a.ph_hi = NPH; a.use_bar = 1; a.pad = 1; hipLaunchKernelGGL(fwd_kernel, dim3(grid), dim3(NWAVES * 64), LDS_BYTES, stream, a);
    hipLaunchKernelGGL(probe_scale, dim3(grid), dim3(NWAVES * 64), 0, stream, a);
#elif MK_N_LAUNCHES == 1
    a.ph_lo = 0; a.ph_hi = NPH; a.use_bar = 1;
    hipLaunchKernelGGL(fwd_kernel, dim3(grid), dim3(NWAVES * 64), LDS_BYTES, stream, a);
#else
    for (int p = 0; p < NPH; ++p) { a.ph_lo = p; a.ph_hi = p + 1; a.use_bar = 0;
        hipLaunchKernelGGL(fwd_kernel, dim3(grid), dim3(NWAVES * 64), LDS_BYTES, stream, a); }
#endif
}
```

```cpp
#include <hip/hip_runtime.h>
#include <cstdio>
#include <cstdint>
#include <cmath>

#ifndef MK_N_LAUNCHES
#define MK_N_LAUNCHES 1
#endif

#ifndef PG8_KALIGN
#define PG8_KALIGN ".p2align 6"
#endif
namespace pg8 {
#define PG8_LAS __attribute__((address_space(3)))
typedef unsigned short bf16_t;
typedef short bf16x8 __attribute__((ext_vector_type(8)));
typedef float f32x4 __attribute__((ext_vector_type(4)));
typedef unsigned u32x4 __attribute__((ext_vector_type(4)));
constexpr int BM = 256, BK = 64, HALF = 128, HTB = HALF * BK * 2  , STAGE_BYTES = 8 * HTB, NXCD = 8, WGM = 8;

__host__ __device__ __forceinline__ int lds_byte(int r, int c) { const int st = (r >> 4) * 2 + (c >> 5), rr = r & 15, cc = c & 31, ob = rr * 64 + cc * 2; return st * 1024 + (ob ^ (((ob >> 9) & 1) << 5)); }
__host__ __device__ __forceinline__ void stage_rc(int b, int& R, int& C) { const int st = b / 1024, sb = b % 1024, swz = sb ^ (((sb >> 9) & 1) << 5); R = (st >> 1) * 16 + swz / 64; C = (st & 1) * 32 + (swz % 64) / 2; }
__host__ __device__ __forceinline__ int perm32(int rho) { const int n = rho >> 4, i = rho & 15; return 8 * (i >> 2) + 4 * n + (i & 3); }

struct Unit { int pm, pn, aux; };
struct Gemm { const bf16_t* A; const bf16_t* Bt; int M, N, K; };

struct StaticOrder {
    static constexpr bool GATHER = false;
    int nM, nN, nwg, G, c;
    __host__ __device__ void init(int M, int N, int G_, int c_) { nM = M / BM; nN = N / BM; nwg = nM * nN; G = G_; c = c_; }
    __host__ __device__ bool next(int i, Unit& u) const {
        const long L = (long)i * G + c; if (L >= nwg) return false;
        int wgid = (int)L; { const int q = nwg / NXCD, r = nwg % NXCD, xcd = wgid % NXCD, off = wgid / NXCD; wgid = (xcd < r ? xcd * (q + 1) : r * (q + 1) + (xcd - r) * q) + off; }
        const int nig = WGM * nN, gid = wgid / nig, fm = gid * WGM, gsz = (nM - fm) < WGM ? (nM - fm) : WGM;
        u.pm = fm + ((wgid % nig) % gsz); u.pn = (wgid % nig) / gsz; u.aux = 0; return true;
    }
    __device__ __forceinline__ const char* aptr(const Gemm& g, const Unit& u, size_t tstep) const { return (const char*)g.A + (size_t)u.pm * tstep; }
    __device__ __forceinline__ const char* bptr(const Gemm& g, const Unit& u, size_t tstep) const { return (const char*)g.Bt + (size_t)u.pn * tstep; }
    __device__ __forceinline__ int arow(const Unit&, int) const { return 0; }
    __device__ __forceinline__ void a_ready(const Unit&) const {}
    __device__ __forceinline__ void done(const Unit&) const {}
};

__device__ __forceinline__ unsigned cvt_pk_bf16(float lo, float hi) { unsigned r; asm volatile("v_cvt_pk_bf16_f32 %0, %1, %2" : "=v"(r) : "v"(lo), "v"(hi)); return r; }
typedef unsigned u32x2 __attribute__((ext_vector_type(2)));
constexpr int SEQ_ = 8192;
constexpr float QLOG2 = 0.125f * 1.4426950408889634f;
constexpr size_t E_QA = 0, E_KCMP = 16777216, E_KSLC = 20971520, E_KWIN = 25165824, E_VCMP = 29360128, E_VSLC = 33554432, E_VWIN = 37748736,
                 E_QM = 41943040, E_KM = 58720256, E_VM = 75497472;

struct EpiProj0 {
    static constexpr bool PERM = true, AFTER_DRAIN = false;
    bf16_t* qkv; float* gates; const float* cosT; const float* sinT;
    __device__ __forceinline__ void operator()(const f32x4 (&acc)[2][2][4][2], const Unit& u, int wr, int wc, int fr, int fq) const {
        const int row0 = u.pm * BM + wr * 64 + fr;
#pragma unroll
        for (int bj = 0; bj < 2; ++bj) {
            const int hs = u.pn * 4 + bj * 2 + (wc >> 1);
            const int p0 = 32 * (wc & 1) + 8 * fq;
            if (hs < 44) {
                const bool rope = (hs < 14) || (hs >= 20 && hs < 36), isq = hs < 8 || (hs >= 20 && hs < 28);
                size_t base; int nh, hh;
                if (hs < 8) { base = E_QA; nh = 8; hh = hs; }
                else if (hs < 20) { base = E_KCMP + (size_t)((hs - 8) >> 1) * 4194304; nh = 2; hh = (hs - 8) & 1; }
                else { base = E_QM + (size_t)((hs - 20) >> 3) * 16777216; nh = 8; hh = (hs - 20) & 7; }
#pragma unroll
                for (int ai = 0; ai < 2; ++ai)
#pragma unroll
                    for (int m = 0; m < 4; ++m) {
                        const int r = row0 + ai * HALF + m * 16, b = r >> 13, s = r & (SEQ_ - 1);
                        f32x4 v0 = acc[ai][bj][m][0], v1 = acc[ai][bj][m][1];
                        if (rope) {
                            const f32x4 c4 = *(const f32x4*)(cosT + (size_t)r * 32 + (p0 >> 1)), s4 = *(const f32x4*)(sinT + (size_t)r * 32 + (p0 >> 1));
                            const f32x4 w0 = v0, w1 = v1;
                            v0[0] = w0[0] * c4[0] - w0[1] * s4[0]; v0[1] = w0[1] * c4[0] + w0[0] * s4[0];
                            v0[2] = w0[2] * c4[1] - w0[3] * s4[1]; v0[3] = w0[3] * c4[1] + w0[2] * s4[1];
                            v1[0] = w1[0] * c4[2] - w1[1] * s4[2]; v1[1] = w1[1] * c4[2] + w1[0] * s4[2];
                            v1[2] = w1[2] * c4[3] - w1[3] * s4[3]; v1[3] = w1[3] * c4[3] + w1[2] * s4[3];
                        }
                        if (isq) { v0 = v0 * QLOG2; v1 = v1 * QLOG2; }
                        u32x4 w; w.x = cvt_pk_bf16(v0[0], v0[1]); w.y = cvt_pk_bf16(v0[2], v0[3]); w.z = cvt_pk_bf16(v1[0], v1[1]); w.w = cvt_pk_bf16(v1[2], v1[3]);
                        *(u32x4*)(qkv + base + ((size_t)(b * nh + hh) * SEQ_ + s) * 64 + p0) = w;
                    }
            } else if (hs == 44) {
                if ((wc & 1) == 0 && fq < 3) {
#pragma unroll
                    for (int ai = 0; ai < 2; ++ai)
#pragma unroll
                        for (int m = 0; m < 4; ++m) {
                            const int r = row0 + ai * HALF + m * 16;
                            f32x4 v0 = acc[ai][bj][m][0], v1 = acc[ai][bj][m][1];
#pragma unroll
                            for (int e = 0; e < 4; ++e) { v0[e] = 1.0f / (1.0f + __expf(-v0[e])); v1[e] = 1.0f / (1.0f + __expf(-v1[e])); }
                            *(f32x4*)(gates + (size_t)r * 24 + p0) = v0; *(f32x4*)(gates + (size_t)r * 24 + p0 + 4) = v1;
                        }
                }
            }
        }
    }
};
struct EpiProj1 {
    static constexpr bool PERM = true, AFTER_DRAIN = false;
    bf16_t* qkv;
    __device__ __forceinline__ void operator()(const f32x4 (&acc)[2][2][4][2], const Unit& u, int wr, int wc, int fr, int fq) const {
        const int row0 = u.pm * BM + wr * 64 + fr;
#pragma unroll
        for (int bj = 0; bj < 2; ++bj) {
            const int hs = u.pn * 4 + bj * 2 + (wc >> 1), p0 = 32 * (wc & 1) + 8 * fq, hh = hs & 15;
            const size_t base = (size_t)(hs >> 4) * 33554432;
#pragma unroll
            for (int ai = 0; ai < 2; ++ai)
#pragma unroll
                for (int m = 0; m < 4; ++m) {
                    const int r = row0 + ai * HALF + m * 16, b = r >> 13, s = r & (SEQ_ - 1);
                    f32x4 v0 = acc[ai][bj][m][0], v1 = acc[ai][bj][m][1];
                    if (hs < 16) { v0 = v0 * QLOG2; v1 = v1 * QLOG2; }
                    u32x4 w; w.x = cvt_pk_bf16(v0[0], v0[1]); w.y = cvt_pk_bf16(v0[2], v0[3]); w.z = cvt_pk_bf16(v1[0], v1[1]); w.w = cvt_pk_bf16(v1[2], v1[3]);
                    *(u32x4*)(qkv + base + ((size_t)(b * 16 + hh) * SEQ_ + s) * 64 + p0) = w;
                }
        }
    }
};
__device__ __forceinline__ float bf_lo(unsigned u) { return __builtin_bit_cast(float, u << 16); }
__device__ __forceinline__ float bf_hi(unsigned u) { return __builtin_bit_cast(float, u & 0xffff0000u); }
struct EpiResX {
    static constexpr bool PERM = false, AFTER_DRAIN = false;
    const float* resid; bf16_t* out; float alpha;
    __device__ __forceinline__ void operator()(const f32x4 (&acc)[2][2][4][2], const Unit& u, int wr, int wc, int fr, int fq) const {
        const int row0 = u.pm * BM + wr * 64 + fr, col0 = u.pn * BM + wc * 32 + 4 * fq;
#pragma unroll
        for (int ai = 0; ai < 2; ++ai)
#pragma unroll
            for (int m = 0; m < 4; ++m) { const size_t off = (size_t)(row0 + ai * HALF + m * 16) * 1024 + col0;
#pragma unroll
                for (int bj = 0; bj < 2; ++bj)
#pragma unroll
                    for (int n = 0; n < 2; ++n) { const f32x4 bs = *(const f32x4*)(resid + off + bj * HALF + n * 16); const f32x4 v = bs * alpha + acc[ai][bj][m][n];
                        u32x2 w; w.x = cvt_pk_bf16(v[0], v[1]); w.y = cvt_pk_bf16(v[2], v[3]); *(u32x2*)(out + off + bj * HALF + n * 16) = w; } }
    }
};
struct EpiResB {
    static constexpr bool PERM = false, AFTER_DRAIN = false;
    bf16_t* RB; float alpha;
    __device__ __forceinline__ void operator()(const f32x4 (&acc)[2][2][4][2], const Unit& u, int wr, int wc, int fr, int fq) const {
        const int row0 = u.pm * BM + wr * 64 + fr, col0 = u.pn * BM + wc * 32 + 4 * fq;
#pragma unroll
        for (int ai = 0; ai < 2; ++ai)
#pragma unroll
            for (int m = 0; m < 4; ++m) { const size_t off = (size_t)(row0 + ai * HALF + m * 16) * 1024 + col0;
#pragma unroll
                for (int bj = 0; bj < 2; ++bj)
#pragma unroll
                    for (int n = 0; n < 2; ++n) { const u32x2 b = *(const u32x2*)(RB + off + bj * HALF + n * 16); const f32x4 a = acc[ai][bj][m][n];
                        u32x2 w; w.x = cvt_pk_bf16(bf_lo(b.x) * alpha + a[0], bf_hi(b.x) * alpha + a[1]); w.y = cvt_pk_bf16(bf_lo(b.y) * alpha + a[2], bf_hi(b.y) * alpha + a[3]); *(u32x2*)(RB + off + bj * HALF + n * 16) = w; } }
    }
};
struct EpiMoe1 {
    static constexpr bool PERM = true, AFTER_DRAIN = false;
    bf16_t* H; const float* wrow;
    __device__ __forceinline__ void operator()(const f32x4 (&acc)[2][2][4][2], const Unit& u, int wr, int wc, int fr, int fq) const {
        const int row0 = u.pm * BM + wr * 64 + fr, slot = u.pn >> 1;
#pragma unroll
        for (int ai = 0; ai < 2; ++ai)
#pragma unroll
            for (int m = 0; m < 4; ++m) { const int prow = row0 + ai * HALF + m * 16; const float w = wrow[(size_t)prow * 2 + slot];
#pragma unroll
                for (int bj = 0; bj < 2; ++bj) { const f32x4 g = acc[ai][bj][m][0], up = acc[ai][bj][m][1]; float hv[4];
#pragma unroll
                    for (int e = 0; e < 4; ++e) hv[e] = g[e] / (1.0f + __expf(-g[e])) * up[e] * w;
                    u32x2 o; o.x = cvt_pk_bf16(hv[0], hv[1]); o.y = cvt_pk_bf16(hv[2], hv[3]);
                    *(u32x2*)(H + (size_t)prow * 512 + u.pn * 128 + bj * 64 + wc * 16 + 4 * fq) = o; } }
    }
};
struct EpiMoe2 {
    static constexpr bool PERM = false, AFTER_DRAIN = false;
    bf16_t* RB; const int* rowmap; float alpha;
    __device__ __forceinline__ void operator()(const f32x4 (&acc)[2][2][4][2], const Unit& u, int wr, int wc, int fr, int fq) const {
        const int row0 = u.pm * BM + wr * 64 + fr, col0 = u.pn * BM + wc * 32 + 4 * fq;
#pragma unroll
        for (int ai = 0; ai < 2; ++ai)
#pragma unroll
            for (int m = 0; m < 4; ++m) { const int tok = rowmap[row0 + ai * HALF + m * 16];
                if (tok >= 0) { const size_t off = (size_t)tok * 1024 + col0;
#pragma unroll
                    for (int bj = 0; bj < 2; ++bj)
#pragma unroll
                        for (int n = 0; n < 2; ++n) { const u32x2 b = *(const u32x2*)(RB + off + bj * HALF + n * 16); const f32x4 a = acc[ai][bj][m][n];
                            u32x2 w; w.x = cvt_pk_bf16(bf_lo(b.x) * alpha + a[0], bf_hi(b.x) * alpha + a[1]); w.y = cvt_pk_bf16(bf_lo(b.y) * alpha + a[2], bf_hi(b.y) * alpha + a[3]); *(u32x2*)(RB + off + bj * HALF + n * 16) = w; } } }
    }
};

template <class Epi, class Sched, bool ALIGN_EPI = false, bool SP2 = false>
__device__ __forceinline__ void gemm_phase(PG8_LAS unsigned char* lds, const Gemm g, const Sched& S, const Epi& E) {
    const int tid = threadIdx.x, wid = __builtin_amdgcn_readfirstlane(tid >> 6), lane = tid & 63, wr = wid >> 2, wc = wid & 3, fr = lane & 15, fq = lane >> 4;
    const int K = g.K, nt = K / BK;
    unsigned voffA[2], voffB[2]; int Rv[2], Cv[2];
#pragma unroll
    for (int i = 0; i < 2; ++i) { int R, C; stage_rc(tid * 16 + i * 8192, R, C); const int Rb = Epi::PERM ? ((R & ~31) + perm32(R & 31)) : R; Rv[i] = R; Cv[i] = C;
        voffA[i] = (unsigned)(R * K + C) * 2u; voffB[i] = (unsigned)(Rb * K + C) * 2u; }
    constexpr bool GATHER = Sched::GATHER; static_assert(!GATHER || SP2, "gather is wired into the SP2 loop only");
    unsigned gA[2][2], gN[2][2];
#define PG8_SETG(G_, U_) do { _Pragma("unroll") for (int _h = 0; _h < 2; ++_h) _Pragma("unroll") for (int _i = 0; _i < 2; ++_i) G_[_h][_i] = GATHER ? (unsigned)S.arow(U_, _h * HALF + Rv[_i]) * (unsigned)(K * 2) + (unsigned)(Cv[_i] * 2) : voffA[_i]; } while (0)
#define PG8_SELG(dst, h_, nx_) unsigned dst[2] = { (nx_) ? gN[h_][0] : gA[h_][0], (nx_) ? gN[h_][1] : gA[h_][1] }
    const size_t kstep = (size_t)(BK * 2);
    const size_t hstep = (size_t)HALF * K * 2;
    const size_t hstepA = GATHER ? (size_t)0 : hstep;
    const size_t tstep = 2 * hstep;
    const unsigned ldsw = (unsigned)wid * 1024u;
    const int aoff = lds_byte(wr * 64 + fr, fq * 8), boff = lds_byte(wc * 32 + fr, fq * 8);
#define PG8_SA(b, h) (((b) * 2 + (h)) * HTB)
#define PG8_SB(b, h) ((4 + (b) * 2 + (h)) * HTB)
#define PG8_STAGE(bufoff, gbase, voff) do { _Pragma("unroll") for (int _i = 0; _i < 2; ++_i) \
        __builtin_amdgcn_global_load_lds((const unsigned*)((const char*)(gbase) + (voff)[_i]), (PG8_LAS unsigned*)(lds + (bufoff) + ldsw + _i * 8192), 16, 0, 0); } while (0)
#define PG8_LDA(dst, b, h) do { _Pragma("unroll") for (int m = 0; m < 4; ++m) _Pragma("unroll") for (int k = 0; k < 2; ++k) dst[m][k] = *(const PG8_LAS bf16x8*)(lds + PG8_SA(b, h) + aoff + m * 2048 + k * 1024); } while (0)
#define PG8_LDB(dst, b, h) do { _Pragma("unroll") for (int n = 0; n < 2; ++n) _Pragma("unroll") for (int k = 0; k < 2; ++k) dst[n][k] = *(const PG8_LAS bf16x8*)(lds + PG8_SB(b, h) + boff + n * 2048 + k * 1024); } while (0)
#define PG8_MMA(ai, bj, At, Bt) do { __builtin_amdgcn_s_setprio(1); _Pragma("unroll") for (int m = 0; m < 4; ++m) _Pragma("unroll") for (int n = 0; n < 2; ++n) _Pragma("unroll") for (int k = 0; k < 2; ++k) \
        acc[ai][bj][m][n] = __builtin_amdgcn_mfma_f32_16x16x32_bf16(Bt[n][k], At[m][k], acc[ai][bj][m][n], 0, 0, 0); __builtin_amdgcn_s_setprio(0); } while (0)
#define PG8_WAIT_V(n) asm volatile("s_waitcnt vmcnt(" #n ")" ::: "memory")
#define PG8_WAIT_L(n) asm volatile("s_waitcnt lgkmcnt(" #n ")" ::: "memory")
#define PG8_BAR __builtin_amdgcn_s_barrier()
#define PG8_SCHED __builtin_amdgcn_sched_barrier(0)
    Unit cur, nxt; int ui = 0;
    if (!S.next(0, cur)) return;
    f32x4 acc[2][2][4][2];
#pragma unroll
    for (int a = 0; a < 2; ++a)
#pragma unroll
        for (int b = 0; b < 2; ++b)
#pragma unroll
            for (int m = 0; m < 4; ++m)
#pragma unroll
                for (int n = 0; n < 2; ++n) acc[a][b][m][n] = (f32x4){0.f, 0.f, 0.f, 0.f};
    bf16x8 At[4][2], B0[2][2], B1[2][2];
    const char* cA = GATHER ? (const char*)g.A : S.aptr(g, cur, tstep); const char* cB = S.bptr(g, cur, tstep);
    S.a_ready(cur);
    PG8_SETG(gA, cur);
    if constexpr (SP2) {
        PG8_STAGE(PG8_SB(0, 0), cB, voffB); PG8_STAGE(PG8_SB(0, 1), cB + hstep, voffB); PG8_STAGE(PG8_SA(0, 0), cA, gA[0]); PG8_STAGE(PG8_SA(0, 1), cA + hstepA, gA[1]);
        if (wr == 1) PG8_BAR;
        PG8_WAIT_V(2); PG8_BAR;
        PG8_STAGE(PG8_SB(1, 0), cB + kstep, voffB); PG8_STAGE(PG8_SA(1, 0), cA + kstep, gA[0]); PG8_STAGE(PG8_SB(1, 1), cB + hstep + kstep, voffB);
        PG8_WAIT_V(6); PG8_BAR;
    } else {
        PG8_STAGE(PG8_SB(0, 0), cB, voffB); PG8_STAGE(PG8_SA(0, 0), cA, voffA); PG8_STAGE(PG8_SB(0, 1), cB + hstep, voffB); PG8_STAGE(PG8_SA(0, 1), cA + hstep, voffA);
        if (wr == 1) PG8_BAR;
        PG8_WAIT_V(4); PG8_BAR;
        PG8_STAGE(PG8_SB(1, 0), cB + kstep, voffB); PG8_STAGE(PG8_SA(1, 0), cA + kstep, voffA); PG8_STAGE(PG8_SB(1, 1), cB + hstep + kstep, voffB);
        PG8_WAIT_V(6); PG8_BAR;
    }
    for (;;) {
        const bool has_next = S.next(ui + 1, nxt);
        const char* nA = (has_next && !GATHER) ? S.aptr(g, nxt, tstep) : cA; const char* nB = has_next ? S.bptr(g, nxt, tstep) : cB;
        if (has_next) PG8_SETG(gN, nxt); else { _Pragma("unroll") for (int _h = 0; _h < 2; ++_h) _Pragma("unroll") for (int _i = 0; _i < 2; ++_i) gN[_h][_i] = gA[_h][_i]; }
        asm volatile(PG8_KALIGN ::: "memory");
        for (int t = 0; t < nt; t += 2) {
            const bool last = (t == nt - 2);
            const char* a1 = cA + (size_t)(t + 1) * kstep;
            const char* a2 = last ? nA : cA + (size_t)(t + 2) * kstep; const char* b2 = last ? nB : cB + (size_t)(t + 2) * kstep;
            const char* a3 = a2 + kstep; const char* b3 = b2 + kstep;
            if (last && has_next) S.a_ready(nxt);
            if constexpr (SP2) {
            PG8_LDB(B0, 0, 0); PG8_LDB(B1, 0, 1); PG8_SCHED; PG8_LDA(At, 0, 0); PG8_STAGE(PG8_SA(1, 1), a1 + hstepA, gA[1]);
            PG8_WAIT_V(8); PG8_WAIT_L(0); PG8_BAR; PG8_MMA(0, 0, At, B0); PG8_MMA(0, 1, At, B1); PG8_BAR; PG8_SCHED;
            PG8_LDA(At, 0, 1); PG8_STAGE(PG8_SB(0, 0), b2, voffB); PG8_STAGE(PG8_SB(0, 1), b2 + hstep, voffB); { PG8_SELG(gs_, 0, last); PG8_STAGE(PG8_SA(0, 0), a2, gs_); }
            PG8_WAIT_V(8); PG8_WAIT_L(0); PG8_BAR; PG8_MMA(1, 0, At, B0); PG8_MMA(1, 1, At, B1); PG8_BAR; PG8_SCHED;
            PG8_LDB(B0, 1, 0); PG8_LDB(B1, 1, 1); PG8_SCHED; PG8_LDA(At, 1, 0); { PG8_SELG(gs_, 1, last); PG8_STAGE(PG8_SA(0, 1), a2 + hstepA, gs_); }
            PG8_WAIT_V(8); PG8_WAIT_L(0); PG8_BAR; PG8_MMA(0, 0, At, B0); PG8_MMA(0, 1, At, B1); PG8_BAR; PG8_SCHED;
            PG8_LDA(At, 1, 1); PG8_STAGE(PG8_SB(1, 0), b3, voffB); PG8_STAGE(PG8_SB(1, 1), b3 + hstep, voffB); { PG8_SELG(gs_, 0, last); PG8_STAGE(PG8_SA(1, 0), a3, gs_); }
            PG8_WAIT_V(8); PG8_WAIT_L(0); PG8_BAR; PG8_MMA(1, 0, At, B0); PG8_MMA(1, 1, At, B1); PG8_BAR; PG8_SCHED;
            } else {
            PG8_LDB(B0, 0, 0); PG8_SCHED; PG8_LDA(At, 0, 0); PG8_STAGE(PG8_SA(1, 1), a1 + hstep, voffA);
            PG8_WAIT_L(8); PG8_BAR; PG8_WAIT_L(0); PG8_MMA(0, 0, At, B0); PG8_BAR; PG8_SCHED;
            PG8_LDB(B1, 0, 1); PG8_STAGE(PG8_SB(0, 0), b2, voffB);
            PG8_BAR; PG8_WAIT_L(0); PG8_MMA(0, 1, At, B1); PG8_BAR;
            PG8_LDA(At, 0, 1); PG8_STAGE(PG8_SA(0, 0), a2, voffA);
            PG8_BAR; PG8_WAIT_L(0); PG8_MMA(1, 0, At, B0); PG8_BAR; PG8_SCHED;
            PG8_STAGE(PG8_SB(0, 1), b2 + hstep, voffB);
            PG8_WAIT_V(6); PG8_BAR; PG8_MMA(1, 1, At, B1); PG8_BAR;
            PG8_LDB(B0, 1, 0); PG8_SCHED; PG8_LDA(At, 1, 0); PG8_STAGE(PG8_SA(0, 1), a2 + hstep, voffA);
            PG8_WAIT_L(8); PG8_BAR; PG8_WAIT_L(0); PG8_MMA(0, 0, At, B0); PG8_BAR; PG8_SCHED;
            PG8_LDB(B1, 1, 1); PG8_STAGE(PG8_SB(1, 0), b3, voffB);
            PG8_BAR; PG8_WAIT_L(0); PG8_MMA(0, 1, At, B1); PG8_BAR;
            PG8_LDA(At, 1, 1); PG8_STAGE(PG8_SA(1, 0), a3, voffA);
            PG8_BAR; PG8_WAIT_L(0); PG8_MMA(1, 0, At, B0); PG8_BAR; PG8_SCHED;
            PG8_STAGE(PG8_SB(1, 1), b3 + hstep, voffB);
            PG8_WAIT_V(6); PG8_BAR; PG8_MMA(1, 1, At, B1); PG8_BAR;
            }
        }
        if constexpr (ALIGN_EPI) { if (wr == 0) PG8_BAR; }
        if constexpr (!Epi::AFTER_DRAIN) { E(acc, cur, wr, wc, fr, fq); S.done(cur); }
        if (!has_next) break;
#pragma unroll
        for (int a = 0; a < 2; ++a)
#pragma unroll
            for (int b = 0; b < 2; ++b)
#pragma unroll
                for (int m = 0; m < 4; ++m)
#pragma unroll
                    for (int n = 0; n < 2; ++n) acc[a][b][m][n] = (f32x4){0.f, 0.f, 0.f, 0.f};
        cur = nxt; cA = nA; cB = nB; ++ui;
#pragma unroll
        for (int _h = 0; _h < 2; ++_h)
#pragma unroll
            for (int _i = 0; _i < 2; ++_i) gA[_h][_i] = gN[_h][_i];
        if constexpr (ALIGN_EPI) { if (wr == 1) PG8_BAR; }
    }
    PG8_WAIT_V(0);
    if constexpr (!ALIGN_EPI) { if (wr == 0) PG8_BAR; }
    PG8_BAR;
    if constexpr (Epi::AFTER_DRAIN) { E.fused(acc, cur, wr, wc, fr, fq, lds, wid, lane); S.done(cur); }
#undef PG8_SETG
#undef PG8_SELG
#undef PG8_SA
#undef PG8_SB
#undef PG8_STAGE
#undef PG8_LDA
#undef PG8_LDB
#undef PG8_MMA
#undef PG8_WAIT_V
#undef PG8_WAIT_L
#undef PG8_BAR
#undef PG8_SCHED
}
}

constexpr int NWAVES = 8;
constexpr int BATCH = 4, SEQ = 8192, DM = 1024, NTOK = BATCH * SEQ;
constexpr int NPH = 18;
constexpr float LN_EPS = 1e-5f;
constexpr float ALPHA = 1.4142135623730951f;
constexpr float QSCALE = 0.125f;
constexpr float NAIVE_SC = 0.6931471805599453f;
constexpr int MAXPAN = 152, MAXROWS = MAXPAN * 256;
constexpr size_t MiB = 1u << 20;
constexpr size_t WS_CTL = 0, CTL_ZERO_BYTES = 1 * MiB;
constexpr size_t WS_POSB = 1 * MiB, WS_KC = 1 * MiB + 4096, WS_VC = WS_KC + 524288, WS_KMEAN = WS_VC + 524288;
constexpr size_t WS_KMH = 2 * MiB + 512 * 1024, WS_KML = 2 * MiB + 768 * 1024;
constexpr size_t WS_W1T = 3 * MiB;
constexpr size_t WS_COS = 4 * MiB, WS_SIN = 8 * MiB;
constexpr size_t WS_TOKI = 12 * MiB, WS_ROWMAP = WS_TOKI + 524288, WS_WROW = WS_ROWMAP + 262144;
constexpr size_t WS_HIST = 13 * MiB + 512 * 1024, WS_GTAB = WS_HIST + 32768;
constexpr size_t WS_WIN0 = 14 * MiB, WS_WOUT0 = 20 * MiB, WS_WIN1 = 22 * MiB, WS_WOUT1 = 28 * MiB, WS_W1E = 30 * MiB, WS_B2 = 62 * MiB;
constexpr size_t WS_ABF = 110 * MiB, WS_O = 174 * MiB, WS_QKV = 238 * MiB, WS_END = 430 * MiB;
constexpr size_t WS_GATES = WS_QKV + 176 * MiB;
constexpr size_t WS_XS = WS_QKV, WS_H = WS_QKV + 80 * MiB;
static_assert(WS_WROW + (size_t)MAXROWS * 8 <= WS_WIN0 && WS_KMEAN + 262144 <= WS_COS && (size_t)MAXROWS * 2048 <= 80 * MiB && (size_t)MAXROWS * 1024 <= 96 * MiB, "ws map");
constexpr int CW_BAR = 4096;
constexpr int CW_Q = 20480;
constexpr int CW_CNT = 16384;
constexpr int RING_BYTES = 131072;
constexpr int LDSCTL_OFF = RING_BYTES, MISC_OFF = LDSCTL_OFF + 320;
constexpr int PTAB_OFF = LDSCTL_OFF + 1024;
constexpr int LDS_BYTES = 147456;

#define GAS __attribute__((address_space(1)))
#define LAS __attribute__((address_space(3)))
typedef unsigned short bf16;
typedef unsigned v4u __attribute__((ext_vector_type(4)));
typedef unsigned v2u __attribute__((ext_vector_type(2)));
typedef float f32x4 __attribute__((ext_vector_type(4)));
typedef GAS unsigned gu32;
#define RLX_AGENT __ATOMIC_RELAXED, __HIP_MEMORY_SCOPE_AGENT
#define LDS_WAIT() asm volatile("s_waitcnt lgkmcnt(0)" ::: "memory")
__device__ __forceinline__ unsigned f2bf(float f) { unsigned u = __builtin_bit_cast(unsigned, f); return (u + 0x7fffu + ((u >> 16) & 1u)) >> 16; }
__device__ __forceinline__ unsigned pk2(float lo, float hi) { return f2bf(lo) | (f2bf(hi) << 16); }
__device__ __forceinline__ float bflo(unsigned u) { return __builtin_bit_cast(float, u << 16); }
__device__ __forceinline__ float bfhi(unsigned u) { return __builtin_bit_cast(float, u & 0xffff0000u); }
__device__ __forceinline__ float bf2f(bf16 h) { return __builtin_bit_cast(float, (unsigned)h << 16); }

#define XB_TMO      128
#define XB_XCNT(j)  (256  + 64 * (j))
#define XB_XSUB(j)  (1280 + 64 * (j))
#define XB_XGEN(j)  (2304 + 64 * (j))
#define XB_TOP      3328
#define XB_TOPGEN   3392
#define XCD_BAR_WORDS 3456
#define XB_SPIN_CAP (1u << 24)
__device__ __forceinline__ unsigned xb_ld(unsigned* p)              { return __hip_atomic_load(p, __ATOMIC_RELAXED, __HIP_MEMORY_SCOPE_AGENT); }
__device__ __forceinline__ unsigned xb_add(unsigned* p, unsigned v) { return __hip_atomic_fetch_add(p, v, __ATOMIC_RELAXED, __HIP_MEMORY_SCOPE_AGENT); }
__device__ __forceinline__ unsigned xb_xcc_id() { return (unsigned)__builtin_amdgcn_s_getreg((3 << 11) | 20) & 0xFu; }
#define XB_SPIN(cond, bar) do { unsigned _sp = 0; while (cond) { __builtin_amdgcn_s_sleep(1); \
    if ((++_sp & 255u) == 0u) { if (xb_ld(&(bar)[XB_TMO])) break; if (_sp > XB_SPIN_CAP) { atomicAdd(&(bar)[XB_TMO], 1u); break; } } } } while (0)
struct XcdBarrier { unsigned* bar; unsigned x; volatile LAS unsigned* st; };
__device__ __forceinline__ XcdBarrier xcd_barrier_post(unsigned* bar, volatile LAS unsigned* st) {
    XcdBarrier b; b.bar = bar; b.x = xb_xcc_id(); b.st = st;
    if (threadIdx.x == 0) (void)xb_add(&bar[XB_XCNT(b.x)], 1u);
    return b;
}
__device__ __forceinline__ void xcd_barrier_complete(unsigned* bar, unsigned x, unsigned& nloc, unsigned& nx) {
    const unsigned G = gridDim.x * gridDim.y * gridDim.z;
    unsigned sum, cnt, mine, sp = 0u;
    for (;;) {
        sum = 0u; cnt = 0u; mine = 0u;
#pragma unroll
        for (unsigned j = 0; j < 16; ++j) { const unsigned c = xb_ld(&bar[XB_XCNT(j)]); sum += c; cnt += (c > 0u) ? 1u : 0u; mine = (j == x) ? c : mine; }
        if (sum == G) break;
        __builtin_amdgcn_s_sleep(1);
        if ((++sp & 255u) == 0u) { if (xb_ld(&bar[XB_TMO])) break; if (sp > XB_SPIN_CAP) { atomicAdd(&bar[XB_TMO], 1u); break; } }
    }
    nloc = mine > 0u ? mine : 1u; nx = cnt > 0u ? cnt : 1u;
}
__device__ __forceinline__ void xcd_barrier(const XcdBarrier& b) {
    asm volatile("s_waitcnt vmcnt(0)" ::: "memory");
    __syncthreads();
    if (threadIdx.x == 0) {
        unsigned* bar = b.bar;
        __builtin_amdgcn_s_waitcnt(0);
        unsigned nloc = b.st[0], nx = b.st[1];
        if (nloc == 0u) { xcd_barrier_complete(bar, b.x, nloc, nx); b.st[0] = nloc; b.st[1] = nx; }
        const unsigned old = xb_add(&bar[XB_XSUB(b.x)], 1u);
        const unsigned gen = old / nloc;
        if (old + 1u == (gen + 1u) * nloc) {
            __builtin_amdgcn_fence(__ATOMIC_RELEASE, "agent");
            asm volatile("s_waitcnt vmcnt(0)" ::: "memory");
            const unsigned og = xb_add(&bar[XB_TOP], 1u);
            const unsigned tg = og / nx;
            if (og + 1u == (tg + 1u) * nx) xb_add(&bar[XB_TOPGEN], 1u);
            else XB_SPIN(xb_ld(&bar[XB_TOPGEN]) == tg, bar);
            __builtin_amdgcn_fence(__ATOMIC_ACQUIRE, "agent");
            xb_add(&bar[XB_XGEN(b.x)], 1u);
            asm volatile("s_waitcnt vmcnt(0)" ::: "memory");
        } else {
            XB_SPIN(xb_ld(&bar[XB_XGEN(b.x)]) == gen, bar);
            __builtin_amdgcn_fence(__ATOMIC_ACQUIRE, "agent");
            asm volatile("s_waitcnt vmcnt(0)" ::: "memory");
        }
    }
    __syncthreads();
}

struct Args { const float* in[23]; float* out; unsigned char* ws; int ph_lo, ph_hi, use_bar, pad; };
struct Frame {
    LAS unsigned char* lds;
    unsigned char* ws;
    int tid, lane, wave, vcu, G;
};
__device__ __forceinline__ float wave_sum(float v) {
#pragma unroll
    for (int o = 1; o < 64; o <<= 1) v += __shfl_xor(v, o);
    return v;
}

template <class Map>
__device__ __forceinline__ void tr_item(const float* W, int N, int kb, int nb, bf16* WT, int ldt, int koff, LAS float* scr, int lane, Map map) {
    const int k0 = 64 * kb, n0 = 32 * nb;
#pragma unroll 8
    for (int i = 0; i < 32; ++i) { const int kk = 2 * i + (lane >> 5), n = n0 + (lane & 31); scr[kk * 33 + (lane & 31)] = (n < N) ? W[(size_t)(k0 + kk) * N + n] : 0.f; }
    LDS_WAIT(); asm volatile("" ::: "memory");
    const int c = lane & 7;
#pragma unroll
    for (int j = 0; j < 4; ++j) { const int nl = (lane >> 3) + 8 * j, n = n0 + nl; const LAS float* s = scr + (8 * c) * 33 + nl;
        if (n < N) { const int row = map(n);
            if (row >= 0) { v4u o; o.x = pk2(s[0 * 33], s[1 * 33]); o.y = pk2(s[2 * 33], s[3 * 33]); o.z = pk2(s[4 * 33], s[5 * 33]); o.w = pk2(s[6 * 33], s[7 * 33]);
                *(v4u*)(WT + (size_t)row * ldt + koff + k0 + 8 * c) = o; } } }
    LDS_WAIT(); asm volatile("" ::: "memory");
}
__device__ __forceinline__ int rope_perm(int d) { return d < 32 ? 2 * d : 2 * (d - 32) + 1; }
struct MapIdent { __device__ __forceinline__ int operator()(int n) const { return n; } };
struct MapGU { int up; __device__ __forceinline__ int operator()(int n) const { return (n >> 2) * 8 + up * 4 + (n & 3); } };
struct MapIn0 {
    __device__ __forceinline__ int operator()(int n) const {
        int hs, d; bool rope;
        if (n < 512) { hs = n >> 6; d = n & 63; rope = true; }
        else if (n < 1280) { const int seg = (n - 512) >> 7, w = (n - 512) & 127;
            rope = (seg & 1) == 0; hs = (rope ? 8 : 14) + (seg >> 1) * 2 + (w >> 6); d = w & 63; }
        else if (n < 1304) { return 44 * 64 + (n - 1280); }
        else { const int m = n - 1304, t = m >> 9; hs = 20 + t * 8 + ((m & 511) >> 6); d = m & 63; rope = t < 2; }
        return hs * 64 + (rope ? rope_perm(d) : d);
    }
};
__device__ __forceinline__ void bucket_pair(int pi, int& lo, int& hi) { lo = pi < 3 ? 0 : (pi < 5 ? 1 : 2); hi = pi < 3 ? pi + 1 : (pi < 5 ? pi - 1 : 3); }

__device__ __forceinline__ void p0_prologue(Frame& F, const Args& A) {
    LAS float* scr = (LAS float*)(F.lds + F.wave * 16384);
    const int gw = F.vcu * NWAVES + F.wave, NGW = F.G * NWAVES;
    bf16* WIN0 = (bf16*)(F.ws + WS_WIN0); bf16* WOUT0 = (bf16*)(F.ws + WS_WOUT0); bf16* WIN1 = (bf16*)(F.ws + WS_WIN1); bf16* WOUT1 = (bf16*)(F.ws + WS_WOUT1);
    bf16* W1E = (bf16*)(F.ws + WS_W1E); bf16* B2 = (bf16*)(F.ws + WS_B2);
    constexpr int I_A = 16 * 89, I_B = 16 * 32, I_C = 16 * 96, I_D = 16 * 32, I_E = 64 * 128, I_F = 96 * 128;
    constexpr int NITEMS = I_A + I_B + I_C + I_D + I_E + I_F;
    for (int it = gw; it < NITEMS; it += NGW) {
        int r = it;
        if (r < I_A) { tr_item(A.in[2], 2840, r / 89, r % 89, WIN0, 1024, 0, scr, F.lane, MapIn0()); continue; } r -= I_A;
        if (r < I_B) { tr_item(A.in[3], 1024, r / 32, r % 32, WOUT0, 1024, 0, scr, F.lane, MapIdent()); continue; } r -= I_B;
        if (r < I_C) { tr_item(A.in[10], 3072, r / 96, r % 96, WIN1, 1024, 0, scr, F.lane, MapIdent()); continue; } r -= I_C;
        if (r < I_D) { tr_item(A.in[11], 1024, r / 32, r % 32, WOUT1, 1024, 0, scr, F.lane, MapIdent()); continue; } r -= I_D;
        if (r < I_E) { const int job = r >> 7, sub = r & 127, le = job >> 1, up = job & 1;
            const float* src = (up ? A.in[21] : A.in[20]) + (size_t)le * 1024 * 256; MapGU mp; mp.up = up;
            tr_item(src, 256, sub >> 3, sub & 7, W1E + (size_t)le * 512 * 1024, 1024, 0, scr, F.lane, mp); continue; } r -= I_E;
        { const int job = r >> 7, sub = r & 127, slot = job & 1, lb = job >> 1, layer = lb / 24, bkt = lb % 24, g = bkt / 6; int lo, hi; bucket_pair(bkt % 6, lo, hi);
            const int e = g * 4 + (slot ? hi : lo);
            tr_item(A.in[22] + (size_t)(layer * 16 + e) * 256 * 1024, 1024, sub >> 5, sub & 31, B2 + (size_t)lb * 1024 * 512, 512, slot * 256, scr, F.lane, MapIdent()); }
    }
    { const float* x = A.in[0]; bf16* xb = (bf16*)(F.ws + WS_ABF);
      for (size_t i = (size_t)(F.vcu * 512 + F.tid); i < (size_t)NTOK * DM / 8; i += (size_t)F.G * 512) {
          const f32x4 a = *(const f32x4*)(x + i * 8), b = *(const f32x4*)(x + i * 8 + 4);
          v4u o; o.x = pk2(a[0], a[1]); o.y = pk2(a[2], a[3]); o.z = pk2(b[0], b[1]); o.w = pk2(b[2], b[3]); *(v4u*)(xb + i * 8) = o; } }
    { const int* pos = (const int*)A.in[1]; float* cosT = (float*)(F.ws + WS_COS); float* sinT = (float*)(F.ws + WS_SIN);
      for (int i = F.vcu * 512 + F.tid; i < NTOK * 32; i += F.G * 512) { const int tok = i >> 5, k = i & 31;
          const float inv = powf(10000.0f, -(float)k / 32.0f), ang = (float)pos[tok] * inv; cosT[i] = cosf(ang); sinT[i] = sinf(ang); } }
    { bf16* W1T = (bf16*)(F.ws + WS_W1T);
      for (int i = F.vcu * 512 + F.tid; i < 2 * 2048 * 128; i += F.G * 512) { const int sel = i >> 18, f = (i >> 7) & 2047, j = i & 127;
          const float v = A.in[sel ? 8 : 6][(size_t)f * 128 + j]; const int fp = sel ? f : ((f & ~63) | rope_perm(f & 63));
          W1T[(size_t)sel * 262144 + (size_t)j * 2048 + fp] = (bf16)f2bf(v); } }
    if (F.vcu < 32) { const int sel = F.vcu >> 4, j = 8 * (F.vcu & 15) + (F.tid & 7), part = F.tid >> 3; const float* pe = A.in[4 + sel]; const float* w1 = A.in[sel ? 8 : 6]; float s = 0.f;
#pragma unroll 8
        for (int i = part * 32; i < part * 32 + 32; ++i) s = fmaf(pe[i], w1[(size_t)i * 128 + j], s);
        __syncthreads();
        LAS float* red = (LAS float*)F.lds; red[F.tid] = s; __syncthreads();
        if (F.tid < 8) { float t = 0.f; for (int k = 0; k < 64; ++k) t += red[k * 8 + F.tid]; ((float*)(F.ws + WS_POSB))[sel * 128 + 8 * (F.vcu & 15) + F.tid] = t; } }
}

__device__ __forceinline__ float gelu_tanh(float x) { const float u = 0.7978845608028654f * (x + 0.044715f * x * x * x); return 0.5f * x * (1.0f + tanhf(u)); }
__device__ __forceinline__ void p2_compress(Frame& F, const Args& A) {
    typedef short bf16x8_ __attribute__((ext_vector_type(8))); typedef float f32x16_ __attribute__((ext_vector_type(16)));
    LAS float* part = (LAS float*)F.lds;
    LAS float* hid = (LAS float*)(F.lds + 32768);
    const bf16* qkv = (const bf16*)(F.ws + WS_QKV); const bf16* W1T = (const bf16*)(F.ws + WS_W1T);
    const float* posb = (const float*)(F.ws + WS_POSB);
    const int lane = F.lane, r32 = lane & 31, hi = lane >> 5, cg = F.wave & 3, kh = F.wave >> 2;
    for (int tile = F.vcu; tile < 256; tile += F.G) {
        const int sel = tile >> 7, bkv = (tile >> 4) & 7, n0 = (tile & 15) * 32;
        const bf16* src = qkv + (sel ? pg8::E_VCMP : pg8::E_KCMP) + (size_t)bkv * SEQ * 64;
        const float* w2 = A.in[sel ? 9 : 7];
        const int nrow = min(n0 + r32, 510);
        const bf16* ap = src + (size_t)nrow * 1024 + kh * 1024 + 8 * hi;
        const bf16* bp = W1T + (size_t)sel * 262144 + (size_t)(32 * cg + r32) * 2048 + kh * 1024 + 8 * hi;
        f32x16_ acc;
#pragma unroll
        for (int r = 0; r < 16; ++r) acc[r] = 0.f;
#pragma unroll 8
        for (int kk = 0; kk < 64; ++kk) { const bf16x8_ a = *(const bf16x8_*)(ap + 16 * kk), bb = *(const bf16x8_*)(bp + 16 * kk);
            acc = __builtin_amdgcn_mfma_f32_32x32x16_bf16(a, bb, acc, 0, 0, 0); }
#pragma unroll
        for (int r = 0; r < 16; ++r) part[kh * 4096 + ((r & 3) + 8 * (r >> 2) + 4 * hi) * 128 + 32 * cg + r32] = acc[r];
        __syncthreads();
        for (int idx = F.tid; idx < 4096; idx += 512) { const float x = part[idx] + part[4096 + idx] + posb[sel * 128 + (idx & 127)]; hid[idx] = gelu_tanh(x); }
        __syncthreads();
        { const int row = F.tid >> 4, c0 = (F.tid & 15) * 4; float y0 = 0.f, y1 = 0.f, y2 = 0.f, y3 = 0.f;
          for (int jj = 0; jj < 128; ++jj) { const float hv = hid[row * 128 + jj]; const f32x4 wv = *(const f32x4*)(w2 + jj * 64 + c0); y0 = fmaf(hv, wv[0], y0); y1 = fmaf(hv, wv[1], y1); y2 = fmaf(hv, wv[2], y2); y3 = fmaf(hv, wv[3], y3); }
          bf16* dst = (bf16*)(F.ws + (sel ? WS_VC : WS_KC)) + ((size_t)bkv * 512 + n0 + row) * 64;
          if (sel) { v2u w; w.x = pk2(y0, y1); w.y = pk2(y2, y3); *(v2u*)(dst + c0) = w; }
          else { dst[rope_perm(c0)] = (bf16)f2bf(y0); dst[rope_perm(c0 + 1)] = (bf16)f2bf(y1); dst[rope_perm(c0 + 2)] = (bf16)f2bf(y2); dst[rope_perm(c0 + 3)] = (bf16)f2bf(y3); } }
        __syncthreads();
    }
    { const bf16* km = qkv + pg8::E_KM; float* kmean = (float*)(F.ws + WS_KMEAN);
      for (int it = F.vcu * NWAVES + F.wave; it < 1024; it += F.G * NWAVES) { const int bh = it >> 5, blk = it & 31; float s = 0.f;
          const bf16* p = km + ((size_t)bh * SEQ + blk * 256) * 64 + F.lane;
          for (int i = 0; i < 256; ++i) s += bf2f(p[(size_t)i * 64]);
          const float mean = s * (1.0f / 256.0f); kmean[(size_t)it * 64 + F.lane] = mean;
          const unsigned hb = f2bf(mean); const float hf = __builtin_bit_cast(float, hb << 16);
          ((bf16*)(F.ws + WS_KMH))[(size_t)it * 64 + F.lane] = (bf16)hb; ((bf16*)(F.ws + WS_KML))[(size_t)it * 64 + F.lane] = (bf16)f2bf(mean - hf); } }
}

__device__ __forceinline__ void ldrow(const bf16* p, unsigned (&r)[32]) {
#pragma unroll
    for (int i = 0; i < 8; ++i) { const v4u t = *(const v4u*)(p + 8 * i); r[4 * i] = t.x; r[4 * i + 1] = t.y; r[4 * i + 2] = t.z; r[4 * i + 3] = t.w; }
}
__device__ __forceinline__ float dot64(const unsigned (&q)[32], const unsigned (&k)[32]) {
    float s0 = 0.f, s1 = 0.f;
#pragma unroll
    for (int i = 0; i < 32; ++i) { s0 = fmaf(bflo(q[i]), bflo(k[i]), s0); s1 = fmaf(bfhi(q[i]), bfhi(k[i]), s1); }
    return s0 + s1;
}
__device__ __forceinline__ void osm_step(bool ok, float s, float& m, float& l, float (&o)[64], const unsigned (&v)[32]) {
    if (ok) {
        if (s > m) { const float f = __expf(m - s); l *= f;
#pragma unroll
            for (int i = 0; i < 64; ++i) o[i] *= f;
            m = s; }
        const float p = __expf(s - m); l += p;
#pragma unroll
        for (int i = 0; i < 32; ++i) { o[2 * i] = fmaf(p, bflo(v[i]), o[2 * i]); o[2 * i + 1] = fmaf(p, bfhi(v[i]), o[2 * i + 1]); }
    }
}

__device__ __forceinline__ void p3_nsa_naive(Frame& F, const Args& A, bf16* O) {
    LAS float* imp = (LAS float*)F.lds;
    const bf16* qkv = (const bf16*)(F.ws + WS_QKV);
    const float* gates = (const float*)(F.ws + WS_GATES);
    const bf16* KC = (const bf16*)(F.ws + WS_KC); const bf16* VC = (const bf16*)(F.ws + WS_VC);
    for (int item = F.vcu; item < 512; item += F.G) {
        const int b = item >> 7, kv = (item >> 6) & 1, qt = item & 63;
        const int ql = F.tid >> 2, g = F.tid & 3, t = qt * 128 + ql, h = kv * 4 + g, tok = b * SEQ + t;
        unsigned q[32]; ldrow(qkv + pg8::E_QA + ((size_t)(b * 8 + h) * SEQ + t) * 64, q);
        float o[64]; float* otp = (float*)(F.ws + WS_ABF) + (size_t)tok * 512 + h * 64;
        for (int i = F.tid; i < 128 * 129; i += 512) imp[i] = 0.f;
        __syncthreads();
        const float g0 = gates[(size_t)tok * 24 + h * 3 + 0], g1 = gates[(size_t)tok * 24 + h * 3 + 1], g2 = gates[(size_t)tok * 24 + h * 3 + 2];
        const int nvis = t >= 31 ? min((t - 31) / 16 + 1, 511) : 0;
        const int nbound = min((qt * 128 + 127 - 31) / 16 + 1, 511);
        const bf16* kcp = KC + (size_t)(b * 2 + kv) * 512 * 64; const bf16* vcp = VC + (size_t)(b * 2 + kv) * 512 * 64;
        float m = -1e30f, l = 0.f;
#pragma unroll
        for (int i = 0; i < 64; ++i) o[i] = 0.f;
        for (int n = 0; n < nbound; ++n) { unsigned kr[32]; ldrow(kcp + (size_t)n * 64, kr);
            const float s = dot64(q, kr) * NAIVE_SC; asm volatile("" ::: "memory"); ldrow(vcp + (size_t)n * 64, kr); osm_step(n < nvis, s, m, l, o, kr); }
        float linv = 1.0f / fmaxf(l, 1e-30f);
#pragma unroll
        for (int i = 0; i < 16; ++i) { f32x4 w; w[0] = g0 * linv * o[4 * i]; w[1] = g0 * linv * o[4 * i + 1]; w[2] = g0 * linv * o[4 * i + 2]; w[3] = g0 * linv * o[4 * i + 3]; *(f32x4*)(otp + 4 * i) = w; }
        { float acc = 0.f;
          for (int n = 0; n < nbound; ++n) { unsigned kr[32]; ldrow(kcp + (size_t)n * 64, kr);
              const float s = dot64(q, kr) * NAIVE_SC; float p = (n < nvis) ? __expf(s - m) * linv : 0.f;
              p += __shfl_xor(p, 1); p += __shfl_xor(p, 2); acc += p;
              if ((n & 3) == 3) { if (g == 0) imp[ql * 129 + (n >> 2)] = acc; acc = p; } } }
        __syncthreads();
        const int cur = t >> 6; unsigned m0 = 0u, m1 = 0u, m2 = 0u, m3 = 0u;
#define SETBIT(j) do { const unsigned _b = 1u << ((j) & 31); const int _w = (j) >> 5; m0 |= _w == 0 ? _b : 0u; m1 |= _w == 1 ? _b : 0u; m2 |= _w == 2 ? _b : 0u; m3 |= _w == 3 ? _b : 0u; } while (0)
        if (cur < 16) { m0 = (1u << (cur + 1)) - 1u; }
        else { SETBIT(0); SETBIT(cur - 1); SETBIT(cur);
            for (int r = 0; r < 13; ++r) { float best = -0.5f; int bj = 1;
                for (int j = 1; j <= cur - 2; ++j) { const float v = imp[ql * 129 + j]; if (v > best) { best = v; bj = j; } }
                imp[ql * 129 + bj] = -1.0f; SETBIT(bj); } }
        m = -1e30f; l = 0.f;
#pragma unroll
        for (int i = 0; i < 64; ++i) o[i] = 0.f;
        { const bf16* kb = qkv + pg8::E_KSLC + (size_t)(b * 2 + kv) * SEQ * 64; const bf16* vb = qkv + pg8::E_VSLC + (size_t)(b * 2 + kv) * SEQ * 64;
          for (int it = 0; it < 16; ++it) {
              const bool have = (m0 | m1 | m2 | m3) != 0u; int j = 0;
              if (m0) { j = __builtin_ctz(m0); m0 &= m0 - 1u; } else if (m1) { j = 32 + __builtin_ctz(m1); m1 &= m1 - 1u; }
              else if (m2) { j = 64 + __builtin_ctz(m2); m2 &= m2 - 1u; } else if (m3) { j = 96 + __builtin_ctz(m3); m3 &= m3 - 1u; }
              for (int kk = 0; kk < 64; ++kk) { const int row = j * 64 + kk; unsigned kr[32]; ldrow(kb + (size_t)row * 64, kr);
                  const float s = dot64(q, kr) * NAIVE_SC; asm volatile("" ::: "memory"); ldrow(vb + (size_t)row * 64, kr); osm_step(have && row <= t, s, m, l, o, kr); } } }
        linv = 1.0f / fmaxf(l, 1e-30f);
#pragma unroll
        for (int i = 0; i < 16; ++i) { f32x4 w = *(const f32x4*)(otp + 4 * i); w[0] = fmaf(g1 * linv, o[4 * i], w[0]); w[1] = fmaf(g1 * linv, o[4 * i + 1], w[1]); w[2] = fmaf(g1 * linv, o[4 * i + 2], w[2]); w[3] = fmaf(g1 * linv, o[4 * i + 3], w[3]); *(f32x4*)(otp + 4 * i) = w; }
        m = -1e30f; l = 0.f;
#pragma unroll
        for (int i = 0; i < 64; ++i) o[i] = 0.f;
        { const bf16* kb = qkv + pg8::E_KWIN + (size_t)(b * 2 + kv) * SEQ * 64; const bf16* vb = qkv + pg8::E_VWIN + (size_t)(b * 2 + kv) * SEQ * 64;
          const int shi = qt * 128 + 127, slo = max(qt * 128 - 511, 0);
          for (int s_ = shi; s_ >= slo; --s_) { unsigned kr[32]; ldrow(kb + (size_t)s_ * 64, kr);
              const float s = dot64(q, kr) * NAIVE_SC; asm volatile("" ::: "memory"); ldrow(vb + (size_t)s_ * 64, kr); osm_step(s_ <= t && s_ > t - 512, s, m, l, o, kr); } }
        linv = 1.0f / fmaxf(l, 1e-30f);
        { bf16* op = O + (size_t)tok * 1024 + h * 64;
#pragma unroll
          for (int i = 0; i < 8; ++i) { const f32x4 a0 = *(const f32x4*)(otp + 8 * i), a1 = *(const f32x4*)(otp + 8 * i + 4); const float gl = g2 * linv; v4u w;
              w.x = pk2(fmaf(gl, o[8 * i], a0[0]), fmaf(gl, o[8 * i + 1], a0[1])); w.y = pk2(fmaf(gl, o[8 * i + 2], a0[2]), fmaf(gl, o[8 * i + 3], a0[3]));
              w.z = pk2(fmaf(gl, o[8 * i + 4], a1[0]), fmaf(gl, o[8 * i + 5], a1[1])); w.w = pk2(fmaf(gl, o[8 * i + 6], a1[2]), fmaf(gl, o[8 * i + 7], a1[3])); *(v4u*)(op + 8 * i) = w; } }
        __syncthreads();
    }
}

__device__ __forceinline__ void p3_moba_naive(Frame& F, const Args& A, bf16* O) {
    const bf16* qkv = (const bf16*)(F.ws + WS_QKV);
    const float* kmean = (const float*)(F.ws + WS_KMEAN);
    for (int item = F.vcu; item < 512; item += F.G) {
        const int bh = item >> 4, tile = item & 15, b = bh >> 3, h = bh & 7, t = tile * 512 + F.tid, tok = b * SEQ + t, cur = t >> 8;
        unsigned q[32]; ldrow(qkv + pg8::E_QM + ((size_t)bh * SEQ + t) * 64, q);
        float v0 = -3e38f, v1 = -3e38f, v2 = -3e38f; int i0 = -1, i1 = -1, i2 = -1;
        for (int n = 0; n < cur; ++n) { const float* kmp = kmean + ((size_t)bh * 32 + n) * 64; float gs = 0.f;
#pragma unroll
            for (int i = 0; i < 32; ++i) { gs = fmaf(bflo(q[i]), kmp[2 * i], gs); gs = fmaf(bfhi(q[i]), kmp[2 * i + 1], gs); }
            if (gs > v0) { v2 = v1; i2 = i1; v1 = v0; i1 = i0; v0 = gs; i0 = n; } else if (gs > v1) { v2 = v1; i2 = i1; v1 = gs; i1 = n; } else if (gs > v2) { v2 = gs; i2 = n; } }
        float o[64], m = -1e30f, l = 0.f;
#pragma unroll
        for (int i = 0; i < 64; ++i) o[i] = 0.f;
        const bf16* kb = qkv + pg8::E_KM + (size_t)bh * SEQ * 64; const bf16* vb = qkv + pg8::E_VM + (size_t)bh * SEQ * 64;
        for (int si = 0; si < 3; ++si) { const int j = si == 0 ? i0 : (si == 1 ? i1 : i2); const bool have = j >= 0; const int jj = have ? j : 0;
            for (int kk = 0; kk < 256; ++kk) { const int row = jj * 256 + kk; unsigned kr[32], vr[32]; ldrow(kb + (size_t)row * 64, kr); ldrow(vb + (size_t)row * 64, vr);
                const float s = dot64(q, kr) * NAIVE_SC; osm_step(have, s, m, l, o, vr); } }
        { const int r0 = (tile * 512 + (F.tid & ~63)) & ~255, r1 = tile * 512 + (F.tid | 63);
          for (int row = r0; row <= r1; ++row) { unsigned kr[32], vr[32]; ldrow(kb + (size_t)row * 64, kr); ldrow(vb + (size_t)row * 64, vr);
              const float s = dot64(q, kr) * NAIVE_SC; osm_step(row <= t, s, m, l, o, vr); } }
        const float linv = 1.0f / fmaxf(l, 1e-30f);
        { bf16* op = O + (size_t)tok * 1024 + 512 + h * 64;
#pragma unroll
          for (int i = 0; i < 8; ++i) { v4u w; w.x = pk2(o[8 * i] * linv, o[8 * i + 1] * linv); w.y = pk2(o[8 * i + 2] * linv, o[8 * i + 3] * linv); w.z = pk2(o[8 * i + 4] * linv, o[8 * i + 5] * linv); w.w = pk2(o[8 * i + 6] * linv, o[8 * i + 7] * linv); *(v4u*)(op + 8 * i) = w; } }
    }
}

__device__ __forceinline__ void p11_sb_naive(Frame& F, const Args& A) {
    const bf16* qkv = (const bf16*)(F.ws + WS_QKV);
    bf16* O = (bf16*)(F.ws + WS_O);
    for (int item = F.vcu; item < 1024; item += F.G) {
        const int bh = item >> 4, tile = item & 15, b = bh >> 4, h = bh & 15, t = tile * 512 + F.tid, tok = b * SEQ + t;
        unsigned q[32]; ldrow(qkv + ((size_t)bh * SEQ + t) * 64, q);
        const bf16* kb = qkv + (size_t)33554432 + (size_t)bh * SEQ * 64; const bf16* vb = qkv + (size_t)67108864 + (size_t)bh * SEQ * 64;
        float o[64], C = 0.f;
#pragma unroll
        for (int i = 0; i < 64; ++i) o[i] = 0.f;
        for (int s_ = tile * 512 + (F.tid | 63) - 1; s_ >= 0; --s_) {
            if (!__any(C > -120.f)) break;
            unsigned kr[32], vr[32]; ldrow(kb + (size_t)s_ * 64, kr); ldrow(vb + (size_t)s_ * 64, vr);
            const float z = dot64(q, kr) * NAIVE_SC, sp = fmaxf(z, 0.f) + __logf(1.0f + __expf(-fabsf(z)));
            if (s_ < t && C > -120.f) { const float w = __expf(z - sp + C); C -= sp;
#pragma unroll
                for (int i = 0; i < 32; ++i) { o[2 * i] = fmaf(w, bflo(vr[i]), o[2 * i]); o[2 * i + 1] = fmaf(w, bfhi(vr[i]), o[2 * i + 1]); } } }
        { bf16* op = O + (size_t)tok * 1024 + h * 64;
#pragma unroll
          for (int i = 0; i < 8; ++i) { v4u w; w.x = pk2(o[8 * i], o[8 * i + 1]); w.y = pk2(o[8 * i + 2], o[8 * i + 3]); w.z = pk2(o[8 * i + 4], o[8 * i + 5]); w.w = pk2(o[8 * i + 6], o[8 * i + 7]); *(v4u*)(op + 8 * i) = w; } }
    }
}

template <bool ROUTE, bool FINAL>
__device__ __forceinline__ void ln_phase(Frame& F, const Args& A, int layer, const float* gain, const float* bias, bf16* RB, float* outf) {
    const int TPW = NTOK / F.G, tok_lo = F.vcu * TPW;
    LAS float* WR = (LAS float*)F.lds;
    LAS int* hist = (LAS int*)(F.lds + 81920);
    if (ROUTE) {
        if (F.tid < 24) hist[F.tid] = 0;
        const float* wg = A.in[16] + (size_t)layer * 1024 * 4; const float* wrt = A.in[18] + (size_t)layer * 4 * 1024 * 4;
        for (int i = F.tid; i < 20 * 1024; i += 512) { const int c = i >> 10, k = i & 1023; WR[i] = c < 4 ? wg[k * 4 + c] : wrt[(size_t)((c - 4) >> 2) * 4096 + k * 4 + ((c - 4) & 3)]; }
        int* rowmap = (int*)(F.ws + WS_ROWMAP);
        for (int i = F.vcu * 512 + F.tid; i < MAXROWS; i += F.G * 512) rowmap[i] = -1;
        __syncthreads();
    }
    f32x4 gn[4], bs[4];
#pragma unroll
    for (int j = 0; j < 4; ++j) { gn[j] = *(const f32x4*)(gain + 4 * F.lane + 256 * j); bs[j] = *(const f32x4*)(bias + 4 * F.lane + 256 * j); }
    for (int ir = F.wave; ir < TPW; ir += NWAVES) { const int mrow = tok_lo + ir;
        bf16* xr = RB + (size_t)mrow * DM + 4 * F.lane;
        f32x4 v[4]; float s = 0.f;
#pragma unroll
        for (int j = 0; j < 4; ++j) { const v2u b = *(const v2u*)(xr + 256 * j); v[j][0] = bflo(b.x); v[j][1] = bfhi(b.x); v[j][2] = bflo(b.y); v[j][3] = bfhi(b.y); s += (v[j][0] + v[j][1]) + (v[j][2] + v[j][3]); }
        const float mean = wave_sum(s) * (1.f / DM); float s2 = 0.f;
#pragma unroll
        for (int j = 0; j < 4; ++j) { v[j] = v[j] - mean; s2 += (v[j][0] * v[j][0] + v[j][1] * v[j][1]) + (v[j][2] * v[j][2] + v[j][3] * v[j][3]); }
        const float rstd = 1.f / sqrtf(wave_sum(s2) * (1.f / DM) + LN_EPS);
#pragma unroll
        for (int j = 0; j < 4; ++j) { v[j] = v[j] * rstd * gn[j] + bs[j];
            if (FINAL) *(f32x4*)(outf + (size_t)mrow * DM + 4 * F.lane + 256 * j) = v[j];
            else { v2u w; w.x = pk2(v[j][0], v[j][1]); w.y = pk2(v[j][2], v[j][3]); *(v2u*)(xr + 256 * j) = w; } }
        if (ROUTE) {
            float lg[4];
#pragma unroll
            for (int c = 0; c < 4; ++c) { float p = 0.f;
#pragma unroll
                for (int j = 0; j < 4; ++j) { const f32x4 w = *(const LAS f32x4*)(WR + c * 1024 + 4 * F.lane + 256 * j); p += (v[j][0] * w[0] + v[j][1] * w[1]) + (v[j][2] * w[2] + v[j][3] * w[3]); }
                lg[c] = wave_sum(p) + A.in[17][layer * 4 + c]; }
            int g = 0; float gm = lg[0];
#pragma unroll
            for (int c = 1; c < 4; ++c) if (lg[c] > gm) { gm = lg[c]; g = c; }
            const float wgp = 1.0f / ((__expf(lg[0] - gm) + __expf(lg[1] - gm)) + (__expf(lg[2] - gm) + __expf(lg[3] - gm)));
            float le[4];
#pragma unroll
            for (int e = 0; e < 4; ++e) { float p = 0.f;
#pragma unroll
                for (int j = 0; j < 4; ++j) { const f32x4 w = *(const LAS f32x4*)(WR + (4 + g * 4 + e) * 1024 + 4 * F.lane + 256 * j); p += (v[j][0] * w[0] + v[j][1] * w[1]) + (v[j][2] * w[2] + v[j][3] * w[3]); }
                le[e] = wave_sum(p) + A.in[19][layer * 16 + g * 4 + e]; }
            int i1 = 0; float e1 = le[0];
#pragma unroll
            for (int e = 1; e < 4; ++e) if (le[e] > e1) { e1 = le[e]; i1 = e; }
            int i2 = -1; float e2 = -3e38f;
#pragma unroll
            for (int e = 0; e < 4; ++e) if (e != i1 && le[e] > e2) { e2 = le[e]; i2 = e; }
            const float w1 = 1.0f / (1.0f + __expf(e2 - e1)), w2 = 1.0f - w1;
            const int lo = min(i1, i2), hi = max(i1, i2), pi = lo == 0 ? hi - 1 : (lo == 1 ? hi + 1 : 5), bkt = g * 6 + pi;
            const float wlo = (i1 < i2 ? w1 : w2) * wgp, whi = (i1 < i2 ? w2 : w1) * wgp;
            if (F.lane == 0) { f32x4 ti; ti[0] = __builtin_bit_cast(float, bkt); ti[1] = 0.f; ti[2] = wlo; ti[3] = whi; *(f32x4*)(F.ws + WS_TOKI + (size_t)mrow * 16) = ti; }
            if (F.lane == 0) __hip_atomic_fetch_add(hist + bkt, 1, __ATOMIC_RELAXED, __HIP_MEMORY_SCOPE_WORKGROUP);
        }
    }
    if (ROUTE) { __syncthreads(); if (F.tid < 24) ((int*)(F.ws + WS_HIST))[F.vcu * 24 + F.tid] = hist[F.tid]; }
}
__device__ __forceinline__ void scatter_phase(Frame& F) {
    const int TPW = NTOK / F.G, tok_lo = F.vcu * TPW;
    LAS int* ptab = (LAS int*)(F.lds + PTAB_OFF); LAS int* pstart = (LAS int*)(F.lds + PTAB_OFF + 1024);
    LAS int* cnt = (LAS int*)(F.lds + PTAB_OFF + 1280); LAS int* lt = (LAS int*)(F.lds + PTAB_OFF + 1408);
    LAS int* H = (LAS int*)F.lds;
    LAS int* dstl = (LAS int*)(F.lds + 32768); LAS int* bkl = (LAS int*)(F.lds + 36864);
    __syncthreads();
    for (int i = F.tid; i < F.G * 24; i += 512) H[i] = ((const int*)(F.ws + WS_HIST))[i];
    for (int i = F.tid; i < TPW; i += 512) bkl[i] = *(const int*)(F.ws + WS_TOKI + (size_t)(tok_lo + i) * 16);
    __syncthreads();
    if (F.tid < 24) { int c = 0, l = 0; for (int v = 0; v < F.G; ++v) { const int h = H[v * 24 + F.tid]; c += h; l += v < F.vcu ? h : 0; } cnt[F.tid] = c; lt[F.tid] = l; }
    __syncthreads();
    if (F.tid == 0) { int p = 0;
        for (int bkt = 0; bkt < 24; ++bkt) { const int np = (cnt[bkt] + 255) >> 8;
            pstart[bkt] = p; for (int i = 0; i < np && p < MAXPAN; ++i) ptab[p++] = bkt; }
        pstart[24] = p;
        for (int i = 0; i < TPW; ++i) { const int bkt = bkl[i]; dstl[i] = pstart[bkt] * 256 + lt[bkt]; lt[bkt] = lt[bkt] + 1; } }
    __syncthreads();
    if (F.vcu == 0) { int* gt = (int*)(F.ws + WS_GTAB); const int np = pstart[24]; if (F.tid == 0) gt[0] = np; if (F.tid < np) gt[1 + F.tid] = ptab[F.tid]; }
    int* rowmap = (int*)(F.ws + WS_ROWMAP); float* wrow = (float*)(F.ws + WS_WROW);
    for (int i = F.tid; i < TPW; i += 512) {
        const int mrow = tok_lo + i, dst = dstl[i];
        const f32x4 ti = *(const f32x4*)(F.ws + WS_TOKI + (size_t)mrow * 16);
        rowmap[dst] = mrow; wrow[(size_t)dst * 2] = ti[2]; wrow[(size_t)dst * 2 + 1] = ti[3];
    }
    __syncthreads();
}
__device__ __forceinline__ int load_ptab(Frame& F) {
    LAS int* ptab = (LAS int*)(F.lds + PTAB_OFF); const int* gt = (const int*)(F.ws + WS_GTAB);
    __syncthreads();
    const int np = gt[0];
    if (F.tid < np && F.tid < MAXPAN) ptab[F.tid] = gt[1 + F.tid];
    __syncthreads();
    return np < MAXPAN ? np : MAXPAN;
}
struct MoeOrder1 {
    static constexpr bool GATHER = true;
    int G, c, nunits; const LAS int* ptab; const bf16* W1E; const int* rowmap;
    __device__ __forceinline__ int arow(const pg8::Unit& u, int r) const { const int t = rowmap[u.pm * 256 + r]; return t < 0 ? 0 : t; }
    __device__ __forceinline__ bool next(int i, pg8::Unit& u) const { const int L = i * G + c; if (L >= nunits) return false; u.pm = L >> 2; u.pn = L & 3; u.aux = __builtin_amdgcn_readfirstlane(ptab[u.pm]); return true; }
    __device__ __forceinline__ const char* aptr(const pg8::Gemm& g, const pg8::Unit& u, size_t tstep) const { return (const char*)g.A + (size_t)u.pm * tstep; }
    __device__ __forceinline__ const char* bptr(const pg8::Gemm& g, const pg8::Unit& u, size_t tstep) const {
        const int grp = u.aux / 6; int lo, hi; bucket_pair(u.aux % 6, lo, hi); const int e = grp * 4 + ((u.pn >> 1) ? hi : lo);
        return (const char*)(W1E + ((size_t)e * 512 + (size_t)(u.pn & 1) * 256) * 1024); }
    __device__ __forceinline__ void a_ready(const pg8::Unit&) const {}
    __device__ __forceinline__ void done(const pg8::Unit&) const {}
};
struct MoeOrder2 {
    static constexpr bool GATHER = false;
    __device__ __forceinline__ int arow(const pg8::Unit&, int) const { return 0; }
    int G, c, nunits; const LAS int* ptab; const bf16* B2;
    __device__ __forceinline__ bool next(int i, pg8::Unit& u) const { const int L = i * G + c; if (L >= nunits) return false; u.pm = L >> 2; u.pn = L & 3; u.aux = __builtin_amdgcn_readfirstlane(ptab[u.pm]); return true; }
    __device__ __forceinline__ const char* aptr(const pg8::Gemm& g, const pg8::Unit& u, size_t tstep) const { return (const char*)g.A + (size_t)u.pm * tstep; }
    __device__ __forceinline__ const char* bptr(const pg8::Gemm& g, const pg8::Unit& u, size_t tstep) const { return (const char*)(B2 + ((size_t)u.aux * 1024 + (size_t)u.pn * 256) * 512); }
    __device__ __forceinline__ void a_ready(const pg8::Unit&) const {}
    __device__ __forceinline__ void done(const pg8::Unit&) const {}
};

#define KOFF(i) (32 * ((i) >> 4) + 8 * (((i) & 15) >> 2) + ((i) & 3))
typedef short bf16x8 __attribute__((ext_vector_type(8)));
typedef short s16x4 __attribute__((ext_vector_type(4)));
typedef float f32x16 __attribute__((ext_vector_type(16)));
#define MFMA32(a, b, c) __builtin_amdgcn_mfma_f32_32x32x16_bf16(a, b, c, 0, 0, 0)
#ifndef SB_EXIT
#define SB_EXIT 1
#endif
constexpr float L2E = 1.4426950408889634f, LN2 = 0.6931471805599453f;
__device__ __forceinline__ int crow(int r, int hi) { return (r & 3) + 8 * (r >> 2) + 4 * hi; }
typedef __bf16 bf16x2_t __attribute__((ext_vector_type(2)));
__device__ __forceinline__ unsigned cvtpk(float lo, float hi) { bf16x2_t v; v[0] = (__bf16)lo; v[1] = (__bf16)hi; return __builtin_bit_cast(unsigned, v); }
__device__ __forceinline__ void swap32(float v, float& r0, float& r1) { unsigned a = __builtin_bit_cast(unsigned, v), b = a;
    asm volatile("v_nop\n\tv_nop\n\tv_permlane32_swap_b32 %0, %1" : "+v"(a), "+v"(b)); r0 = __builtin_bit_cast(float, a); r1 = __builtin_bit_cast(float, b); }
__device__ __forceinline__ float swap_sum(float v) { float r0, r1; swap32(v, r0, r1); return r0 + r1; }
__device__ __forceinline__ float swap_max(float v) { float r0, r1; swap32(v, r0, r1); return fmaxf(r0, r1); }
__device__ __forceinline__ float swap_other(float v, int hi) { float r0, r1; swap32(v, r0, r1); return hi ? r0 : r1; }
__device__ __forceinline__ void kv_issue(const bf16* Kt, const bf16* Vt, int wave, int lane, v4u& kr, v4u& vr) {
    kr = *(const v4u*)(Kt + (size_t)lane * 64 + wave * 8);
    vr = *(const v4u*)(Vt + (size_t)(16 * (wave & 3) + (lane >> 2)) * 64 + (wave >> 2) * 32 + (lane & 3) * 8);
}
__device__ __forceinline__ void kv_commit(LAS unsigned char* kbuf, LAS unsigned char* vbuf, int wave, int lane, const v4u& kr, const v4u& vr) {
    *(LAS v4u*)(kbuf + wave * 1024 + lane * 16) = kr; *(LAS v4u*)(vbuf + wave * 1024 + lane * 16) = vr;
}
__device__ __forceinline__ void qk_tile(const LAS unsigned char* kbuf, const bf16x8 (&qr)[4], int r32, int hi, f32x16& p0, f32x16& p1) {
#pragma unroll
    for (int r = 0; r < 16; ++r) { p0[r] = 0.f; p1[r] = 0.f; }
#pragma unroll
    for (int d0 = 0; d0 < 4; ++d0) { const LAS unsigned char* kp = kbuf + (2 * d0 + hi) * 1024 + r32 * 16;
        const bf16x8 k0 = *(const LAS bf16x8*)kp, k1 = *(const LAS bf16x8*)(kp + 512);
        p0 = MFMA32(k0, qr[d0], p0); p1 = MFMA32(k1, qr[d0], p1); }
}
__device__ __forceinline__ s16x4 vtr(const LAS unsigned char* p) { return __builtin_bit_cast(s16x4, __builtin_amdgcn_ds_read_tr16_b64_v4i16((LAS s16x4*)p)); }
__device__ __forceinline__ void pv_tile(const LAS unsigned char* vbuf, const f32x16& p0, const f32x16& p1, f32x16 (&o)[2], int lane, int hi) {
    const LAS unsigned char* vp0 = vbuf + ((lane >> 4) & 1) * 32 + (lane & 3) * 8 + (4 * hi + ((lane & 15) >> 2)) * 64;
#pragma unroll
    for (int s = 0; s < 4; ++s) { const int rb = 8 * (s & 1); v4u w;
        if (s < 2) { w.x = cvtpk(p0[rb], p0[rb + 1]); w.y = cvtpk(p0[rb + 2], p0[rb + 3]); w.z = cvtpk(p0[rb + 4], p0[rb + 5]); w.w = cvtpk(p0[rb + 6], p0[rb + 7]); }
        else       { w.x = cvtpk(p1[rb], p1[rb + 1]); w.y = cvtpk(p1[rb + 2], p1[rb + 3]); w.z = cvtpk(p1[rb + 4], p1[rb + 5]); w.w = cvtpk(p1[rb + 6], p1[rb + 7]); }
        const bf16x8 pb = __builtin_bit_cast(bf16x8, w);
#pragma unroll
        for (int dh = 0; dh < 2; ++dh) {
#ifdef DBG_SAFE_TR
            bf16x8 a;
#pragma unroll
            for (int j = 0; j < 8; ++j) { const int key = 16 * s + 8 * (j >> 2) + 4 * hi + (j & 3); a[j] = *(const LAS short*)(vbuf + dh * 4096 + key * 64 + (lane & 31) * 2); }
#else
            const s16x4 lo = vtr(vp0 + dh * 4096 + s * 1024), hi4 = vtr(vp0 + dh * 4096 + s * 1024 + 512);
            bf16x8 a; a[0] = lo[0]; a[1] = lo[1]; a[2] = lo[2]; a[3] = lo[3]; a[4] = hi4[0]; a[5] = hi4[1]; a[6] = hi4[2]; a[7] = hi4[3];
#endif
            o[dh] = MFMA32(a, pb, o[dh]); }
        __builtin_amdgcn_sched_barrier(0); }
}
__device__ __forceinline__ void store_o(bf16* orow, const f32x16 (&o)[2], int hi, float sc) {
#pragma unroll
    for (int dh = 0; dh < 2; ++dh)
#pragma unroll
        for (int g = 0; g < 4; ++g) { v2u w; w.x = pk2(o[dh][4 * g] * sc, o[dh][4 * g + 1] * sc); w.y = pk2(o[dh][4 * g + 2] * sc, o[dh][4 * g + 3] * sc);
            *(v2u*)(orow + 32 * dh + 8 * g + 4 * hi) = w; }
}

__device__ __forceinline__ void sb_process(f32x16& p0, f32x16& p1, int thr, int hi, float& A) {
    float sp[32], T[8];
#pragma unroll
    for (int i = 0; i < 32; ++i) { const float z = i < 16 ? p0[i] : p1[i - 16];
        const float e = __builtin_amdgcn_exp2f(-fabsf(z)), spv = fmaxf(z, 0.f) + __builtin_amdgcn_logf(1.0f + e);
        const bool valid = KOFF(i) < thr; sp[i] = valid ? spv : 0.f; const float zz = valid ? (z - spv) : -1e30f;
        if (i < 16) p0[i] = zz; else p1[i - 16] = zz; }
#pragma unroll
    for (int u = 0; u < 8; ++u) T[u] = (sp[4 * u] + sp[4 * u + 1]) + (sp[4 * u + 2] + sp[4 * u + 3]);
    float after = A;
#pragma unroll
    for (int u = 7; u >= 0; --u) { const float pt = swap_sum(T[u]); const float hb = after + (hi ? 0.f : (pt - T[u]));
        float inrun = 0.f;
#pragma unroll
        for (int e = 3; e >= 0; --e) { const int i = 4 * u + e; const float zz = i < 16 ? p0[i] : p1[i - 16];
            const float w = __builtin_amdgcn_exp2f(zz - hb - inrun); if (i < 16) p0[i] = w; else p1[i - 16] = w; inrun += sp[i]; }
        after += pt; }
    A = after;
}
__device__ __forceinline__ void p11_sb_mfma(Frame& F) {
    const bf16* Qg = (const bf16*)(F.ws + WS_QKV); const bf16* Kg = Qg + (size_t)33554432; const bf16* Vg = Qg + (size_t)67108864;
    bf16* O = (bf16*)(F.ws + WS_O);
    LAS unsigned char* L = F.lds; volatile LAS unsigned* flag = (volatile LAS unsigned*)(F.lds + 32768);
    const int lane = F.lane, r32 = lane & 31, hi = lane >> 5, w = F.wave;
    for (int unit = F.vcu; unit < 2048; unit += F.G) {
        const int bh = unit >> 5, qb = unit & 31, b = bh >> 4, h = bh & 15, Q0 = qb * 256, tq = Q0 + 32 * w + r32;
        const bf16* Kh = Kg + (size_t)bh * SEQ * 64; const bf16* Vh = Vg + (size_t)bh * SEQ * 64;
        bf16x8 qr[4];
#pragma unroll
        for (int d0 = 0; d0 < 4; ++d0) qr[d0] = *(const bf16x8*)(Qg + ((size_t)bh * SEQ + tq) * 64 + 16 * d0 + 8 * hi);
        f32x16 o[2];
#pragma unroll
        for (int r = 0; r < 16; ++r) { o[0][r] = 0.f; o[1][r] = 0.f; }
        float A = 0.f; const int kt_top = (Q0 >> 6) + 3, my_top = (Q0 >> 6) + (w >> 1);
        bool done = false;
        if (F.tid == 0) { flag[0] = 0u; flag[1] = 0u; flag[2] = 0u; }
        { v4u kr, vr; kv_issue(Kh + (size_t)kt_top * 4096, Vh + (size_t)kt_top * 4096, w, lane, kr, vr); kv_commit(L, L + 16384, w, lane, kr, vr); }
        __syncthreads();
        for (int i = 0, kt = kt_top; kt >= 0; ++i, --kt) {
            const int cb = i & 1; v4u kr, vr;
            if (kt > 0) kv_issue(Kh + (size_t)(kt - 1) * 4096, Vh + (size_t)(kt - 1) * 4096, w, lane, kr, vr);
            if (!done && kt <= my_top) {
                f32x16 p0, p1; qk_tile(L + cb * 8192, qr, r32, hi, p0, p1);
                sb_process(p0, p1, tq - 64 * kt - 4 * hi, hi, A);
                pv_tile(L + 16384 + cb * 8192, p0, p1, o, lane, hi);
                if (SB_EXIT && __all(A > 174.f)) done = true;
            }
            const int fi = i % 3; if (F.tid == 0) flag[(i + 1) % 3] = 0u;
            if (done && lane == 0) __hip_atomic_fetch_or((LAS unsigned*)(F.lds + 32768) + fi, 1u << w, __ATOMIC_RELAXED, __HIP_MEMORY_SCOPE_WORKGROUP);
            if (kt > 0) kv_commit(L + (cb ^ 1) * 8192, L + 16384 + (cb ^ 1) * 8192, w, lane, kr, vr);
            __syncthreads();
            if (flag[fi] == 0xFFu) break;
        }
        store_o(O + (size_t)(b * SEQ + tq) * 1024 + h * 64, o, hi, 1.0f);
        __syncthreads();
    }
}

struct TileMask { int lo, hi_; bool on; };
__device__ __forceinline__ void sm_process(f32x16& p0, f32x16& p1, float& m, float& l, f32x16 (&o)[2], const TileMask tm) {
    float mx = -1e30f;
    if (__all(tm.on && tm.lo < 0 && tm.hi_ >= 63)) {
#pragma unroll
        for (int i = 0; i < 32; ++i) { const float x = i < 16 ? p0[i] : p1[i - 16]; mx = fmaxf(mx, x); }
    } else {
        const int lo = tm.on ? tm.lo : 1000, hi_ = tm.hi_;
#pragma unroll
        for (int i = 0; i < 32; ++i) { const float s = i < 16 ? p0[i] : p1[i - 16]; const float x = (KOFF(i) > lo && KOFF(i) <= hi_) ? s : -INFINITY; if (i < 16) p0[i] = x; else p1[i - 16] = x; mx = fmaxf(mx, x); }
    }
    mx = swap_max(mx);
    const float mnew = fmaxf(m, mx), alpha = __builtin_amdgcn_exp2f(m - mnew);
    float ls = 0.f;
#pragma unroll
    for (int i = 0; i < 32; ++i) { const float x = i < 16 ? p0[i] : p1[i - 16]; const float pv = __builtin_amdgcn_exp2f(x - mnew); if (i < 16) p0[i] = pv; else p1[i - 16] = pv; ls += pv; }
    l = l * alpha + ls; m = mnew;
    if (!__all(alpha == 1.0f)) {
#pragma unroll
        for (int r = 0; r < 16; ++r) { o[0][r] *= alpha; o[1][r] *= alpha; } }
}
template <class Act, class Mask>
__device__ __forceinline__ void sm_stream(Frame& F, const bf16* Kh, const bf16* Vh, int t0, int t1, const bf16x8 (&qr)[4], float& m, float& l, f32x16 (&o)[2], Act act, Mask mask) {
    if (t0 >= t1) return;
    LAS unsigned char* L = F.lds; const int lane = F.lane, r32 = lane & 31, hi = lane >> 5, w = F.wave;
    { v4u kr, vr; kv_issue(Kh + (size_t)t0 * 4096, Vh + (size_t)t0 * 4096, w, lane, kr, vr); kv_commit(L, L + 16384, w, lane, kr, vr); }
    __syncthreads();
    for (int t = t0; t < t1; ++t) {
        const int cb = (t - t0) & 1; v4u kr, vr;
        if (t + 1 < t1) kv_issue(Kh + (size_t)(t + 1) * 4096, Vh + (size_t)(t + 1) * 4096, w, lane, kr, vr);
        if (act(t)) { f32x16 p0, p1; qk_tile(L + cb * 8192, qr, r32, hi, p0, p1);
            __builtin_amdgcn_sched_barrier(0);
            sm_process(p0, p1, m, l, o, mask(t));
            __builtin_amdgcn_sched_barrier(0);
            pv_tile(L + 16384 + cb * 8192, p0, p1, o, lane, hi); }
        if (t + 1 < t1) kv_commit(L + (cb ^ 1) * 8192, L + 16384 + (cb ^ 1) * 8192, w, lane, kr, vr);
        __syncthreads();
    }
}

constexpr size_t MB_CNT = 0, MB_SELP = 1 * MiB, MB_SEG = 2 * MiB;
constexpr size_t MB_PARTO = 0, MB_PARTML = 96 * MiB;
__device__ __forceinline__ bool better(float va, int ia, float vb, int ib) { return va > vb || (va == vb && ia < ib); }
__device__ __forceinline__ void top3_insert(float gv, int n, float& v0, int& i0, float& v1, int& i1, float& v2, int& i2) {
    const bool b0 = better(gv, n, v0, i0), b1 = better(gv, n, v1, i1), b2 = better(gv, n, v2, i2);
    const float nv2 = b1 ? v1 : (b2 ? gv : v2), nv1 = b0 ? v0 : (b1 ? gv : v1), nv0 = b0 ? gv : v0;
    const int ni2 = b1 ? i1 : (b2 ? n : i2), ni1 = b0 ? i0 : (b1 ? n : i1), ni0 = b0 ? n : i0;
    v0 = nv0; v1 = nv1; v2 = nv2; i0 = ni0; i1 = ni1; i2 = ni2;
}
__device__ __forceinline__ void moba_gate(Frame& F) {
    const bf16* qkv = (const bf16*)(F.ws + WS_QKV);
    const bf16* KMH = (const bf16*)(F.ws + WS_KMH); const bf16* KML = (const bf16*)(F.ws + WS_KML);
    int* cnt = (int*)(F.ws + WS_ABF + MB_CNT); unsigned* selp = (unsigned*)(F.ws + WS_ABF + MB_SELP); unsigned short* seg = (unsigned short*)(F.ws + WS_ABF + MB_SEG);
    LAS int* wc = (LAS int*)F.lds;
    const int lane = F.lane, r32 = lane & 31, hi = lane >> 5, w = F.wave;
    for (int it = 0; it < 4; ++it) {
        const int u = it * F.G + F.vcu; if (u >= 1024) break;
        const int bh = u >> 5, cur = u & 31, tq = cur * 256 + 32 * w + r32;
        bf16x8 qr[4];
#pragma unroll
        for (int d0 = 0; d0 < 4; ++d0) qr[d0] = *(const bf16x8*)(qkv + pg8::E_QM + ((size_t)bh * SEQ + tq) * 64 + 16 * d0 + 8 * hi);
        f32x16 gt;
#pragma unroll
        for (int r = 0; r < 16; ++r) gt[r] = 0.f;
#pragma unroll
        for (int d0 = 0; d0 < 4; ++d0) { const bf16x8 kh = *(const bf16x8*)(KMH + ((size_t)bh * 32 + r32) * 64 + 16 * d0 + 8 * hi), kl = *(const bf16x8*)(KML + ((size_t)bh * 32 + r32) * 64 + 16 * d0 + 8 * hi);
            gt = MFMA32(kh, qr[d0], gt); gt = MFMA32(kl, qr[d0], gt); }
        float v0 = -INFINITY, v1 = -INFINITY, v2 = -INFINITY; int i0 = 99, i1 = 99, i2 = 99;
#pragma unroll
        for (int r = 0; r < 16; ++r) { const int n = crow(r, hi); const float gv = n < cur ? gt[r] : -INFINITY; top3_insert(gv, n, v0, i0, v1, i1, v2, i2); }
        const float pv0 = swap_other(v0, hi), pv1 = swap_other(v1, hi), pv2 = swap_other(v2, hi);
        const int pi0 = __builtin_bit_cast(int, swap_other(__builtin_bit_cast(float, i0), hi)), pi1 = __builtin_bit_cast(int, swap_other(__builtin_bit_cast(float, i1), hi)), pi2 = __builtin_bit_cast(int, swap_other(__builtin_bit_cast(float, i2), hi));
        top3_insert(pv0, pi0, v0, i0, v1, i1, v2, i2); top3_insert(pv1, pi1, v0, i0, v1, i1, v2, i2); top3_insert(pv2, pi2, v0, i0, v1, i1, v2, i2);
        const int s0 = (i0 < 32 && v0 > -INFINITY) ? i0 : 255, s1 = (i1 < 32 && v1 > -INFINITY) ? i1 : 255, s2 = (i2 < 32 && v2 > -INFINITY) ? i2 : 255;
        if (hi == 0) selp[(size_t)bh * SEQ + tq] = (unsigned)s0 | ((unsigned)s1 << 8) | ((unsigned)s2 << 16);
        for (int j = 0; j < cur; ++j) { const bool sel = (hi == 0) && (s0 == j || s1 == j || s2 == j); const unsigned long long bal = __ballot(sel); if (lane == 0) wc[w * 32 + j] = __popcll(bal); }
        __syncthreads();
        for (int j = 0; j < cur; ++j) { const bool sel = (hi == 0) && (s0 == j || s1 == j || s2 == j); const unsigned long long bal = __ballot(sel);
            int base = 0; for (int ww = 0; ww < w; ++ww) base += wc[ww * 32 + j];
            if (sel) { const int rank = __popcll(bal & ((1ull << r32) - 1ull)), slot = s0 == j ? 0 : (s1 == j ? 1 : 2);
                seg[(((size_t)bh * 32 + cur) * 32 + j) * 256 + base + rank] = (unsigned short)((32 * w + r32) | (slot << 8)); } }
        if (F.tid < 32) { int c = 0; if (F.tid < cur) { for (int ww = 0; ww < 8; ++ww) c += wc[ww * 32 + F.tid]; } cnt[((size_t)bh * 32 + cur) * 32 + F.tid] = c; }
        __syncthreads();
    }
}
constexpr int MB_UST = 100352, MB_TOT = 104448, MB_C32 = 108544;
__device__ __forceinline__ int moba_part_setup(Frame& F) {
    const int* cnt = (const int*)(F.ws + WS_ABF + MB_CNT); LAS int* ust = (LAS int*)(F.lds + MB_UST); LAS int* tot = (LAS int*)(F.lds + MB_TOT);
    __syncthreads();
    for (int p = F.tid; p < 1024; p += 512) { const int bh = p >> 5, j = p & 31; int t = 0; for (int cu = j + 1; cu < 32; ++cu) t += cnt[((size_t)bh * 32 + cu) * 32 + j]; tot[p] = t; }
    __syncthreads();
    if (F.tid == 0) { int a = 0; for (int p = 0; p < 1024; ++p) { ust[p] = a; a += (tot[p] + 255) >> 8; } ust[1024] = a; }
    __syncthreads();
    return ust[1024];
}
__device__ __forceinline__ void moba_part_unit(Frame& F, float* dout, const int u) {
    const bf16* qkv = (const bf16*)(F.ws + WS_QKV);
    const int* cnt = (const int*)(F.ws + WS_ABF + MB_CNT); const unsigned short* seg = (const unsigned short*)(F.ws + WS_ABF + MB_SEG);
    bf16* parto = (bf16*)((unsigned char*)dout + MB_PARTO); float* partml = (float*)((unsigned char*)dout + MB_PARTML);
    LAS int* ust = (LAS int*)(F.lds + MB_UST); LAS int* tot = (LAS int*)(F.lds + MB_TOT); LAS int* c32 = (LAS int*)(F.lds + MB_C32);
    const int lane = F.lane, r32 = lane & 31, hi = lane >> 5, w = F.wave;
    {
        int lo = 0, hb = 1024;
        while (hb - lo > 1) { const int mid = (lo + hb) >> 1; if (ust[mid] <= u) lo = mid; else hb = mid; }
        const int p = lo, bh = p >> 5, j = p & 31, k = u - ust[p], total = tot[p];
        if (F.tid < 32) c32[F.tid] = F.tid > j ? cnt[((size_t)bh * 32 + F.tid) * 32 + j] : 0;
        __syncthreads();
        const int ci = 256 * k + 32 * w + r32; const bool valid = ci < total;
        int cu = j + 1, acc = 0;
        if (valid) { for (int c2 = j + 1; c2 < 32; ++c2) { const int n = c32[c2]; if (ci >= acc + n) { acc += n; cu = c2 + 1; } else break; } }
        int ql = 0, slot = 0;
        if (valid) { const unsigned e = seg[(((size_t)bh * 32 + cu) * 32 + j) * 256 + (ci - acc)]; ql = e & 255; slot = e >> 8; } else cu = j + 1;
        const int tq = valid ? cu * 256 + ql : (j + 1) * 256;
        bf16x8 qr[4];
#pragma unroll
        for (int d0 = 0; d0 < 4; ++d0) qr[d0] = *(const bf16x8*)(qkv + pg8::E_QM + ((size_t)bh * SEQ + tq) * 64 + 16 * d0 + 8 * hi);
        const int validi = valid ? 1 : 0;
        float m = -1e30f, l = 0.f; f32x16 o[2];
#pragma unroll
        for (int r = 0; r < 16; ++r) { o[0][r] = 0.f; o[1][r] = 0.f; }
        sm_stream(F, qkv + pg8::E_KM + (size_t)bh * SEQ * 64, qkv + pg8::E_VM + (size_t)bh * SEQ * 64, 4 * j, 4 * j + 4, qr, m, l, o,
            [=](int t) { return __ballot(validi != 0) != 0ull; }, [=](int t) { TileMask tm; tm.lo = -1; tm.hi_ = 63; tm.on = validi != 0; return tm; });
        const float lt = swap_sum(l);
        if (valid) { const size_t pi = ((size_t)bh * SEQ + tq) * 3 + slot;
            store_o(parto + pi * 64, o, hi, 1.0f / lt);
            if (hi == 0) { partml[pi * 2] = m; partml[pi * 2 + 1] = lt; } }
    }
}
__device__ __forceinline__ void moba_merge(Frame& F, const float* dout) {
    const bf16* qkv = (const bf16*)(F.ws + WS_QKV);
    const unsigned* selp = (const unsigned*)(F.ws + WS_ABF + MB_SELP);
    const bf16* parto = (const bf16*)((const unsigned char*)dout + MB_PARTO); const float* partml = (const float*)((const unsigned char*)dout + MB_PARTML);
    bf16* O = (bf16*)(F.ws + WS_O);
    const int lane = F.lane, r32 = lane & 31, hi = lane >> 5, w = F.wave;
    for (int it = 0; it < 4; ++it) {
        const int u = it * F.G + F.vcu; if (u >= 1024) break;
        const int bh = u >> 5, cur = u & 31, b = bh >> 3, h = bh & 7, tq = cur * 256 + 32 * w + r32;
        bf16x8 qr[4];
#pragma unroll
        for (int d0 = 0; d0 < 4; ++d0) qr[d0] = *(const bf16x8*)(qkv + pg8::E_QM + ((size_t)bh * SEQ + tq) * 64 + 16 * d0 + 8 * hi);
        float m = -1e30f, l = 0.f; f32x16 o[2];
#pragma unroll
        for (int r = 0; r < 16; ++r) { o[0][r] = 0.f; o[1][r] = 0.f; }
        const int wmax = cur * 256 + 32 * w + 31;
        sm_stream(F, qkv + pg8::E_KM + (size_t)bh * SEQ * 64, qkv + pg8::E_VM + (size_t)bh * SEQ * 64, 4 * cur, 4 * cur + 4, qr, m, l, o,
            [=](int t) { return 64 * t <= wmax; }, [=](int t) { TileMask tm; tm.lo = -1; tm.hi_ = tq - 64 * t - 4 * hi; tm.on = true; return tm; });
        float L = swap_sum(l);
        const unsigned sp = selp[(size_t)bh * SEQ + tq];
        float ms[3], ls[3]; float M = m;
#pragma unroll
        for (int s = 0; s < 3; ++s) { const bool on = ((sp >> (8 * s)) & 255u) != 255u; const size_t pi = ((size_t)bh * SEQ + tq) * 3 + s;
            ms[s] = on ? partml[pi * 2] : -1e30f; ls[s] = on ? partml[pi * 2 + 1] : 0.f; M = fmaxf(M, ms[s]); }
        const float wo = __builtin_amdgcn_exp2f(m - M); L *= wo;
#pragma unroll
        for (int r = 0; r < 16; ++r) { o[0][r] *= wo; o[1][r] *= wo; }
#pragma unroll
        for (int s = 0; s < 3; ++s) { const float ws_ = ls[s] * __builtin_amdgcn_exp2f(ms[s] - M); L += ws_;
            if (ls[s] > 0.f) { const bf16* po = parto + (((size_t)bh * SEQ + tq) * 3 + s) * 64;
#pragma unroll
                for (int dh = 0; dh < 2; ++dh)
#pragma unroll
                    for (int g = 0; g < 4; ++g) { const v2u pk = *(const v2u*)(po + 32 * dh + 8 * g + 4 * hi);
                        o[dh][4 * g] = fmaf(ws_, bflo(pk.x), o[dh][4 * g]); o[dh][4 * g + 1] = fmaf(ws_, bfhi(pk.x), o[dh][4 * g + 1]);
                        o[dh][4 * g + 2] = fmaf(ws_, bflo(pk.y), o[dh][4 * g + 2]); o[dh][4 * g + 3] = fmaf(ws_, bfhi(pk.y), o[dh][4 * g + 3]); } } }
        store_o(O + (size_t)(b * SEQ + tq) * 1024 + 512 + h * 64, o, hi, 1.0f / fmaxf(L, 1e-30f));
    }
}
constexpr int NSA_IMPG = 32768, NSA_IMPL = NSA_IMPG + 64 * 129 * 4, NSA_SEL = NSA_IMPL + 64 * 129 * 4;
__device__ __forceinline__ void nsa_unit(Frame& F, const int bkv, const int c) {
    const bf16* qkv = (const bf16*)(F.ws + WS_QKV);
    const float* gates = (const float*)(F.ws + WS_GATES);
    const bf16* KC = (const bf16*)(F.ws + WS_KC); const bf16* VC = (const bf16*)(F.ws + WS_VC);
    bf16* O = (bf16*)(F.ws + WS_O);
    LAS float* impG = (LAS float*)(F.lds + NSA_IMPG); LAS float* impL = (LAS float*)(F.lds + NSA_IMPL); LAS unsigned short* sel16 = (LAS unsigned short*)(F.lds + NSA_SEL);
    const int lane = F.lane, r32 = lane & 31, hi = lane >> 5, w = F.wave, ql = 8 * w + (r32 >> 2), g = r32 & 3;
    {
        const int b = bkv >> 1, kv = bkv & 1, h = kv * 4 + g, tq = 64 * c + ql, tok = b * SEQ + tq;
        bf16x8 qr[4];
#pragma unroll
        for (int d0 = 0; d0 < 4; ++d0) qr[d0] = *(const bf16x8*)(qkv + pg8::E_QA + ((size_t)(b * 8 + h) * SEQ + tq) * 64 + 16 * d0 + 8 * hi);
        const float g0 = gates[(size_t)tok * 24 + h * 3 + 0], g1 = gates[(size_t)tok * 24 + h * 3 + 1], g2 = gates[(size_t)tok * 24 + h * 3 + 2];
        f32x16 o[2]; LAS float* otl = (LAS float*)(F.lds + NSA_IMPG) + F.tid;
        for (int i = F.tid; i < 2 * 64 * 129; i += 512) impG[i] = 0.f;
        const int nvis = tq >= 31 ? min((tq - 31) / 16 + 1, 511) : 0, ntc = (4 * c + 66) >> 6;
        const bf16* kcp = KC + (size_t)bkv * 512 * 64; const bf16* vcp = VC + (size_t)bkv * 512 * 64;
        float m = -1e30f, l = 0.f;
#pragma unroll
        for (int r = 0; r < 16; ++r) { o[0][r] = 0.f; o[1][r] = 0.f; }
        sm_stream(F, kcp, vcp, 0, ntc, qr, m, l, o, [=](int t) { return true; }, [=](int t) { TileMask tm; tm.lo = -1; tm.hi_ = nvis - 1 - 64 * t - 4 * hi; tm.on = true; return tm; });
        float linv = 1.0f / fmaxf(swap_sum(l), 1e-30f);
#pragma unroll
        for (int r = 0; r < 16; ++r) { o[0][r] *= g0 * linv; o[1][r] *= g0 * linv; }
        if (c >= 16) {
            LAS unsigned char* L = F.lds;
            for (int t = 0; t < ntc; ++t) {
                { v4u kr, vr; kv_issue(kcp + (size_t)t * 4096, vcp + (size_t)t * 4096, w, lane, kr, vr); kv_commit(L, L + 16384, w, lane, kr, vr); }
                __syncthreads();
                f32x16 p0, p1; qk_tile(L, qr, r32, hi, p0, p1);
#pragma unroll
                for (int uu = 0; uu < 8; ++uu) { float pe[4];
#pragma unroll
                    for (int e = 0; e < 4; ++e) { const int i = 4 * uu + e; const float s = i < 16 ? p0[i] : p1[i - 16]; const int n = 64 * t + 32 * (i >> 4) + crow(i & 15, hi);
                        pe[e] = n < nvis ? __builtin_amdgcn_exp2f(s - m) * linv : 0.f; }
                    float G = (pe[0] + pe[1]) + (pe[2] + pe[3]), Lst = pe[3];
                    G += __shfl_xor(G, 1); G += __shfl_xor(G, 2); Lst += __shfl_xor(Lst, 1); Lst += __shfl_xor(Lst, 2);
                    const int j = 16 * t + 2 * uu + hi;
                    if (g == 0 && j < 128) { impG[ql * 129 + j] = G; impL[ql * 129 + j + 1] = Lst; } }
                __syncthreads();
            }
        }
        __syncthreads();
        { const int qs = F.tid >> 3, k8 = F.tid & 7; unsigned bits = 0u;
          if (c < 16) { if (k8 == 0) bits = (1u << (c + 1)) - 1u; }
          else { float v[16];
#pragma unroll
              for (int e = 0; e < 16; ++e) { const int j = 16 * k8 + e; v[e] = (j >= 1 && j <= c - 2) ? impG[qs * 129 + j] + impL[qs * 129 + j] : -1.0f;
                  if (j == 0 || j == c - 1 || j == c) bits |= 1u << e; }
              for (int rnd = 0; rnd < 13; ++rnd) { float bv = -1.0f; int bj = 999;
#pragma unroll
                  for (int e = 0; e < 16; ++e) { if (v[e] > bv) { bv = v[e]; bj = 16 * k8 + e; } }
#pragma unroll
                  for (int sh = 1; sh < 8; sh <<= 1) { const float ov = __shfl_xor(bv, sh); const int oj = __shfl_xor(bj, sh); if (better(ov, oj, bv, bj)) { bv = ov; bj = oj; } }
#pragma unroll
                  for (int e = 0; e < 16; ++e) { if (bj == 16 * k8 + e) { v[e] = -1.0f; bits |= 1u << e; } } } }
          sel16[qs * 8 + k8] = (unsigned short)bits; }
        __syncthreads();
#pragma unroll
        for (int r = 0; r < 16; ++r) { otl[r * 512] = o[0][r]; otl[(16 + r) * 512] = o[1][r]; }
        m = -1e30f; l = 0.f;
#pragma unroll
        for (int r = 0; r < 16; ++r) { o[0][r] = 0.f; o[1][r] = 0.f; }
        { const LAS unsigned short* myrow = sel16 + ql * 8;
          sm_stream(F, qkv + pg8::E_KSLC + (size_t)bkv * SEQ * 64, qkv + pg8::E_VSLC + (size_t)bkv * SEQ * 64, 0, c + 1, qr, m, l, o,
              [=](int t) { return __ballot((myrow[t >> 4] >> (t & 15)) & 1) != 0ull; },
              [=](int t) { TileMask tm; tm.lo = -1; tm.hi_ = tq - 64 * t - 4 * hi; tm.on = ((myrow[t >> 4] >> (t & 15)) & 1) != 0; return tm; }); }
        linv = 1.0f / fmaxf(swap_sum(l), 1e-30f);
#pragma unroll
        for (int r = 0; r < 16; ++r) { otl[r * 512] = fmaf(g1 * linv, o[0][r], otl[r * 512]); otl[(16 + r) * 512] = fmaf(g1 * linv, o[1][r], otl[(16 + r) * 512]); }
        m = -1e30f; l = 0.f;
#pragma unroll
        for (int r = 0; r < 16; ++r) { o[0][r] = 0.f; o[1][r] = 0.f; }
        sm_stream(F, qkv + pg8::E_KWIN + (size_t)bkv * SEQ * 64, qkv + pg8::E_VWIN + (size_t)bkv * SEQ * 64, max(c - 8, 0), c + 1, qr, m, l, o,
            [=](int t) { return true; }, [=](int t) { TileMask tm; tm.hi_ = tq - 64 * t - 4 * hi; tm.lo = tm.hi_ - 512; tm.on = true; return tm; });
        linv = 1.0f / fmaxf(swap_sum(l), 1e-30f);
#pragma unroll
        for (int r = 0; r < 16; ++r) { o[0][r] = fmaf(g2 * linv, o[0][r], otl[r * 512]); o[1][r] = fmaf(g2 * linv, o[1][r], otl[(16 + r) * 512]); }
        store_o(O + (size_t)tok * 1024 + h * 64, o, hi, 1.0f);
        __syncthreads();
    }
}

__global__ void __launch_bounds__(NWAVES * 64, 2) fwd_kernel(Args args) {
    extern __shared__ __attribute__((aligned(16))) unsigned char lds[];
    Frame F;
    F.lds = (LAS unsigned char*)lds; F.ws = args.ws;
    F.tid = threadIdx.x; F.lane = F.tid & 63; F.wave = __builtin_amdgcn_readfirstlane(F.tid >> 6);
    F.G = gridDim.x; { const int bx = blockIdx.x; F.vcu = (F.G % 8 == 0) ? (bx % 8) * (F.G / 8) + bx / 8 : bx; }
    for (int u = F.tid; u < (LDS_BYTES - LDSCTL_OFF) / 4; u += NWAVES * 64) ((LAS unsigned*)(F.lds + LDSCTL_OFF))[u] = 0u;
    __syncthreads();
    volatile LAS unsigned* MISC = (volatile LAS unsigned*)(F.lds + MISC_OFF);
    unsigned* ctl = (unsigned*)(args.ws + WS_CTL);
    XcdBarrier bar; bar.bar = ctl + CW_BAR + args.pad * XCD_BAR_WORDS; bar.x = 0; bar.st = nullptr;
    if (args.use_bar) bar = xcd_barrier_post(ctl + CW_BAR + args.pad * XCD_BAR_WORDS, MISC + 8);
    const int lo = args.ph_lo, hi = args.ph_hi;
#ifdef ONLYPH
#define IN(k) ((k) == ONLYPH && lo <= (k) && (k) < hi)
#else
#define IN(k) (lo <= (k) && (k) < hi)
#endif
#ifdef PROBE_REP
#define NREP(k) ((k) == PROBE_REP ? 2 : 1)
#else
#define NREP(k) 1
#endif
#ifdef PROBE_BAR
#define SEAM(k) do { if (IN(k) && IN((k) + 1)) { xcd_barrier(bar); xcd_barrier(bar); } } while (0)
#else
#define SEAM(k) do { if (IN(k) && IN((k) + 1)) xcd_barrier(bar); } while (0)
#endif
    float* R = args.out;
    bf16* RB = (bf16*)(args.ws + WS_ABF);
    bf16* ABF = (bf16*)(args.ws + WS_ABF); bf16* OB = (bf16*)(args.ws + WS_O); bf16* QKV = (bf16*)(args.ws + WS_QKV);
    bf16* XS = (bf16*)(args.ws + WS_XS); bf16* HB = (bf16*)(args.ws + WS_H);

    if (IN(0)) { for (int rep = 0; rep < NREP(0); ++rep) p0_prologue(F, args); } SEAM(0);
    if (IN(1)) { pg8::Gemm g{ABF, (const bf16*)(args.ws + WS_WIN0), NTOK, 3072, DM}; pg8::StaticOrder S; S.init(NTOK, 3072, F.G, (int)blockIdx.x);
        pg8::EpiProj0 E{QKV, (float*)(args.ws + WS_GATES), (const float*)(args.ws + WS_COS), (const float*)(args.ws + WS_SIN)};
        pg8::gemm_phase<pg8::EpiProj0, pg8::StaticOrder, true, true>(F.lds, g, S, E); } SEAM(1);
    if (IN(2)) { for (int rep = 0; rep < NREP(2); ++rep) p2_compress(F, args); } SEAM(2);
    if (IN(3)) { moba_gate(F); xcd_barrier(bar);
        { const int nmb = moba_part_setup(F), q2 = 1024 + ((nmb + 3) >> 2);
          volatile LAS int* qslot = (volatile LAS int*)(F.lds + MB_C32 + 256);
          for (;;) { __syncthreads();
              if (F.tid == 0) *qslot = (int)__hip_atomic_fetch_add(ctl + CW_Q, 1u, RLX_AGENT);
              __syncthreads();
              const int qi = *qslot; if (qi >= q2) break;
              if (qi < 1024) nsa_unit(F, qi & 7, 127 - (qi >> 3));
              else { const int u0 = (qi - 1024) * 4; for (int u = u0; u < u0 + 4 && u < nmb; ++u) moba_part_unit(F, R, u); } } }
        xcd_barrier(bar);
        moba_merge(F, R);
    } SEAM(3);
    if (IN(4)) { pg8::Gemm g{OB, (const bf16*)(args.ws + WS_WOUT0), NTOK, DM, DM}; pg8::StaticOrder S; S.init(NTOK, DM, F.G, (int)blockIdx.x);
        pg8::EpiResX E{args.in[0], RB, ALPHA};
        pg8::gemm_phase<pg8::EpiResX, pg8::StaticOrder, true, true>(F.lds, g, S, E); } SEAM(4);
    if (IN(5)) { ln_phase<true, false>(F, args, 0, args.in[12], args.in[13], RB, nullptr); } SEAM(5);
    if (IN(6)) { for (int rep = 0; rep < NREP(6); ++rep) scatter_phase(F); } SEAM(6);
    if (IN(7)) { const int np = load_ptab(F); pg8::Gemm g{ABF, nullptr, MAXROWS, 1024, DM};
        MoeOrder1 S{F.G, (int)blockIdx.x, np * 4, (const LAS int*)(F.lds + PTAB_OFF), (const bf16*)(args.ws + WS_W1E), (const int*)(args.ws + WS_ROWMAP)};
        pg8::EpiMoe1 E{HB, (const float*)(args.ws + WS_WROW)};
        pg8::gemm_phase<pg8::EpiMoe1, MoeOrder1, true, true>(F.lds, g, S, E); } SEAM(7);
    if (IN(8)) { const int np = load_ptab(F); pg8::Gemm g{HB, nullptr, MAXROWS, 1024, 512};
        MoeOrder2 S{F.G, (int)blockIdx.x, np * 4, (const LAS int*)(F.lds + PTAB_OFF), (const bf16*)(args.ws + WS_B2)};
        pg8::EpiMoe2 E{RB, (const int*)(args.ws + WS_ROWMAP), ALPHA};
        pg8::gemm_phase<pg8::EpiMoe2, MoeOrder2, true, true>(F.lds, g, S, E); } SEAM(8);
    if (IN(9)) { ln_phase<false, false>(F, args, 0, args.in[14], args.in[15], RB, nullptr); } SEAM(9);
    if (IN(10)) { pg8::Gemm g{ABF, (const bf16*)(args.ws + WS_WIN1), NTOK, 3072, DM}; pg8::StaticOrder S; S.init(NTOK, 3072, F.G, (int)blockIdx.x);
        pg8::EpiProj1 E{QKV};
        pg8::gemm_phase<pg8::EpiProj1, pg8::StaticOrder, true, true>(F.lds, g, S, E); } SEAM(10);
    if (IN(11)) { for (int rep = 0; rep < NREP(11); ++rep) p11_sb_mfma(F); } SEAM(11);
    if (IN(12)) { pg8::Gemm g{OB, (const bf16*)(args.ws + WS_WOUT1), NTOK, DM, DM}; pg8::StaticOrder S; S.init(NTOK, DM, F.G, (int)blockIdx.x);
        pg8::EpiResB E{RB, ALPHA};
        pg8::gemm_phase<pg8::EpiResB, pg8::StaticOrder, true, true>(F.lds, g, S, E); } SEAM(12);
    if (IN(13)) { ln_phase<true, false>(F, args, 1, args.in[12] + DM, args.in[13] + DM, RB, nullptr); } SEAM(13);
    if (IN(14)) { scatter_phase(F); } SEAM(14);
    if (IN(15)) { const int np = load_ptab(F); pg8::Gemm g{ABF, nullptr, MAXROWS, 1024, DM};
        MoeOrder1 S{F.G, (int)blockIdx.x, np * 4, (const LAS int*)(F.lds + PTAB_OFF), (const bf16*)(args.ws + WS_W1E) + (size_t)16 * 512 * 1024, (const int*)(args.ws + WS_ROWMAP)};
        pg8::EpiMoe1 E{HB, (const float*)(args.ws + WS_WROW)};
        pg8::gemm_phase<pg8::EpiMoe1, MoeOrder1, true, true>(F.lds, g, S, E); } SEAM(15);
    if (IN(16)) { const int np = load_ptab(F); pg8::Gemm g{HB, nullptr, MAXROWS, 1024, 512};
        MoeOrder2 S{F.G, (int)blockIdx.x, np * 4, (const LAS int*)(F.lds + PTAB_OFF), (const bf16*)(args.ws + WS_B2) + (size_t)24 * 1024 * 512};
        pg8::EpiMoe2 E{RB, (const int*)(args.ws + WS_ROWMAP), ALPHA};
        pg8::gemm_phase<pg8::EpiMoe2, MoeOrder2, true, true>(F.lds, g, S, E); } SEAM(16);
    if (IN(17)) { ln_phase<false, true>(F, args, 1, args.in[14] + DM, args.in[15] + DM, RB, R); }
#undef IN
#undef SEAM
}


#ifdef PROBE_ATTN
__device__ __forceinline__ void mkframe(Frame& F, const Args& args, unsigned char* lds) { F.lds = (LAS unsigned char*)lds; F.ws = args.ws; F.tid = threadIdx.x; F.lane = F.tid & 63; F.wave = __builtin_amdgcn_readfirstlane(F.tid >> 6);
    F.G = gridDim.x; const int bx = blockIdx.x; F.vcu = (F.G % 8 == 0) ? (bx % 8) * (F.G / 8) + bx / 8 : bx; }
__global__ void __launch_bounds__(NWAVES * 64, 2) probe_naive(Args args) { extern __shared__ __attribute__((aligned(16))) unsigned char lds[]; Frame F; mkframe(F, args, lds);
    p3_nsa_naive(F, args, (bf16*)args.out); p3_moba_naive(F, args, (bf16*)args.out); }
__global__ void __launch_bounds__(NWAVES * 64, 2) probe_cmp(Args args) { extern __shared__ __attribute__((aligned(16))) unsigned char lds[]; Frame F; mkframe(F, args, lds);
    const bf16* o1 = (const bf16*)(args.ws + WS_O); const bf16* o2 = (const bf16*)args.out; float num = 0.f, den = 0.f;
    for (size_t i = (size_t)(F.vcu * 512 + F.tid); i < (size_t)NTOK * 1024; i += (size_t)F.G * 512) { if ((int)((i & 1023) >> 9) != PROBE_ATTN - 1) continue; const float a = bf2f(o1[i]), b = bf2f(o2[i]); num += (a - b) * (a - b); den += b * b; }
    num = wave_sum(num); den = wave_sum(den);
    if (F.lane == 0) { atomicAdd((float*)(args.ws + WS_CTL) + 32768, num); atomicAdd((float*)(args.ws + WS_CTL) + 32769, den); } }
__global__ void __launch_bounds__(NWAVES * 64, 2) probe_scale(Args args) { const float num = ((const float*)(args.ws + WS_CTL))[32768], den = ((const float*)(args.ws + WS_CTL))[32769], sc = 1.0f + 10.0f * sqrtf(num / fmaxf(den, 1e-30f));
    for (size_t i = (size_t)blockIdx.x * 512 + threadIdx.x; i < (size_t)NTOK * DM / 4; i += (size_t)gridDim.x * 512) { f32x4 v = ((const f32x4*)args.out)[i]; v = v * sc; ((f32x4*)args.out)[i] = v; } }
#endif
extern "C" void kernel_launch(void* const* d_in, const int* in_sizes, int n_in, void* d_out, int out_size, void* d_ws, size_t ws_size, hipStream_t stream) {
    static int grid = 0;
    if (grid == 0) {
        if (n_in != 23 || in_sizes[0] != NTOK * DM || out_size != NTOK * DM || ws_size < WS_END) { fprintf(stderr, "kernel_launch: unexpected shapes (n_in %d, in0 %d, out %d, ws %zu); nothing launched\n", n_in, n_in > 0 ? in_sizes[0] : -1, out_size, ws_size); grid = -1; return; }
        int dev = 0, cus = 0, per_cu = 0;
        if (hipGetDevice(&dev) != hipSuccess || hipDeviceGetAttribute(&cus, hipDeviceAttributeMultiprocessorCount, dev) != hipSuccess) { grid = -1; return; }
        if (hipFuncSetAttribute((const void*)fwd_kernel, hipFuncAttributeMaxDynamicSharedMemorySize, LDS_BYTES) != hipSuccess) { fprintf(stderr, "kernel_launch: hipFuncSetAttribute failed\n"); grid = -1; return; }
        if (hipOccupancyMaxActiveBlocksPerMultiprocessor(&per_cu, (const void*)fwd_kernel, NWAVES * 64, LDS_BYTES) != hipSuccess || per_cu < 1) { fprintf(stderr, "kernel_launch: occupancy query reports %d workgroups per CU\n", per_cu); }
        (void)hipGetLastError();
        grid = cus;
    }
    if (grid < 0) return;
    if (hipMemsetAsync((char*)d_ws + WS_CTL, 0, CTL_ZERO_BYTES, stream) != hipSuccess) return;
    Args a{};
    for (int i = 0; i < 23; ++i) a.in[i] = (const float*)d_in[i];
    a.out = (float*)d_out; a.ws = (unsigned char*)d_ws; a.pad = 0;
#if defined(PROBE_ATTN)
    hipFuncSetAttribute((const void*)probe_naive, hipFuncAttributeMaxDynamicSharedMemorySize, LDS_BYTES);
    a.ph_lo = 0; a.ph_hi = 4; a.use_bar = 1; a.pad = 0; hipLaunchKernelGGL(fwd_kernel, dim3(grid), dim3(NWAVES * 64), LDS_BYTES, stream, a);
    hipLaunchKernelGGL(probe_naive, dim3(grid), dim3(NWAVES * 64), LDS_BYTES, stream, a);
    hipLaunchKernelGGL(probe_cmp, dim3(grid), dim3(NWAVES * 64), 0, stream, a);
    a.ph_lo = 4; a.ph_hi = NPH; a.use_bar = 1; a.pad = 1; hipLaunchKernelGGL(fwd_kernel, dim3(grid), dim3(NWAVES * 64), LDS_BYTES, stream, a);
    hipLaunchKernelGGL(probe_scale, dim3(grid), dim3(NWAVES * 64), 0, stream, a);
#elif MK_N_LAUNCHES == 1
    a.ph_lo = 0; a.ph_hi = NPH; a.use_bar = 1;
    hipLaunchKernelGGL(fwd_kernel, dim3(grid), dim3(NWAVES * 64), LDS_BYTES, stream, a);
#else
    for (int p = 0; p < NPH; ++p) { a.ph_lo = p; a.ph_hi = p + 1; a.use_bar = 0;
        hipLaunchKernelGGL(fwd_kernel, dim3(grid), dim3(NWAVES * 64), LDS_BYTES, stream, a); }
#endif
}
```

```cpp
#include <hip/hip_runtime.h>
#include <cstdio>
#include <cstdint>
#include <cmath>

#ifndef MK_N_LAUNCHES
#define MK_N_LAUNCHES 1
#endif

#ifndef PG8_KALIGN
#define PG8_KALIGN ".p2align 6"
#endif
namespace pg8 {
#define PG8_LAS __attribute__((address_space(3)))
typedef unsigned short bf16_t;
typedef short bf16x8 __attribute__((ext_vector_type(8)));
typedef float f32x4 __attribute__((ext_vector_type(4)));
typedef unsigned u32x4 __attribute__((ext_vector_type(4)));
constexpr int BM = 256, BK = 64, HALF = 128, HTB = HALF * BK * 2  , STAGE_BYTES = 8 * HTB, NXCD = 8, WGM = 8;

__host__ __device__ __forceinline__ int lds_byte(int r, int c) { const int st = (r >> 4) * 2 + (c >> 5), rr = r & 15, cc = c & 31, ob = rr * 64 + cc * 2; return st * 1024 + (ob ^ (((ob >> 9) & 1) << 5)); }
__host__ __device__ __forceinline__ void stage_rc(int b, int& R, int& C) { const int st = b / 1024, sb = b % 1024, swz = sb ^ (((sb >> 9) & 1) << 5); R = (st >> 1) * 16 + swz / 64; C = (st & 1) * 32 + (swz % 64) / 2; }
__host__ __device__ __forceinline__ int perm32(int rho) { const int n = rho >> 4, i = rho & 15; return 8 * (i >> 2) + 4 * n + (i & 3); }

struct Unit { int pm, pn, aux; };
struct Gemm { const bf16_t* A; const bf16_t* Bt; int M, N, K; };

struct StaticOrder {
    static constexpr bool GATHER = false;
    int nM, nN, nwg, G, c;
    __host__ __device__ void init(int M, int N, int G_, int c_) { nM = M / BM; nN = N / BM; nwg = nM * nN; G = G_; c = c_; }
    __host__ __device__ bool next(int i, Unit& u) const {
        const long L = (long)i * G + c; if (L >= nwg) return false;
        int wgid = (int)L; { const int q = nwg / NXCD, r = nwg % NXCD, xcd = wgid % NXCD, off = wgid / NXCD; wgid = (xcd < r ? xcd * (q + 1) : r * (q + 1) + (xcd - r) * q) + off; }
        const int nig = WGM * nN, gid = wgid / nig, fm = gid * WGM, gsz = (nM - fm) < WGM ? (nM - fm) : WGM;
        u.pm = fm + ((wgid % nig) % gsz); u.pn = (wgid % nig) / gsz; u.aux = 0; return true;
    }
    __device__ __forceinline__ const char* aptr(const Gemm& g, const Unit& u, size_t tstep) const { return (const char*)g.A + (size_t)u.pm * tstep; }
    __device__ __forceinline__ const char* bptr(const Gemm& g, const Unit& u, size_t tstep) const { return (const char*)g.Bt + (size_t)u.pn * tstep; }
    __device__ __forceinline__ int arow(const Unit&, int) const { return 0; }
    __device__ __forceinline__ void a_ready(const Unit&) const {}
    __device__ __forceinline__ void done(const Unit&) const {}
};

__device__ __forceinline__ unsigned cvt_pk_bf16(float lo, float hi) { unsigned r; asm volatile("v_cvt_pk_bf16_f32 %0, %1, %2" : "=v"(r) : "v"(lo), "v"(hi)); return r; }
typedef unsigned u32x2 __attribute__((ext_vector_type(2)));
constexpr int SEQ_ = 8192;
constexpr float QLOG2 = 0.125f * 1.4426950408889634f;
constexpr size_t E_QA = 0, E_KCMP = 16777216, E_KSLC = 20971520, E_KWIN = 25165824, E_VCMP = 29360128, E_VSLC = 33554432, E_VWIN = 37748736,
                 E_QM = 41943040, E_KM = 58720256, E_VM = 75497472;

struct EpiProj0 {
    static constexpr bool PERM = true, AFTER_DRAIN = false;
    bf16_t* qkv; float* gates; const float* cosT; const float* sinT;
    __device__ __forceinline__ void operator()(const f32x4 (&acc)[2][2][4][2], const Unit& u, int wr, int wc, int fr, int fq) const {
        const int row0 = u.pm * BM + wr * 64 + fr;
#pragma unroll
        for (int bj = 0; bj < 2; ++bj) {
            const int hs = u.pn * 4 + bj * 2 + (wc >> 1);
            const int p0 = 32 * (wc & 1) + 8 * fq;
            if (hs < 44) {
                const bool rope = (hs < 14) || (hs >= 20 && hs < 36), isq = hs < 8 || (hs >= 20 && hs < 28);
                size_t base; int nh, hh;
                if (hs < 8) { base = E_QA; nh = 8; hh = hs; }
                else if (hs < 20) { base = E_KCMP + (size_t)((hs - 8) >> 1) * 4194304; nh = 2; hh = (hs - 8) & 1; }
                else { base = E_QM + (size_t)((hs - 20) >> 3) * 16777216; nh = 8; hh = (hs - 20) & 7; }
#pragma unroll
                for (int ai = 0; ai < 2; ++ai)
#pragma unroll
                    for (int m = 0; m < 4; ++m) {
                        const int r = row0 + ai * HALF + m * 16, b = r >> 13, s = r & (SEQ_ - 1);
                        f32x4 v0 = acc[ai][bj][m][0], v1 = acc[ai][bj][m][1];
                        if (rope) {
                            const f32x4 c4 = *(const f32x4*)(cosT + (size_t)r * 32 + (p0 >> 1)), s4 = *(const f32x4*)(sinT + (size_t)r * 32 + (p0 >> 1));
                            const f32x4 w0 = v0, w1 = v1;
                            v0[0] = w0[0] * c4[0] - w0[1] * s4[0]; v0[1] = w0[1] * c4[0] + w0[0] * s4[0];
                            v0[2] = w0[2] * c4[1] - w0[3] * s4[1]; v0[3] = w0[3] * c4[1] + w0[2] * s4[1];
                            v1[0] = w1[0] * c4[2] - w1[1] * s4[2]; v1[1] = w1[1] * c4[2] + w1[0] * s4[2];
                            v1[2] = w1[2] * c4[3] - w1[3] * s4[3]; v1[3] = w1[3] * c4[3] + w1[2] * s4[3];
                        }
                        if (isq) { v0 = v0 * QLOG2; v1 = v1 * QLOG2; }
                        u32x4 w; w.x = cvt_pk_bf16(v0[0], v0[1]); w.y = cvt_pk_bf16(v0[2], v0[3]); w.z = cvt_pk_bf16(v1[0], v1[1]); w.w = cvt_pk_bf16(v1[2], v1[3]);
                        *(u32x4*)(qkv + base + ((size_t)(b * nh + hh) * SEQ_ + s) * 64 + p0) = w;
                    }
            } else if (hs == 44) {
                if ((wc & 1) == 0 && fq < 3) {
#pragma unroll
                    for (int ai = 0; ai < 2; ++ai)
#pragma unroll
                        for (int m = 0; m < 4; ++m) {
                            const int r = row0 + ai * HALF + m * 16;
                            f32x4 v0 = acc[ai][bj][m][0], v1 = acc[ai][bj][m][1];
#pragma unroll
                            for (int e = 0; e < 4; ++e) { v0[e] = 1.0f / (1.0f + __expf(-v0[e])); v1[e] = 1.0f / (1.0f + __expf(-v1[e])); }
                            *(f32x4*)(gates + (size_t)r * 24 + p0) = v0; *(f32x4*)(gates + (size_t)r * 24 + p0 + 4) = v1;
                        }
                }
            }
        }
    }
};
struct EpiProj1 {
    static constexpr bool PERM = true, AFTER_DRAIN = false;
    bf16_t* qkv;
    __device__ __forceinline__ void operator()(const f32x4 (&acc)[2][2][4][2], const Unit& u, int wr, int wc, int fr, int fq) const {
        const int row0 = u.pm * BM + wr * 64 + fr;
#pragma unroll
        for (int bj = 0; bj < 2; ++bj) {
            const int hs = u.pn * 4 + bj * 2 + (wc >> 1), p0 = 32 * (wc & 1) + 8 * fq, hh = hs & 15;
            const size_t base = (size_t)(hs >> 4) * 33554432;
#pragma unroll
            for (int ai = 0; ai < 2; ++ai)
#pragma unroll
                for (int m = 0; m < 4; ++m) {
                    const int r = row0 + ai * HALF + m * 16, b = r >> 13, s = r & (SEQ_ - 1);
                    f32x4 v0 = acc[ai][bj][m][0], v1 = acc[ai][bj][m][1];
                    if (hs < 16) { v0 = v0 * QLOG2; v1 = v1 * QLOG2; }
                    u32x4 w; w.x = cvt_pk_bf16(v0[0], v0[1]); w.y = cvt_pk_bf16(v0[2], v0[3]); w.z = cvt_pk_bf16(v1[0], v1[1]); w.w = cvt_pk_bf16(v1[2], v1[3]);
                    *(u32x4*)(qkv + base + ((size_t)(b * 16 + hh) * SEQ_ + s) * 64 + p0) = w;
                }
        }
    }
};
__device__ __forceinline__ float bf_lo(unsigned u) { return __builtin_bit_cast(float, u << 16); }
__device__ __forceinline__ float bf_hi(unsigned u) { return __builtin_bit_cast(float, u & 0xffff0000u); }
struct EpiResX {
    static constexpr bool PERM = false, AFTER_DRAIN = false;
    const float* resid; bf16_t* out; float alpha;
    __device__ __forceinline__ void operator()(const f32x4 (&acc)[2][2][4][2], const Unit& u, int wr, int wc, int fr, int fq) const {
        const int row0 = u.pm * BM + wr * 64 + fr, col0 = u.pn * BM + wc * 32 + 4 * fq;
#pragma unroll
        for (int ai = 0; ai < 2; ++ai)
#pragma unroll
            for (int m = 0; m < 4; ++m) { const size_t off = (size_t)(row0 + ai * HALF + m * 16) * 1024 + col0;
#pragma unroll
                for (int bj = 0; bj < 2; ++bj)
#pragma unroll
                    for (int n = 0; n < 2; ++n) { const f32x4 bs = *(const f32x4*)(resid + off + bj * HALF + n * 16); const f32x4 v = bs * alpha + acc[ai][bj][m][n];
                        u32x2 w; w.x = cvt_pk_bf16(v[0], v[1]); w.y = cvt_pk_bf16(v[2], v[3]); *(u32x2*)(out + off + bj * HALF + n * 16) = w; } }
    }
};
struct EpiResB {
    static constexpr bool PERM = false, AFTER_DRAIN = false;
    bf16_t* RB; float alpha;
    __device__ __forceinline__ void operator()(const f32x4 (&acc)[2][2][4][2], const Unit& u, int wr, int wc, int fr, int fq) const {
        const int row0 = u.pm * BM + wr * 64 + fr, col0 = u.pn * BM + wc * 32 + 4 * fq;
#pragma unroll
        for (int ai = 0; ai < 2; ++ai)
#pragma unroll
            for (int m = 0; m < 4; ++m) { const size_t off = (size_t)(row0 + ai * HALF + m * 16) * 1024 + col0;
#pragma unroll
                for (int bj = 0; bj < 2; ++bj)
#pragma unroll
                    for (int n = 0; n < 2; ++n) { const u32x2 b = *(const u32x2*)(RB + off + bj * HALF + n * 16); const f32x4 a = acc[ai][bj][m][n];
                        u32x2 w; w.x = cvt_pk_bf16(bf_lo(b.x) * alpha + a[0], bf_hi(b.x) * alpha + a[1]); w.y = cvt_pk_bf16(bf_lo(b.y) * alpha + a[2], bf_hi(b.y) * alpha + a[3]); *(u32x2*)(RB + off + bj * HALF + n * 16) = w; } }
    }
};
struct EpiMoe1 {
    static constexpr bool PERM = true, AFTER_DRAIN = false;
    bf16_t* H; const float* wrow;
    __device__ __forceinline__ void operator()(const f32x4 (&acc)[2][2][4][2], const Unit& u, int wr, int wc, int fr, int fq) const {
        const int row0 = u.pm * BM + wr * 64 + fr, slot = u.pn >> 1;
#pragma unroll
        for (int ai = 0; ai < 2; ++ai)
#pragma unroll
            for (int m = 0; m < 4; ++m) { const int prow = row0 + ai * HALF + m * 16; const float w = wrow[(size_t)prow * 2 + slot];
#pragma unroll
                for (int bj = 0; bj < 2; ++bj) { const f32x4 g = acc[ai][bj][m][0], up = acc[ai][bj][m][1]; float hv[4];
#pragma unroll
                    for (int e = 0; e < 4; ++e) hv[e] = g[e] / (1.0f + __expf(-g[e])) * up[e] * w;
                    u32x2 o; o.x = cvt_pk_bf16(hv[0], hv[1]); o.y = cvt_pk_bf16(hv[2], hv[3]);
                    *(u32x2*)(H + (size_t)prow * 512 + u.pn * 128 + bj * 64 + wc * 16 + 4 * fq) = o; } }
    }
};
struct EpiMoe2 {
    static constexpr bool PERM = false, AFTER_DRAIN = false;
    bf16_t* RB; const int* rowmap; float alpha;
    __device__ __forceinline__ void operator()(const f32x4 (&acc)[2][2][4][2], const Unit& u, int wr, int wc, int fr, int fq) const {
        const int row0 = u.pm * BM + wr * 64 + fr, col0 = u.pn * BM + wc * 32 + 4 * fq;
#pragma unroll
        for (int ai = 0; ai < 2; ++ai)
#pragma unroll
            for (int m = 0; m < 4; ++m) { const int tok = rowmap[row0 + ai * HALF + m * 16];
                if (tok >= 0) { const size_t off = (size_t)tok * 1024 + col0;
#pragma unroll
                    for (int bj = 0; bj < 2; ++bj)
#pragma unroll
                        for (int n = 0; n < 2; ++n) { const u32x2 b = *(const u32x2*)(RB + off + bj * HALF + n * 16); const f32x4 a = acc[ai][bj][m][n];
                            u32x2 w; w.x = cvt_pk_bf16(bf_lo(b.x) * alpha + a[0], bf_hi(b.x) * alpha + a[1]); w.y = cvt_pk_bf16(bf_lo(b.y) * alpha + a[2], bf_hi(b.y) * alpha + a[3]); *(u32x2*)(RB + off + bj * HALF + n * 16) = w; } } }
    }
};

template <class Epi, class Sched, bool ALIGN_EPI = false, bool SP2 = false>
__device__ __forceinline__ void gemm_phase(PG8_LAS unsigned char* lds, const Gemm g, const Sched& S, const Epi& E) {
    const int tid = threadIdx.x, wid = __builtin_amdgcn_readfirstlane(tid >> 6), lane = tid & 63, wr = wid >> 2, wc = wid & 3, fr = lane & 15, fq = lane >> 4;
    const int K = g.K, nt = K / BK;
    unsigned voffA[2], voffB[2]; int Rv[2], Cv[2];
#pragma unroll
    for (int i = 0; i < 2; ++i) { int R, C; stage_rc(tid * 16 + i * 8192, R, C); const int Rb = Epi::PERM ? ((R & ~31) + perm32(R & 31)) : R; Rv[i] = R; Cv[i] = C;
        voffA[i] = (unsigned)(R * K + C) * 2u; voffB[i] = (unsigned)(Rb * K + C) * 2u; }
    constexpr bool GATHER = Sched::GATHER; static_assert(!GATHER || SP2, "gather is wired into the SP2 loop only");
    unsigned gA[2][2], gN[2][2];
#define PG8_SETG(G_, U_) do { _Pragma("unroll") for (int _h = 0; _h < 2; ++_h) _Pragma("unroll") for (int _i = 0; _i < 2; ++_i) G_[_h][_i] = GATHER ? (unsigned)S.arow(U_, _h * HALF + Rv[_i]) * (unsigned)(K * 2) + (unsigned)(Cv[_i] * 2) : voffA[_i]; } while (0)
#define PG8_SELG(dst, h_, nx_) unsigned dst[2] = { (nx_) ? gN[h_][0] : gA[h_][0], (nx_) ? gN[h_][1] : gA[h_][1] }
    const size_t kstep = (size_t)(BK * 2);
    const size_t hstep = (size_t)HALF * K * 2;
    const size_t hstepA = GATHER ? (size_t)0 : hstep;
    const size_t tstep = 2 * hstep;
    const unsigned ldsw = (unsigned)wid * 1024u;
    const int aoff = lds_byte(wr * 64 + fr, fq * 8), boff = lds_byte(wc * 32 + fr, fq * 8);
#define PG8_SA(b, h) (((b) * 2 + (h)) * HTB)
#define PG8_SB(b, h) ((4 + (b) * 2 + (h)) * HTB)
#define PG8_STAGE(bufoff, gbase, voff) do { _Pragma("unroll") for (int _i = 0; _i < 2; ++_i) \
        __builtin_amdgcn_global_load_lds((const unsigned*)((const char*)(gbase) + (voff)[_i]), (PG8_LAS unsigned*)(lds + (bufoff) + ldsw + _i * 8192), 16, 0, 0); } while (0)
#define PG8_LDA(dst, b, h) do { _Pragma("unroll") for (int m = 0; m < 4; ++m) _Pragma("unroll") for (int k = 0; k < 2; ++k) dst[m][k] = *(const PG8_LAS bf16x8*)(lds + PG8_SA(b, h) + aoff + m * 2048 + k * 1024); } while (0)
#define PG8_LDB(dst, b, h) do { _Pragma("unroll") for (int n = 0; n < 2; ++n) _Pragma("unroll") for (int k = 0; k < 2; ++k) dst[n][k] = *(const PG8_LAS bf16x8*)(lds + PG8_SB(b, h) + boff + n * 2048 + k * 1024); } while (0)
#define PG8_MMA(ai, bj, At, Bt) do { __builtin_amdgcn_s_setprio(1); _Pragma("unroll") for (int m = 0; m < 4; ++m) _Pragma("unroll") for (int n = 0; n < 2; ++n) _Pragma("unroll") for (int k = 0; k < 2; ++k) \
        acc[ai][bj][m][n] = __builtin_amdgcn_mfma_f32_16x16x32_bf16(Bt[n][k], At[m][k], acc[ai][bj][m][n], 0, 0, 0); __builtin_amdgcn_s_setprio(0); } while (0)
#define PG8_WAIT_V(n) asm volatile("s_waitcnt vmcnt(" #n ")" ::: "memory")
#define PG8_WAIT_L(n) asm volatile("s_waitcnt lgkmcnt(" #n ")" ::: "memory")
#define PG8_BAR __builtin_amdgcn_s_barrier()
#define PG8_SCHED __builtin_amdgcn_sched_barrier(0)
    Unit cur, nxt; int ui = 0;
    if (!S.next(0, cur)) return;
    f32x4 acc[2][2][4][2];
#pragma unroll
    for (int a = 0; a < 2; ++a)
#pragma unroll
        for (int b = 0; b < 2; ++b)
#pragma unroll
            for (int m = 0; m < 4; ++m)
#pragma unroll
                for (int n = 0; n < 2; ++n) acc[a][b][m][n] = (f32x4){0.f, 0.f, 0.f, 0.f};
    bf16x8 At[4][2], B0[2][2], B1[2][2];
    const char* cA = GATHER ? (const char*)g.A : S.aptr(g, cur, tstep); const char* cB = S.bptr(g, cur, tstep);
    S.a_ready(cur);
    PG8_SETG(gA, cur);
    if constexpr (SP2) {
        PG8_STAGE(PG8_SB(0, 0), cB, voffB); PG8_STAGE(PG8_SB(0, 1), cB + hstep, voffB); PG8_STAGE(PG8_SA(0, 0), cA, gA[0]); PG8_STAGE(PG8_SA(0, 1), cA + hstepA, gA[1]);
        if (wr == 1) PG8_BAR;
        PG8_WAIT_V(2); PG8_BAR;
        PG8_STAGE(PG8_SB(1, 0), cB + kstep, voffB); PG8_STAGE(PG8_SA(1, 0), cA + kstep, gA[0]); PG8_STAGE(PG8_SB(1, 1), cB + hstep + kstep, voffB);
        PG8_WAIT_V(6); PG8_BAR;
    } else {
        PG8_STAGE(PG8_SB(0, 0), cB, voffB); PG8_STAGE(PG8_SA(0, 0), cA, voffA); PG8_STAGE(PG8_SB(0, 1), cB + hstep, voffB); PG8_STAGE(PG8_SA(0, 1), cA + hstep, voffA);
        if (wr == 1) PG8_BAR;
        PG8_WAIT_V(4); PG8_BAR;
        PG8_STAGE(PG8_SB(1, 0), cB + kstep, voffB); PG8_STAGE(PG8_SA(1, 0), cA + kstep, voffA); PG8_STAGE(PG8_SB(1, 1), cB + hstep + kstep, voffB);
        PG8_WAIT_V(6); PG8_BAR;
    }
    for (;;) {
        const bool has_next = S.next(ui + 1, nxt);
        const char* nA = (has_next && !GATHER) ? S.aptr(g, nxt, tstep) : cA; const char* nB = has_next ? S.bptr(g, nxt, tstep) : cB;
        if (has_next) PG8_SETG(gN, nxt); else { _Pragma("unroll") for (int _h = 0; _h < 2; ++_h) _Pragma("unroll") for (int _i = 0; _i < 2; ++_i) gN[_h][_i] = gA[_h][_i]; }
        asm volatile(PG8_KALIGN ::: "memory");
        for (int t = 0; t < nt; t += 2) {
            const bool last = (t == nt - 2);
            const char* a1 = cA + (size_t)(t + 1) * kstep;
            const char* a2 = last ? nA : cA + (size_t)(t + 2) * kstep; const char* b2 = last ? nB : cB + (size_t)(t + 2) * kstep;
            const char* a3 = a2 + kstep; const char* b3 = b2 + kstep;
            if (last && has_next) S.a_ready(nxt);
            if constexpr (SP2) {
            PG8_LDB(B0, 0, 0); PG8_LDB(B1, 0, 1); PG8_SCHED; PG8_LDA(At, 0, 0); PG8_STAGE(PG8_SA(1, 1), a1 + hstepA, gA[1]);
            PG8_WAIT_V(8); PG8_WAIT_L(0); PG8_BAR; PG8_MMA(0, 0, At, B0); PG8_MMA(0, 1, At, B1); PG8_BAR; PG8_SCHED;
            PG8_LDA(At, 0, 1); PG8_STAGE(PG8_SB(0, 0), b2, voffB); PG8_STAGE(PG8_SB(0, 1), b2 + hstep, voffB); { PG8_SELG(gs_, 0, last); PG8_STAGE(PG8_SA(0, 0), a2, gs_); }
            PG8_WAIT_V(8); PG8_WAIT_L(0); PG8_BAR; PG8_MMA(1, 0, At, B0); PG8_MMA(1, 1, At, B1); PG8_BAR; PG8_SCHED;
            PG8_LDB(B0, 1, 0); PG8_LDB(B1, 1, 1); PG8_SCHED; PG8_LDA(At, 1, 0); { PG8_SELG(gs_, 1, last); PG8_STAGE(PG8_SA(0, 1), a2 + hstepA, gs_); }
            PG8_WAIT_V(8); PG8_WAIT_L(0); PG8_BAR; PG8_MMA(0, 0, At, B0); PG8_MMA(0, 1, At, B1); PG8_BAR; PG8_SCHED;
            PG8_LDA(At, 1, 1); PG8_STAGE(PG8_SB(1, 0), b3, voffB); PG8_STAGE(PG8_SB(1, 1), b3 + hstep, voffB); { PG8_SELG(gs_, 0, last); PG8_STAGE(PG8_SA(1, 0), a3, gs_); }
            PG8_WAIT_V(8); PG8_WAIT_L(0); PG8_BAR; PG8_MMA(1, 0, At, B0); PG8_MMA(1, 1, At, B1); PG8_BAR; PG8_SCHED;
            } else {
            PG8_LDB(B0, 0, 0); PG8_SCHED; PG8_LDA(At, 0, 0); PG8_STAGE(PG8_SA(1, 1), a1 + hstep, voffA);
            PG8_WAIT_L(8); PG8_BAR; PG8_WAIT_L(0); PG8_MMA(0, 0, At, B0); PG8_BAR; PG8_SCHED;
            PG8_LDB(B1, 0, 1); PG8_STAGE(PG8_SB(0, 0), b2, voffB);
            PG8_BAR; PG8_WAIT_L(0); PG8_MMA(0, 1, At, B1); PG8_BAR;
            PG8_LDA(At, 0, 1); PG8_STAGE(PG8_SA(0, 0), a2, voffA);
            PG8_BAR; PG8_WAIT_L(0); PG8_MMA(1, 0, At, B0); PG8_BAR; PG8_SCHED;
            PG8_STAGE(PG8_SB(0, 1), b2 + hstep, voffB);
            PG8_WAIT_V(6); PG8_BAR; PG8_MMA(1, 1, At, B1); PG8_BAR;
            PG8_LDB(B0, 1, 0); PG8_SCHED; PG8_LDA(At, 1, 0); PG8_STAGE(PG8_SA(0, 1), a2 + hstep, voffA);
            PG8_WAIT_L(8); PG8_BAR; PG8_WAIT_L(0); PG8_MMA(0, 0, At, B0); PG8_BAR; PG8_SCHED;
            PG8_LDB(B1, 1, 1); PG8_STAGE(PG8_SB(1, 0), b3, voffB);
            PG8_BAR; PG8_WAIT_L(0); PG8_MMA(0, 1, At, B1); PG8_BAR;
            PG8_LDA(At, 1, 1); PG8_STAGE(PG8_SA(1, 0), a3, voffA);
            PG8_BAR; PG8_WAIT_L(0); PG8_MMA(1, 0, At, B0); PG8_BAR; PG8_SCHED;
            PG8_STAGE(PG8_SB(1, 1), b3 + hstep, voffB);
            PG8_WAIT_V(6); PG8_BAR; PG8_MMA(1, 1, At, B1); PG8_BAR;
            }
        }
        if constexpr (ALIGN_EPI) { if (wr == 0) PG8_BAR; }
        if constexpr (!Epi::AFTER_DRAIN) { E(acc, cur, wr, wc, fr, fq); S.done(cur); }
        if (!has_next) break;
#pragma unroll
        for (int a = 0; a < 2; ++a)
#pragma unroll
            for (int b = 0; b < 2; ++b)
#pragma unroll
                for (int m = 0; m < 4; ++m)
#pragma unroll
                    for (int n = 0; n < 2; ++n) acc[a][b][m][n] = (f32x4){0.f, 0.f, 0.f, 0.f};
        cur = nxt; cA = nA; cB = nB; ++ui;
#pragma unroll
        for (int _h = 0; _h < 2; ++_h)
#pragma unroll
            for (int _i = 0; _i < 2; ++_i) gA[_h][_i] = gN[_h][_i];
        if constexpr (ALIGN_EPI) { if (wr == 1) PG8_BAR; }
    }
    PG8_WAIT_V(0);
    if constexpr (!ALIGN_EPI) { if (wr == 0) PG8_BAR; }
    PG8_BAR;
    if constexpr (Epi::AFTER_DRAIN) { E.fused(acc, cur, wr, wc, fr, fq, lds, wid, lane); S.done(cur); }
#undef PG8_SETG
#undef PG8_SELG
#undef PG8_SA
#undef PG8_SB
#undef PG8_STAGE
#undef PG8_LDA
#undef PG8_LDB
#undef PG8_MMA
#undef PG8_WAIT_V
#undef PG8_WAIT_L
#undef PG8_BAR
#undef PG8_SCHED
}
}

constexpr int NWAVES = 8;
constexpr int BATCH = 4, SEQ = 8192, DM = 1024, NTOK = BATCH * SEQ;
constexpr int NPH = 18;
constexpr float LN_EPS = 1e-5f;
constexpr float ALPHA = 1.4142135623730951f;
constexpr float QSCALE = 0.125f;
constexpr float NAIVE_SC = 0.6931471805599453f;
constexpr int MAXPAN = 152, MAXROWS = MAXPAN * 256;
constexpr size_t MiB = 1u << 20;
constexpr size_t WS_CTL = 0, CTL_ZERO_BYTES = 1 * MiB;
constexpr size_t WS_POSB = 1 * MiB, WS_KC = 1 * MiB + 4096, WS_VC = WS_KC + 524288, WS_KMEAN = WS_VC + 524288;
constexpr size_t WS_KMH = 2 * MiB + 512 * 1024, WS_KML = 2 * MiB + 768 * 1024;
constexpr size_t WS_W1T = 3 * MiB;
constexpr size_t WS_COS = 4 * MiB, WS_SIN = 8 * MiB;
constexpr size_t WS_TOKI = 12 * MiB, WS_ROWMAP = WS_TOKI + 524288, WS_WROW = WS_ROWMAP + 262144;
constexpr size_t WS_HIST = 13 * MiB + 512 * 1024, WS_GTAB = WS_HIST + 32768;
constexpr size_t WS_WIN0 = 14 * MiB, WS_WOUT0 = 20 * MiB, WS_WIN1 = 22 * MiB, WS_WOUT1 = 28 * MiB, WS_W1E = 30 * MiB, WS_B2 = 62 * MiB;
constexpr size_t WS_ABF = 110 * MiB, WS_O = 174 * MiB, WS_QKV = 238 * MiB, WS_END = 430 * MiB;
constexpr size_t WS_GATES = WS_QKV + 176 * MiB;
constexpr size_t WS_XS = WS_QKV, WS_H = WS_QKV + 80 * MiB;
static_assert(WS_WROW + (size_t)MAXROWS * 8 <= WS_WIN0 && WS_KMEAN + 262144 <= WS_COS && (size_t)MAXROWS * 2048 <= 80 * MiB && (size_t)MAXROWS * 1024 <= 96 * MiB, "ws map");
constexpr int CW_BAR = 4096;
constexpr int CW_Q = 20480;
constexpr int CW_CNT = 16384;
constexpr int RING_BYTES = 131072;
constexpr int LDSCTL_OFF = RING_BYTES, MISC_OFF = LDSCTL_OFF + 320;
constexpr int PTAB_OFF = LDSCTL_OFF + 1024;
constexpr int LDS_BYTES = 147456;

#define GAS __attribute__((address_space(1)))
#define LAS __attribute__((address_space(3)))
typedef unsigned short bf16;
typedef unsigned v4u __attribute__((ext_vector_type(4)));
typedef unsigned v2u __attribute__((ext_vector_type(2)));
typedef float f32x4 __attribute__((ext_vector_type(4)));
typedef GAS unsigned gu32;
#define RLX_AGENT __ATOMIC_RELAXED, __HIP_MEMORY_SCOPE_AGENT
#define LDS_WAIT() asm volatile("s_waitcnt lgkmcnt(0)" ::: "memory")
__device__ __forceinline__ unsigned f2bf(float f) { unsigned u = __builtin_bit_cast(unsigned, f); return (u + 0x7fffu + ((u >> 16) & 1u)) >> 16; }
__device__ __forceinline__ unsigned pk2(float lo, float hi) { return f2bf(lo) | (f2bf(hi) << 16); }
__device__ __forceinline__ float bflo(unsigned u) { return __builtin_bit_cast(float, u << 16); }
__device__ __forceinline__ float bfhi(unsigned u) { return __builtin_bit_cast(float, u & 0xffff0000u); }
__device__ __forceinline__ float bf2f(bf16 h) { return __builtin_bit_cast(float, (unsigned)h << 16); }

#define XB_TMO      128
#define XB_XCNT(j)  (256  + 64 * (j))
#define XB_XSUB(j)  (1280 + 64 * (j))
#define XB_XGEN(j)  (2304 + 64 * (j))
#define XB_TOP      3328
#define XB_TOPGEN   3392
#define XCD_BAR_WORDS 3456
#define XB_SPIN_CAP (1u << 24)
__device__ __forceinline__ unsigned xb_ld(unsigned* p)              { return __hip_atomic_load(p, __ATOMIC_RELAXED, __HIP_MEMORY_SCOPE_AGENT); }
__device__ __forceinline__ unsigned xb_add(unsigned* p, unsigned v) { return __hip_atomic_fetch_add(p, v, __ATOMIC_RELAXED, __HIP_MEMORY_SCOPE_AGENT); }
__device__ __forceinline__ unsigned xb_xcc_id() { return (unsigned)__builtin_amdgcn_s_getreg((3 << 11) | 20) & 0xFu; }
#define XB_SPIN(cond, bar) do { unsigned _sp = 0; while (cond) { __builtin_amdgcn_s_sleep(1); \
    if ((++_sp & 255u) == 0u) { if (xb_ld(&(bar)[XB_TMO])) break; if (_sp > XB_SPIN_CAP) { atomicAdd(&(bar)[XB_TMO], 1u); break; } } } } while (0)
struct XcdBarrier { unsigned* bar; unsigned x; volatile LAS unsigned* st; };
__device__ __forceinline__ XcdBarrier xcd_barrier_post(unsigned* bar, volatile LAS unsigned* st) {
    XcdBarrier b; b.bar = bar; b.x = xb_xcc_id(); b.st = st;
    if (threadIdx.x == 0) (void)xb_add(&bar[XB_XCNT(b.x)], 1u);
    return b;
}
__device__ __forceinline__ void xcd_barrier_complete(unsigned* bar, unsigned x, unsigned& nloc, unsigned& nx) {
    const unsigned G = gridDim.x * gridDim.y * gridDim.z;
    unsigned sum, cnt, mine, sp = 0u;
    for (;;) {
        sum = 0u; cnt = 0u; mine = 0u;
#pragma unroll
        for (unsigned j = 0; j < 16; ++j) { const unsigned c = xb_ld(&bar[XB_XCNT(j)]); sum += c; cnt += (c > 0u) ? 1u : 0u; mine = (j == x) ? c : mine; }
        if (sum == G) break;
        __builtin_amdgcn_s_sleep(1);
        if ((++sp & 255u) == 0u) { if (xb_ld(&bar[XB_TMO])) break; if (sp > XB_SPIN_CAP) { atomicAdd(&bar[XB_TMO], 1u); break; } }
    }
    nloc = mine > 0u ? mine : 1u; nx = cnt > 0u ? cnt : 1u;
}
__device__ __forceinline__ void xcd_barrier(const XcdBarrier& b) {
    asm volatile("s_waitcnt vmcnt(0)" ::: "memory");
    __syncthreads();
    if (threadIdx.x == 0) {
        unsigned* bar = b.bar;
        __builtin_amdgcn_s_waitcnt(0);
        unsigned nloc = b.st[0], nx = b.st[1];
        if (nloc == 0u) { xcd_barrier_complete(bar, b.x, nloc, nx); b.st[0] = nloc; b.st[1] = nx; }
        const unsigned old = xb_add(&bar[XB_XSUB(b.x)], 1u);
        const unsigned gen = old / nloc;
        if (old + 1u == (gen + 1u) * nloc) {
            __builtin_amdgcn_fence(__ATOMIC_RELEASE, "agent");
            asm volatile("s_waitcnt vmcnt(0)" ::: "memory");
            const unsigned og = xb_add(&bar[XB_TOP], 1u);
            const unsigned tg = og / nx;
            if (og + 1u == (tg + 1u) * nx) xb_add(&bar[XB_TOPGEN], 1u);
            else XB_SPIN(xb_ld(&bar[XB_TOPGEN]) == tg, bar);
            __builtin_amdgcn_fence(__ATOMIC_ACQUIRE, "agent");
            xb_add(&bar[XB_XGEN(b.x)], 1u);
            asm volatile("s_waitcnt vmcnt(0)" ::: "memory");
        } else {
            XB_SPIN(xb_ld(&bar[XB_XGEN(b.x)]) == gen, bar);
            __builtin_amdgcn_fence(__ATOMIC_ACQUIRE, "agent");
            asm volatile("s_waitcnt vmcnt(0)" ::: "memory");
        }
    }
    __syncthreads();
}

struct Args { const float* in[23]; float* out; unsigned char* ws; int ph_lo, ph_hi, use_bar, pad; };
struct Frame {
    LAS unsigned char* lds;
    unsigned char* ws;
    int tid, lane, wave, vcu, G;
};
__device__ __forceinline__ float wave_sum(float v) {
#pragma unroll
    for (int o = 1; o < 64; o <<= 1) v += __shfl_xor(v, o);
    return v;
}

template <class Map>
__device__ __forceinline__ void tr_item(const float* W, int N, int kb, int nb, bf16* WT, int ldt, int koff, LAS float* scr, int lane, Map map) {
    const int k0 = 64 * kb, n0 = 32 * nb;
#pragma unroll 8
    for (int i = 0; i < 32; ++i) { const int kk = 2 * i + (lane >> 5), n = n0 + (lane & 31); scr[kk * 33 + (lane & 31)] = (n < N) ? W[(size_t)(k0 + kk) * N + n] : 0.f; }
    LDS_WAIT(); asm volatile("" ::: "memory");
    const int c = lane & 7;
#pragma unroll
    for (int j = 0; j < 4; ++j) { const int nl = (lane >> 3) + 8 * j, n = n0 + nl; const LAS float* s = scr + (8 * c) * 33 + nl;
        if (n < N) { const int row = map(n);
            if (row >= 0) { v4u o; o.x = pk2(s[0 * 33], s[1 * 33]); o.y = pk2(s[2 * 33], s[3 * 33]); o.z = pk2(s[4 * 33], s[5 * 33]); o.w = pk2(s[6 * 33], s[7 * 33]);
                *(v4u*)(WT + (size_t)row * ldt + koff + k0 + 8 * c) = o; } } }
    LDS_WAIT(); asm volatile("" ::: "memory");
}
__device__ __forceinline__ int rope_perm(int d) { return d < 32 ? 2 * d : 2 * (d - 32) + 1; }
struct MapIdent { __device__ __forceinline__ int operator()(int n) const { return n; } };
struct MapGU { int up; __device__ __forceinline__ int operator()(int n) const { return (n >> 2) * 8 + up * 4 + (n & 3); } };
struct MapIn0 {
    __device__ __forceinline__ int operator()(int n) const {
        int hs, d; bool rope;
        if (n < 512) { hs = n >> 6; d = n & 63; rope = true; }
        else if (n < 1280) { const int seg = (n - 512) >> 7, w = (n - 512) & 127;
            rope = (seg & 1) == 0; hs = (rope ? 8 : 14) + (seg >> 1) * 2 + (w >> 6); d = w & 63; }
        else if (n < 1304) { return 44 * 64 + (n - 1280); }
        else { const int m = n - 1304, t = m >> 9; hs = 20 + t * 8 + ((m & 511) >> 6); d = m & 63; rope = t < 2; }
        return hs * 64 + (rope ? rope_perm(d) : d);
    }
};
__device__ __forceinline__ void bucket_pair(int pi, int& lo, int& hi) { lo = pi < 3 ? 0 : (pi < 5 ? 1 : 2); hi = pi < 3 ? pi + 1 : (pi < 5 ? pi - 1 : 3); }

__device__ __forceinline__ void p0_prologue(Frame& F, const Args& A) {
    LAS float* scr = (LAS float*)(F.lds + F.wave * 16384);
    const int gw = F.vcu * NWAVES + F.wave, NGW = F.G * NWAVES;
    bf16* WIN0 = (bf16*)(F.ws + WS_WIN0); bf16* WOUT0 = (bf16*)(F.ws + WS_WOUT0); bf16* WIN1 = (bf16*)(F.ws + WS_WIN1); bf16* WOUT1 = (bf16*)(F.ws + WS_WOUT1);
    bf16* W1E = (bf16*)(F.ws + WS_W1E); bf16* B2 = (bf16*)(F.ws + WS_B2);
    constexpr int I_A = 16 * 89, I_B = 16 * 32, I_C = 16 * 96, I_D = 16 * 32, I_E = 64 * 128, I_F = 96 * 128;
    constexpr int NITEMS = I_A + I_B + I_C + I_D + I_E + I_F;
    for (int it = gw; it < NITEMS; it += NGW) {
        int r = it;
        if (r < I_A) { tr_item(A.in[2], 2840, r / 89, r % 89, WIN0, 1024, 0, scr, F.lane, MapIn0()); continue; } r -= I_A;
        if (r < I_B) { tr_item(A.in[3], 1024, r / 32, r % 32, WOUT0, 1024, 0, scr, F.lane, MapIdent()); continue; } r -= I_B;
        if (r < I_C) { tr_item(A.in[10], 3072, r / 96, r % 96, WIN1, 1024, 0, scr, F.lane, MapIdent()); continue; } r -= I_C;
        if (r < I_D) { tr_item(A.in[11], 1024, r / 32, r % 32, WOUT1, 1024, 0, scr, F.lane, MapIdent()); continue; } r -= I_D;
        if (r < I_E) { const int job = r >> 7, sub = r & 127, le = job >> 1, up = job & 1;
            const float* src = (up ? A.in[21] : A.in[20]) + (size_t)le * 1024 * 256; MapGU mp; mp.up = up;
            tr_item(src, 256, sub >> 3, sub & 7, W1E + (size_t)le * 512 * 1024, 1024, 0, scr, F.lane, mp); continue; } r -= I_E;
        { const int job = r >> 7, sub = r & 127, slot = job & 1, lb = job >> 1, layer = lb / 24, bkt = lb % 24, g = bkt / 6; int lo, hi; bucket_pair(bkt % 6, lo, hi);
            const int e = g * 4 + (slot ? hi : lo);
            tr_item(A.in[22] + (size_t)(layer * 16 + e) * 256 * 1024, 1024, sub >> 5, sub & 31, B2 + (size_t)lb * 1024 * 512, 512, slot * 256, scr, F.lane, MapIdent()); }
    }
    { const float* x = A.in[0]; bf16* xb = (bf16*)(F.ws + WS_ABF);
      for (size_t i = (size_t)(F.vcu * 512 + F.tid); i < (size_t)NTOK * DM / 8; i += (size_t)F.G * 512) {
          const f32x4 a = *(const f32x4*)(x + i * 8), b = *(const f32x4*)(x + i * 8 + 4);
          v4u o; o.x = pk2(a[0], a[1]); o.y = pk2(a[2], a[3]); o.z = pk2(b[0], b[1]); o.w = pk2(b[2], b[3]); *(v4u*)(xb + i * 8) = o; } }
    { const int* pos = (const int*)A.in[1]; float* cosT = (float*)(F.ws + WS_COS); float* sinT = (float*)(F.ws + WS_SIN);
      for (int i = F.vcu * 512 + F.tid; i < NTOK * 32; i += F.G * 512) { const int tok = i >> 5, k = i & 31;
          const float inv = powf(10000.0f, -(float)k / 32.0f), ang = (float)pos[tok] * inv; cosT[i] = cosf(ang); sinT[i] = sinf(ang); } }
    { bf16* W1T = (bf16*)(F.ws + WS_W1T);
      for (int i = F.vcu * 512 + F.tid; i < 2 * 2048 * 128; i += F.G * 512) { const int sel = i >> 18, f = (i >> 7) & 2047, j = i & 127;
          const float v = A.in[sel ? 8 : 6][(size_t)f * 128 + j]; const int fp = sel ? f : ((f & ~63) | rope_perm(f & 63));
          W1T[(size_t)sel * 262144 + (size_t)j * 2048 + fp] = (bf16)f2bf(v); } }
    if (F.vcu < 32) { const int sel = F.vcu >> 4, j = 8 * (F.vcu & 15) + (F.tid & 7), part = F.tid >> 3; const float* pe = A.in[4 + sel]; const float* w1 = A.in[sel ? 8 : 6]; float s = 0.f;
#pragma unroll 8
        for (int i = part * 32; i < part * 32 + 32; ++i) s = fmaf(pe[i], w1[(size_t)i * 128 + j], s);
        __syncthreads();
        LAS float* red = (LAS float*)F.lds; red[F.tid] = s; __syncthreads();
        if (F.tid < 8) { float t = 0.f; for (int k = 0; k < 64; ++k) t += red[k * 8 + F.tid]; ((float*)(F.ws + WS_POSB))[sel * 128 + 8 * (F.vcu & 15) + F.tid] = t; } }
}

__device__ __forceinline__ float gelu_tanh(float x) { const float u = 0.7978845608028654f * (x + 0.044715f * x * x * x); return 0.5f * x * (1.0f + tanhf(u)); }
__device__ __forceinline__ void p2_compress(Frame& F, const Args& A) {
    typedef short bf16x8_ __attribute__((ext_vector_type(8))); typedef float f32x16_ __attribute__((ext_vector_type(16)));
    LAS float* part = (LAS float*)F.lds;
    LAS float* hid = (LAS float*)(F.lds + 32768);
    const bf16* qkv = (const bf16*)(F.ws + WS_QKV); const bf16* W1T = (const bf16*)(F.ws + WS_W1T);
    const float* posb = (const float*)(F.ws + WS_POSB);
    const int lane = F.lane, r32 = lane & 31, hi = lane >> 5, cg = F.wave & 3, kh = F.wave >> 2;
    for (int tile = F.vcu; tile < 256; tile += F.G) {
        const int sel = tile >> 7, bkv = (tile >> 4) & 7, n0 = (tile & 15) * 32;
        const bf16* src = qkv + (sel ? pg8::E_VCMP : pg8::E_KCMP) + (size_t)bkv * SEQ * 64;
        const float* w2 = A.in[sel ? 9 : 7];
        const int nrow = min(n0 + r32, 510);
        const bf16* ap = src + (size_t)nrow * 1024 + kh * 1024 + 8 * hi;
        const bf16* bp = W1T + (size_t)sel * 262144 + (size_t)(32 * cg + r32) * 2048 + kh * 1024 + 8 * hi;
        f32x16_ acc;
#pragma unroll
        for (int r = 0; r < 16; ++r) acc[r] = 0.f;
#pragma unroll 8
        for (int kk = 0; kk < 64; ++kk) { const bf16x8_ a = *(const bf16x8_*)(ap + 16 * kk), bb = *(const bf16x8_*)(bp + 16 * kk);
            acc = __builtin_amdgcn_mfma_f32_32x32x16_bf16(a, bb, acc, 0, 0, 0); }
#pragma unroll
        for (int r = 0; r < 16; ++r) part[kh * 4096 + ((r & 3) + 8 * (r >> 2) + 4 * hi) * 128 + 32 * cg + r32] = acc[r];
        __syncthreads();
        for (int idx = F.tid; idx < 4096; idx += 512) { const float x = part[idx] + part[4096 + idx] + posb[sel * 128 + (idx & 127)]; hid[idx] = gelu_tanh(x); }
        __syncthreads();
        { const int row = F.tid >> 4, c0 = (F.tid & 15) * 4; float y0 = 0.f, y1 = 0.f, y2 = 0.f, y3 = 0.f;
          for (int jj = 0; jj < 128; ++jj) { const float hv = hid[row * 128 + jj]; const f32x4 wv = *(const f32x4*)(w2 + jj * 64 + c0); y0 = fmaf(hv, wv[0], y0); y1 = fmaf(hv, wv[1], y1); y2 = fmaf(hv, wv[2], y2); y3 = fmaf(hv, wv[3], y3); }
          bf16* dst = (bf16*)(F.ws + (sel ? WS_VC : WS_KC)) + ((size_t)bkv * 512 + n0 + row) * 64;
          if (sel) { v2u w; w.x = pk2(y0, y1); w.y = pk2(y2, y3); *(v2u*)(dst + c0) = w; }
          else { dst[rope_perm(c0)] = (bf16)f2bf(y0); dst[rope_perm(c0 + 1)] = (bf16)f2bf(y1); dst[rope_perm(c0 + 2)] = (bf16)f2bf(y2); dst[rope_perm(c0 + 3)] = (bf16)f2bf(y3); } }
        __syncthreads();
    }
    { const bf16* km = qkv + pg8::E_KM; float* kmean = (float*)(F.ws + WS_KMEAN);
      for (int it = F.vcu * NWAVES + F.wave; it < 1024; it += F.G * NWAVES) { const int bh = it >> 5, blk = it & 31; float s = 0.f;
          const bf16* p = km + ((size_t)bh * SEQ + blk * 256) * 64 + F.lane;
          for (int i = 0; i < 256; ++i) s += bf2f(p[(size_t)i * 64]);
          const float mean = s * (1.0f / 256.0f); kmean[(size_t)it * 64 + F.lane] = mean;
          const unsigned hb = f2bf(mean); const float hf = __builtin_bit_cast(float, hb << 16);
          ((bf16*)(F.ws + WS_KMH))[(size_t)it * 64 + F.lane] = (bf16)hb; ((bf16*)(F.ws + WS_KML))[(size_t)it * 64 + F.lane] = (bf16)f2bf(mean - hf); } }
}

__device__ __forceinline__ void ldrow(const bf16* p, unsigned (&r)[32]) {
#pragma unroll
    for (int i = 0; i < 8; ++i) { const v4u t = *(const v4u*)(p + 8 * i); r[4 * i] = t.x; r[4 * i + 1] = t.y; r[4 * i + 2] = t.z; r[4 * i + 3] = t.w; }
}
__device__ __forceinline__ float dot64(const unsigned (&q)[32], const unsigned (&k)[32]) {
    float s0 = 0.f, s1 = 0.f;
#pragma unroll
    for (int i = 0; i < 32; ++i) { s0 = fmaf(bflo(q[i]), bflo(k[i]), s0); s1 = fmaf(bfhi(q[i]), bfhi(k[i]), s1); }
    return s0 + s1;
}
__device__ __forceinline__ void osm_step(bool ok, float s, float& m, float& l, float (&o)[64], const unsigned (&v)[32]) {
    if (ok) {
        if (s > m) { const float f = __expf(m - s); l *= f;
#pragma unroll
            for (int i = 0; i < 64; ++i) o[i] *= f;
            m = s; }
        const float p = __expf(s - m); l += p;
#pragma unroll
        for (int i = 0; i < 32; ++i) { o[2 * i] = fmaf(p, bflo(v[i]), o[2 * i]); o[2 * i + 1] = fmaf(p, bfhi(v[i]), o[2 * i + 1]); }
    }
}

__device__ __forceinline__ void p3_nsa_naive(Frame& F, const Args& A, bf16* O) {
    LAS float* imp = (LAS float*)F.lds;
    const bf16* qkv = (const bf16*)(F.ws + WS_QKV);
    const float* gates = (const float*)(F.ws + WS_GATES);
    const bf16* KC = (const bf16*)(F.ws + WS_KC); const bf16* VC = (const bf16*)(F.ws + WS_VC);
    for (int item = F.vcu; item < 512; item += F.G) {
        const int b = item >> 7, kv = (item >> 6) & 1, qt = item & 63;
        const int ql = F.tid >> 2, g = F.tid & 3, t = qt * 128 + ql, h = kv * 4 + g, tok = b * SEQ + t;
        unsigned q[32]; ldrow(qkv + pg8::E_QA + ((size_t)(b * 8 + h) * SEQ + t) * 64, q);
        float o[64]; float* otp = (float*)(F.ws + WS_ABF) + (size_t)tok * 512 + h * 64;
        for (int i = F.tid; i < 128 * 129; i += 512) imp[i] = 0.f;
        __syncthreads();
        const float g0 = gates[(size_t)tok * 24 + h * 3 + 0], g1 = gates[(size_t)tok * 24 + h * 3 + 1], g2 = gates[(size_t)tok * 24 + h * 3 + 2];
        const int nvis = t >= 31 ? min((t - 31) / 16 + 1, 511) : 0;
        const int nbound = min((qt * 128 + 127 - 31) / 16 + 1, 511);
        const bf16* kcp = KC + (size_t)(b * 2 + kv) * 512 * 64; const bf16* vcp = VC + (size_t)(b * 2 + kv) * 512 * 64;
        float m = -1e30f, l = 0.f;
#pragma unroll
        for (int i = 0; i < 64; ++i) o[i] = 0.f;
        for (int n = 0; n < nbound; ++n) { unsigned kr[32]; ldrow(kcp + (size_t)n * 64, kr);
            const float s = dot64(q, kr) * NAIVE_SC; asm volatile("" ::: "memory"); ldrow(vcp + (size_t)n * 64, kr); osm_step(n < nvis, s, m, l, o, kr); }
        float linv = 1.0f / fmaxf(l, 1e-30f);
#pragma unroll
        for (int i = 0; i < 16; ++i) { f32x4 w; w[0] = g0 * linv * o[4 * i]; w[1] = g0 * linv * o[4 * i + 1]; w[2] = g0 * linv * o[4 * i + 2]; w[3] = g0 * linv * o[4 * i + 3]; *(f32x4*)(otp + 4 * i) = w; }
        { float acc = 0.f;
          for (int n = 0; n < nbound; ++n) { unsigned kr[32]; ldrow(kcp + (size_t)n * 64, kr);
              const float s = dot64(q, kr) * NAIVE_SC; float p = (n < nvis) ? __expf(s - m) * linv : 0.f;
              p += __shfl_xor(p, 1); p += __shfl_xor(p, 2); acc += p;
              if ((n & 3) == 3) { if (g == 0) imp[ql * 129 + (n >> 2)] = acc; acc = p; } } }
        __syncthreads();
        const int cur = t >> 6; unsigned m0 = 0u, m1 = 0u, m2 = 0u, m3 = 0u;
#define SETBIT(j) do { const unsigned _b = 1u << ((j) & 31); const int _w = (j) >> 5; m0 |= _w == 0 ? _b : 0u; m1 |= _w == 1 ? _b : 0u; m2 |= _w == 2 ? _b : 0u; m3 |= _w == 3 ? _b : 0u; } while (0)
        if (cur < 16) { m0 = (1u << (cur + 1)) - 1u; }
        else { SETBIT(0); SETBIT(cur - 1); SETBIT(cur);
            for (int r = 0; r < 13; ++r) { float best = -0.5f; int bj = 1;
                for (int j = 1; j <= cur - 2; ++j) { const float v = imp[ql * 129 + j]; if (v > best) { best = v; bj = j; } }
                imp[ql * 129 + bj] = -1.0f; SETBIT(bj); } }
        m = -1e30f; l = 0.f;
#pragma unroll
        for (int i = 0; i < 64; ++i) o[i] = 0.f;
        { const bf16* kb = qkv + pg8::E_KSLC + (size_t)(b * 2 + kv) * SEQ * 64; const bf16* vb = qkv + pg8::E_VSLC + (size_t)(b * 2 + kv) * SEQ * 64;
          for (int it = 0; it < 16; ++it) {
              const bool have = (m0 | m1 | m2 | m3) != 0u; int j = 0;
              if (m0) { j = __builtin_ctz(m0); m0 &= m0 - 1u; } else if (m1) { j = 32 + __builtin_ctz(m1); m1 &= m1 - 1u; }
              else if (m2) { j = 64 + __builtin_ctz(m2); m2 &= m2 - 1u; } else if (m3) { j = 96 + __builtin_ctz(m3); m3 &= m3 - 1u; }
              for (int kk = 0; kk < 64; ++kk) { const int row = j * 64 + kk; unsigned kr[32]; ldrow(kb + (size_t)row * 64, kr);
                  const float s = dot64(q, kr) * NAIVE_SC; asm volatile("" ::: "memory"); ldrow(vb + (size_t)row * 64, kr); osm_step(have && row <= t, s, m, l, o, kr); } } }
        linv = 1.0f / fmaxf(l, 1e-30f);
#pragma unroll
        for (int i = 0; i < 16; ++i) { f32x4 w = *(const f32x4*)(otp + 4 * i); w[0] = fmaf(g1 * linv, o[4 * i], w[0]); w[1] = fmaf(g1 * linv, o[4 * i + 1], w[1]); w[2] = fmaf(g1 * linv, o[4 * i + 2], w[2]); w[3] = fmaf(g1 * linv, o[4 * i + 3], w[3]); *(f32x4*)(otp + 4 * i) = w; }
        m = -1e30f; l = 0.f;
#pragma unroll
        for (int i = 0; i < 64; ++i) o[i] = 0.f;
        { const bf16* kb = qkv + pg8::E_KWIN + (size_t)(b * 2 + kv) * SEQ * 64; const bf16* vb = qkv + pg8::E_VWIN + (size_t)(b * 2 + kv) * SEQ * 64;
          const int shi = qt * 128 + 127, slo = max(qt * 128 - 511, 0);
          for (int s_ = shi; s_ >= slo; --s_) { unsigned kr[32]; ldrow(kb + (size_t)s_ * 64, kr);
              const float s = dot64(q, kr) * NAIVE_SC; asm volatile("" ::: "memory"); ldrow(vb + (size_t)s_ * 64, kr); osm_step(s_ <= t && s_ > t - 512, s, m, l, o, kr); } }
        linv = 1.0f / fmaxf(l, 1e-30f);
        { bf16* op = O + (size_t)tok * 1024 + h * 64;
#pragma unroll
          for (int i = 0; i < 8; ++i) { const f32x4 a0 = *(const f32x4*)(otp + 8 * i), a1 = *(const f32x4*)(otp + 8 * i + 4); const float gl = g2 * linv; v4u w;
              w.x = pk2(fmaf(gl, o[8 * i], a0[0]), fmaf(gl, o[8 * i + 1], a0[1])); w.y = pk2(fmaf(gl, o[8 * i + 2], a0[2]), fmaf(gl, o[8 * i + 3], a0[3]));
              w.z = pk2(fmaf(gl, o[8 * i + 4], a1[0]), fmaf(gl, o[8 * i + 5], a1[1])); w.w = pk2(fmaf(gl, o[8 * i + 6], a1[2]), fmaf(gl, o[8 * i + 7], a1[3])); *(v4u*)(op + 8 * i) = w; } }
        __syncthreads();
    }
}

__device__ __forceinline__ void p3_moba_naive(Frame& F, const Args& A, bf16* O) {
    const bf16* qkv = (const bf16*)(F.ws + WS_QKV);
    const float* kmean = (const float*)(F.ws + WS_KMEAN);
    for (int item = F.vcu; item < 512; item += F.G) {
        const int bh = item >> 4, tile = item & 15, b = bh >> 3, h = bh & 7, t = tile * 512 + F.tid, tok = b * SEQ + t, cur = t >> 8;
        unsigned q[32]; ldrow(qkv + pg8::E_QM + ((size_t)bh * SEQ + t) * 64, q);
        float v0 = -3e38f, v1 = -3e38f, v2 = -3e38f; int i0 = -1, i1 = -1, i2 = -1;
        for (int n = 0; n < cur; ++n) { const float* kmp = kmean + ((size_t)bh * 32 + n) * 64; float gs = 0.f;
#pragma unroll
            for (int i = 0; i < 32; ++i) { gs = fmaf(bflo(q[i]), kmp[2 * i], gs); gs = fmaf(bfhi(q[i]), kmp[2 * i + 1], gs); }
            if (gs > v0) { v2 = v1; i2 = i1; v1 = v0; i1 = i0; v0 = gs; i0 = n; } else if (gs > v1) { v2 = v1; i2 = i1; v1 = gs; i1 = n; } else if (gs > v2) { v2 = gs; i2 = n; } }
        float o[64], m = -1e30f, l = 0.f;
#pragma unroll
        for (int i = 0; i < 64; ++i) o[i] = 0.f;
        const bf16* kb = qkv + pg8::E_KM + (size_t)bh * SEQ * 64; const bf16* vb = qkv + pg8::E_VM + (size_t)bh * SEQ * 64;
        for (int si = 0; si < 3; ++si) { const int j = si == 0 ? i0 : (si == 1 ? i1 : i2); const bool have = j >= 0; const int jj = have ? j : 0;
            for (int kk = 0; kk < 256; ++kk) { const int row = jj * 256 + kk; unsigned kr[32], vr[32]; ldrow(kb + (size_t)row * 64, kr); ldrow(vb + (size_t)row * 64, vr);
                const float s = dot64(q, kr) * NAIVE_SC; osm_step(have, s, m, l, o, vr); } }
        { const int r0 = (tile * 512 + (F.tid & ~63)) & ~255, r1 = tile * 512 + (F.tid | 63);
          for (int row = r0; row <= r1; ++row) { unsigned kr[32], vr[32]; ldrow(kb + (size_t)row * 64, kr); ldrow(vb + (size_t)row * 64, vr);
              const float s = dot64(q, kr) * NAIVE_SC; osm_step(row <= t, s, m, l, o, vr); } }
        const float linv = 1.0f / fmaxf(l, 1e-30f);
        { bf16* op = O + (size_t)tok * 1024 + 512 + h * 64;
#pragma unroll
          for (int i = 0; i < 8; ++i) { v4u w; w.x = pk2(o[8 * i] * linv, o[8 * i + 1] * linv); w.y = pk2(o[8 * i + 2] * linv, o[8 * i + 3] * linv); w.z = pk2(o[8 * i + 4] * linv, o[8 * i + 5] * linv); w.w = pk2(o[8 * i + 6] * linv, o[8 * i + 7] * linv); *(v4u*)(op + 8 * i) = w; } }
    }
}

__device__ __forceinline__ void p11_sb_naive(Frame& F, const Args& A) {
    const bf16* qkv = (const bf16*)(F.ws + WS_QKV);
    bf16* O = (bf16*)(F.ws + WS_O);
    for (int item = F.vcu; item < 1024; item += F.G) {
        const int bh = item >> 4, tile = item & 15, b = bh >> 4, h = bh & 15, t = tile * 512 + F.tid, tok = b * SEQ + t;
        unsigned q[32]; ldrow(qkv + ((size_t)bh * SEQ + t) * 64, q);
        const bf16* kb = qkv + (size_t)33554432 + (size_t)bh * SEQ * 64; const bf16* vb = qkv + (size_t)67108864 + (size_t)bh * SEQ * 64;
        float o[64], C = 0.f;
#pragma unroll
        for (int i = 0; i < 64; ++i) o[i] = 0.f;
        for (int s_ = tile * 512 + (F.tid | 63) - 1; s_ >= 0; --s_) {
            if (!__any(C > -120.f)) break;
            unsigned kr[32], vr[32]; ldrow(kb + (size_t)s_ * 64, kr); ldrow(vb + (size_t)s_ * 64, vr);
            const float z = dot64(q, kr) * NAIVE_SC, sp = fmaxf(z, 0.f) + __logf(1.0f + __expf(-fabsf(z)));
            if (s_ < t && C > -120.f) { const float w = __expf(z - sp + C); C -= sp;
#pragma unroll
                for (int i = 0; i < 32; ++i) { o[2 * i] = fmaf(w, bflo(vr[i]), o[2 * i]); o[2 * i + 1] = fmaf(w, bfhi(vr[i]), o[2 * i + 1]); } } }
        { bf16* op = O + (size_t)tok * 1024 + h * 64;
#pragma unroll
          for (int i = 0; i < 8; ++i) { v4u w; w.x = pk2(o[8 * i], o[8 * i + 1]); w.y = pk2(o[8 * i + 2], o[8 * i + 3]); w.z = pk2(o[8 * i + 4], o[8 * i + 5]); w.w = pk2(o[8 * i + 6], o[8 * i + 7]); *(v4u*)(op + 8 * i) = w; } }
    }
}

template <bool ROUTE, bool FINAL>
__device__ __forceinline__ void ln_phase(Frame& F, const Args& A, int layer, const float* gain, const float* bias, bf16* RB, float* outf) {
    const int TPW = NTOK / F.G, tok_lo = F.vcu * TPW;
    LAS float* WR = (LAS float*)F.lds;
    LAS int* hist = (LAS int*)(F.lds + 81920);
    if (ROUTE) {
        if (F.tid < 24) hist[F.tid] = 0;
        const float* wg = A.in[16] + (size_t)layer * 1024 * 4; const float* wrt = A.in[18] + (size_t)layer * 4 * 1024 * 4;
        for (int i = F.tid; i < 20 * 1024; i += 512) { const int c = i >> 10, k = i & 1023; WR[i] = c < 4 ? wg[k * 4 + c] : wrt[(size_t)((c - 4) >> 2) * 4096 + k * 4 + ((c - 4) & 3)]; }
        int* rowmap = (int*)(F.ws + WS_ROWMAP);
        for (int i = F.vcu * 512 + F.tid; i < MAXROWS; i += F.G * 512) rowmap[i] = -1;
        __syncthreads();
    }
    f32x4 gn[4], bs[4];
#pragma unroll
    for (int j = 0; j < 4; ++j) { gn[j] = *(const f32x4*)(gain + 4 * F.lane + 256 * j); bs[j] = *(const f32x4*)(bias + 4 * F.lane + 256 * j); }
    for (int ir = F.wave; ir < TPW; ir += NWAVES) { const int mrow = tok_lo + ir;
        bf16* xr = RB + (size_t)mrow * DM + 4 * F.lane;
        f32x4 v[4]; float s = 0.f;
#pragma unroll
        for (int j = 0; j < 4; ++j) { const v2u b = *(const v2u*)(xr + 256 * j); v[j][0] = bflo(b.x); v[j][1] = bfhi(b.x); v[j][2] = bflo(b.y); v[j][3] = bfhi(b.y); s += (v[j][0] + v[j][1]) + (v[j][2] + v[j][3]); }
        const float mean = wave_sum(s) * (1.f / DM); float s2 = 0.f;
#pragma unroll
        for (int j = 0; j < 4; ++j) { v[j] = v[j] - mean; s2 += (v[j][0] * v[j][0] + v[j][1] * v[j][1]) + (v[j][2] * v[j][2] + v[j][3] * v[j][3]); }
        const float rstd = 1.f / sqrtf(wave_sum(s2) * (1.f / DM) + LN_EPS);
#pragma unroll
        for (int j = 0; j < 4; ++j) { v[j] = v[j] * rstd * gn[j] + bs[j];
            if (FINAL) *(f32x4*)(outf + (size_t)mrow * DM + 4 * F.lane + 256 * j) = v[j];
            else { v2u w; w.x = pk2(v[j][0], v[j][1]); w.y = pk2(v[j][2], v[j][3]); *(v2u*)(xr + 256 * j) = w; } }
        if (ROUTE) {
            float lg[4];
#pragma unroll
            for (int c = 0; c < 4; ++c) { float p = 0.f;
#pragma unroll
                for (int j = 0; j < 4; ++j) { const f32x4 w = *(const LAS f32x4*)(WR + c * 1024 + 4 * F.lane + 256 * j); p += (v[j][0] * w[0] + v[j][1] * w[1]) + (v[j][2] * w[2] + v[j][3] * w[3]); }
                lg[c] = wave_sum(p) + A.in[17][layer * 4 + c]; }
            int g = 0; float gm = lg[0];
#pragma unroll
            for (int c = 1; c < 4; ++c) if (lg[c] > gm) { gm = lg[c]; g = c; }
            const float wgp = 1.0f / ((__expf(lg[0] - gm) + __expf(lg[1] - gm)) + (__expf(lg[2] - gm) + __expf(lg[3] - gm)));
            float le[4];
#pragma unroll
            for (int e = 0; e < 4; ++e) { float p = 0.f;
#pragma unroll
                for (int j = 0; j < 4; ++j) { const f32x4 w = *(const LAS f32x4*)(WR + (4 + g * 4 + e) * 1024 + 4 * F.lane + 256 * j); p += (v[j][0] * w[0] + v[j][1] * w[1]) + (v[j][2] * w[2] + v[j][3] * w[3]); }
                le[e] = wave_sum(p) + A.in[19][layer * 16 + g * 4 + e]; }
            int i1 = 0; float e1 = le[0];
#pragma unroll
            for (int e = 1; e < 4; ++e) if (le[e] > e1) { e1 = le[e]; i1 = e; }
            int i2 = -1; float e2 = -3e38f;
#pragma unroll
            for (int e = 0; e < 4; ++e) if (e != i1 && le[e] > e2) { e2 = le[e]; i2 = e; }
            const float w1 = 1.0f / (1.0f + __expf(e2 - e1)), w2 = 1.0f - w1;
            const int lo = min(i1, i2), hi = max(i1, i2), pi = lo == 0 ? hi - 1 : (lo == 1 ? hi + 1 : 5), bkt = g * 6 + pi;
            const float wlo = (i1 < i2 ? w1 : w2) * wgp, whi = (i1 < i2 ? w2 : w1) * wgp;
            if (F.lane == 0) { f32x4 ti; ti[0] = __builtin_bit_cast(float, bkt); ti[1] = 0.f; ti[2] = wlo; ti[3] = whi; *(f32x4*)(F.ws + WS_TOKI + (size_t)mrow * 16) = ti; }
            if (F.lane == 0) __hip_atomic_fetch_add(hist + bkt, 1, __ATOMIC_RELAXED, __HIP_MEMORY_SCOPE_WORKGROUP);
        }
    }
    if (ROUTE) { __syncthreads(); if (F.tid < 24) ((int*)(F.ws + WS_HIST))[F.vcu * 24 + F.tid] = hist[F.tid]; }
}
__device__ __forceinline__ void scatter_phase(Frame& F) {
    const int TPW = NTOK / F.G, tok_lo = F.vcu * TPW;
    LAS int* ptab = (LAS int*)(F.lds + PTAB_OFF); LAS int* pstart = (LAS int*)(F.lds + PTAB_OFF + 1024);
    LAS int* cnt = (LAS int*)(F.lds + PTAB_OFF + 1280); LAS int* lt = (LAS int*)(F.lds + PTAB_OFF + 1408);
    LAS int* H = (LAS int*)F.lds;
    LAS int* dstl = (LAS int*)(F.lds + 32768); LAS int* bkl = (LAS int*)(F.lds + 36864);
    __syncthreads();
    for (int i = F.tid; i < F.G * 24; i += 512) H[i] = ((const int*)(F.ws + WS_HIST))[i];
    for (int i = F.tid; i < TPW; i += 512) bkl[i] = *(const int*)(F.ws + WS_TOKI + (size_t)(tok_lo + i) * 16);
    __syncthreads();
    if (F.tid < 24) { int c = 0, l = 0; for (int v = 0; v < F.G; ++v) { const int h = H[v * 24 + F.tid]; c += h; l += v < F.vcu ? h : 0; } cnt[F.tid] = c; lt[F.tid] = l; }
    __syncthreads();
    if (F.tid == 0) { int p = 0;
        for (int bkt = 0; bkt < 24; ++bkt) { const int np = (cnt[bkt] + 255) >> 8;
            pstart[bkt] = p; for (int i = 0; i < np && p < MAXPAN; ++i) ptab[p++] = bkt; }
        pstart[24] = p;
        for (int i = 0; i < TPW; ++i) { const int bkt = bkl[i]; dstl[i] = pstart[bkt] * 256 + lt[bkt]; lt[bkt] = lt[bkt] + 1; } }
    __syncthreads();
    if (F.vcu == 0) { int* gt = (int*)(F.ws + WS_GTAB); const int np = pstart[24]; if (F.tid == 0) gt[0] = np; if (F.tid < np) gt[1 + F.tid] = ptab[F.tid]; }
    int* rowmap = (int*)(F.ws + WS_ROWMAP); float* wrow = (float*)(F.ws + WS_WROW);
    for (int i = F.tid; i < TPW; i += 512) {
        const int mrow = tok_lo + i, dst = dstl[i];
        const f32x4 ti = *(const f32x4*)(F.ws + WS_TOKI + (size_t)mrow * 16);
        rowmap[dst] = mrow; wrow[(size_t)dst * 2] = ti[2]; wrow[(size_t)dst * 2 + 1] = ti[3];
    }
    __syncthreads();
}
__device__ __forceinline__ int load_ptab(Frame& F) {
    LAS int* ptab = (LAS int*)(F.lds + PTAB_OFF); const int* gt = (const int*)(F.ws + WS_GTAB);
    __syncthreads();
    const int np = gt[0];
    if (F.tid < np && F.tid < MAXPAN) ptab[F.tid] = gt[1 + F.tid];
    __syncthreads();
    return np < MAXPAN ? np : MAXPAN;
}
struct MoeOrder1 {
    static constexpr bool GATHER = true;
    int G, c, nunits; const LAS int* ptab; const bf16* W1E; const int* rowmap;
    __device__ __forceinline__ int arow(const pg8::Unit& u, int r) const { const int t = rowmap[u.pm * 256 + r]; return t < 0 ? 0 : t; }
    __device__ __forceinline__ bool next(int i, pg8::Unit& u) const { const int L = i * G + c; if (L >= nunits) return false; u.pm = L >> 2; u.pn = L & 3; u.aux = __builtin_amdgcn_readfirstlane(ptab[u.pm]); return true; }
    __device__ __forceinline__ const char* aptr(const pg8::Gemm& g, const pg8::Unit& u, size_t tstep) const { return (const char*)g.A + (size_t)u.pm * tstep; }
    __device__ __forceinline__ const char* bptr(const pg8::Gemm& g, const pg8::Unit& u, size_t tstep) const {
        const int grp = u.aux / 6; int lo, hi; bucket_pair(u.aux % 6, lo, hi); const int e = grp * 4 + ((u.pn >> 1) ? hi : lo);
        return (const char*)(W1E + ((size_t)e * 512 + (size_t)(u.pn & 1) * 256) * 1024); }
    __device__ __forceinline__ void a_ready(const pg8::Unit&) const {}
    __device__ __forceinline__ void done(const pg8::Unit&) const {}
};
struct MoeOrder2 {
    static constexpr bool GATHER = false;
    __device__ __forceinline__ int arow(const pg8::Unit&, int) const { return 0; }
    int G, c, nunits; const LAS int* ptab; const bf16* B2;
    __device__ __forceinline__ bool next(int i, pg8::Unit& u) const { const int L = i * G + c; if (L >= nunits) return false; u.pm = L >> 2; u.pn = L & 3; u.aux = __builtin_amdgcn_readfirstlane(ptab[u.pm]); return true; }
    __device__ __forceinline__ const char* aptr(const pg8::Gemm& g, const pg8::Unit& u, size_t tstep) const { return (const char*)g.A + (size_t)u.pm * tstep; }
    __device__ __forceinline__ const char* bptr(const pg8::Gemm& g, const pg8::Unit& u, size_t tstep) const { return (const char*)(B2 + ((size_t)u.aux * 1024 + (size_t)u.pn * 256) * 512); }
    __device__ __forceinline__ void a_ready(const pg8::Unit&) const {}
    __device__ __forceinline__ void done(const pg8::Unit&) const {}
};

#define KOFF(i) (32 * ((i) >> 4) + 8 * (((i) & 15) >> 2) + ((i) & 3))
typedef short bf16x8 __attribute__((ext_vector_type(8)));
typedef short s16x4 __attribute__((ext_vector_type(4)));
typedef float f32x16 __attribute__((ext_vector_type(16)));
typedef float f32x2 __attribute__((ext_vector_type(2)));
#define MFMA32(a, b, c) __builtin_amdgcn_mfma_f32_32x32x16_bf16(a, b, c, 0, 0, 0)
#ifndef SB_EXIT
#define SB_EXIT 1
#endif
constexpr float L2E = 1.4426950408889634f, LN2 = 0.6931471805599453f;
__device__ __forceinline__ int crow(int r, int hi) { return (r & 3) + 8 * (r >> 2) + 4 * hi; }
typedef __bf16 bf16x2_t __attribute__((ext_vector_type(2)));
__device__ __forceinline__ unsigned cvtpk(float lo, float hi) { bf16x2_t v; v[0] = (__bf16)lo; v[1] = (__bf16)hi; return __builtin_bit_cast(unsigned, v); }
__device__ __forceinline__ void swap32(float v, float& r0, float& r1) { unsigned a = __builtin_bit_cast(unsigned, v), b = a;
    asm volatile("v_nop\n\tv_nop\n\tv_permlane32_swap_b32 %0, %1" : "+v"(a), "+v"(b)); r0 = __builtin_bit_cast(float, a); r1 = __builtin_bit_cast(float, b); }
__device__ __forceinline__ float swap_sum(float v) { float r0, r1; swap32(v, r0, r1); return r0 + r1; }
__device__ __forceinline__ float swap_max(float v) { float r0, r1; swap32(v, r0, r1); return fmaxf(r0, r1); }
__device__ __forceinline__ float swap_other(float v, int hi) { float r0, r1; swap32(v, r0, r1); return hi ? r0 : r1; }
__device__ __forceinline__ void kv_issue(const bf16* Kt, const bf16* Vt, int wave, int lane, v4u& kr, v4u& vr) {
    kr = *(const v4u*)(Kt + (size_t)lane * 64 + wave * 8);
    vr = *(const v4u*)(Vt + (size_t)(16 * (wave & 3) + (lane >> 2)) * 64 + (wave >> 2) * 32 + (lane & 3) * 8);
}
__device__ __forceinline__ void kv_commit(LAS unsigned char* kbuf, LAS unsigned char* vbuf, int wave, int lane, const v4u& kr, const v4u& vr) {
    *(LAS v4u*)(kbuf + wave * 1024 + lane * 16) = kr; *(LAS v4u*)(vbuf + wave * 1024 + lane * 16) = vr;
}
__device__ __forceinline__ void qk_tile(const LAS unsigned char* kbuf, const bf16x8 (&qr)[4], int r32, int hi, f32x16& p0, f32x16& p1, const float cinit = 0.f) {
#pragma unroll
    for (int r = 0; r < 16; ++r) { p0[r] = cinit; p1[r] = cinit; }
#pragma unroll
    for (int d0 = 0; d0 < 4; ++d0) { const LAS unsigned char* kp = kbuf + (2 * d0 + hi) * 1024 + r32 * 16;
        const bf16x8 k0 = *(const LAS bf16x8*)kp, k1 = *(const LAS bf16x8*)(kp + 512);
        p0 = MFMA32(k0, qr[d0], p0); p1 = MFMA32(k1, qr[d0], p1); }
}
__device__ __forceinline__ s16x4 vtr(const LAS unsigned char* p) { return __builtin_bit_cast(s16x4, __builtin_amdgcn_ds_read_tr16_b64_v4i16((LAS s16x4*)p)); }
__device__ __forceinline__ void pv_tile(const LAS unsigned char* vbuf, const f32x16& p0, const f32x16& p1, f32x16 (&o)[2], int lane, int hi) {
    const LAS unsigned char* vp0 = vbuf + ((lane >> 4) & 1) * 32 + (lane & 3) * 8 + (4 * hi + ((lane & 15) >> 2)) * 64;
#pragma unroll
    for (int s = 0; s < 4; ++s) { const int rb = 8 * (s & 1); v4u w;
        if (s < 2) { w.x = cvtpk(p0[rb], p0[rb + 1]); w.y = cvtpk(p0[rb + 2], p0[rb + 3]); w.z = cvtpk(p0[rb + 4], p0[rb + 5]); w.w = cvtpk(p0[rb + 6], p0[rb + 7]); }
        else       { w.x = cvtpk(p1[rb], p1[rb + 1]); w.y = cvtpk(p1[rb + 2], p1[rb + 3]); w.z = cvtpk(p1[rb + 4], p1[rb + 5]); w.w = cvtpk(p1[rb + 6], p1[rb + 7]); }
        const bf16x8 pb = __builtin_bit_cast(bf16x8, w);
#pragma unroll
        for (int dh = 0; dh < 2; ++dh) {
#ifdef DBG_SAFE_TR
            bf16x8 a;
#pragma unroll
            for (int j = 0; j < 8; ++j) { const int key = 16 * s + 8 * (j >> 2) + 4 * hi + (j & 3); a[j] = *(const LAS short*)(vbuf + dh * 4096 + key * 64 + (lane & 31) * 2); }
#else
            const s16x4 lo = vtr(vp0 + dh * 4096 + s * 1024), hi4 = vtr(vp0 + dh * 4096 + s * 1024 + 512);
            bf16x8 a; a[0] = lo[0]; a[1] = lo[1]; a[2] = lo[2]; a[3] = lo[3]; a[4] = hi4[0]; a[5] = hi4[1]; a[6] = hi4[2]; a[7] = hi4[3];
#endif
            o[dh] = MFMA32(a, pb, o[dh]); }
        __builtin_amdgcn_sched_barrier(0); }
}
__device__ __forceinline__ void store_o(bf16* orow, const f32x16 (&o)[2], int hi, float sc) {
#pragma unroll
    for (int dh = 0; dh < 2; ++dh)
#pragma unroll
        for (int g = 0; g < 4; ++g) { v2u w; w.x = pk2(o[dh][4 * g] * sc, o[dh][4 * g + 1] * sc); w.y = pk2(o[dh][4 * g + 2] * sc, o[dh][4 * g + 3] * sc);
            *(v2u*)(orow + 32 * dh + 8 * g + 4 * hi) = w; }
}

__device__ __forceinline__ void sb_process(f32x16& p0, f32x16& p1, int thr, int hi, float& A) {
    float sp[32], T[8];
    if (__all(thr >= 60)) {
#pragma unroll
        for (int i = 0; i < 32; i += 2) { f32x2 z = {i < 16 ? p0[i] : p1[i - 16], i < 16 ? p0[i + 1] : p1[i - 15]};
            f32x2 e; e[0] = __builtin_amdgcn_exp2f(-fabsf(z[0])); e[1] = __builtin_amdgcn_exp2f(-fabsf(z[1]));
            e = e + 1.0f; f32x2 lg; lg[0] = __builtin_amdgcn_logf(e[0]); lg[1] = __builtin_amdgcn_logf(e[1]);
            f32x2 mxz; mxz[0] = fmaxf(z[0], 0.f); mxz[1] = fmaxf(z[1], 0.f);
            const f32x2 spv = mxz + lg, zz = z - spv; sp[i] = spv[0]; sp[i + 1] = spv[1];
            if (i < 16) { p0[i] = zz[0]; p0[i + 1] = zz[1]; } else { p1[i - 16] = zz[0]; p1[i - 15] = zz[1]; } }
    } else {
#pragma unroll
        for (int i = 0; i < 32; ++i) { const float z = i < 16 ? p0[i] : p1[i - 16];
            const float e = __builtin_amdgcn_exp2f(-fabsf(z)), spv = fmaxf(z, 0.f) + __builtin_amdgcn_logf(1.0f + e);
            const bool valid = KOFF(i) < thr; sp[i] = valid ? spv : 0.f; const float zz = valid ? (z - spv) : -1e30f;
            if (i < 16) p0[i] = zz; else p1[i - 16] = zz; }
    }
#pragma unroll
    for (int u = 0; u < 8; ++u) T[u] = (sp[4 * u] + sp[4 * u + 1]) + (sp[4 * u + 2] + sp[4 * u + 3]);
    float after = A;
#pragma unroll
    for (int u = 7; u >= 0; --u) { const float pt = swap_sum(T[u]); const float hb = after + (hi ? 0.f : (pt - T[u]));
        const float s3 = hb, s2 = hb + sp[4 * u + 3], s1 = s2 + sp[4 * u + 2], s0 = s1 + sp[4 * u + 1];
        const int i0 = 4 * u;
        f32x2 a = {i0 < 16 ? p0[i0] : p1[i0 - 16], i0 < 16 ? p0[i0 + 1] : p1[i0 - 15]}, b = {i0 < 16 ? p0[i0 + 2] : p1[i0 - 14], i0 < 16 ? p0[i0 + 3] : p1[i0 - 13]};
        const f32x2 sa = {s0, s1}, sb = {s2, s3}; a = a - sa; b = b - sb;
        const float w0 = __builtin_amdgcn_exp2f(a[0]), w1 = __builtin_amdgcn_exp2f(a[1]), w2 = __builtin_amdgcn_exp2f(b[0]), w3 = __builtin_amdgcn_exp2f(b[1]);
        if (i0 < 16) { p0[i0] = w0; p0[i0 + 1] = w1; p0[i0 + 2] = w2; p0[i0 + 3] = w3; } else { p1[i0 - 16] = w0; p1[i0 - 15] = w1; p1[i0 - 14] = w2; p1[i0 - 13] = w3; }
        after += pt; }
    A = after;
}
__device__ __forceinline__ void p11_sb_mfma(Frame& F) {
    const bf16* Qg = (const bf16*)(F.ws + WS_QKV); const bf16* Kg = Qg + (size_t)33554432; const bf16* Vg = Qg + (size_t)67108864;
    bf16* O = (bf16*)(F.ws + WS_O);
    LAS unsigned char* L = F.lds; volatile LAS unsigned* flag = (volatile LAS unsigned*)(F.lds + 32768);
    const int lane = F.lane, r32 = lane & 31, hi = lane >> 5, w = F.wave;
    for (int unit = F.vcu; unit < 2048; unit += F.G) {
        const int bh = unit >> 5, qb = unit & 31, b = bh >> 4, h = bh & 15, Q0 = qb * 256, tq = Q0 + 32 * w + r32;
        const bf16* Kh = Kg + (size_t)bh * SEQ * 64; const bf16* Vh = Vg + (size_t)bh * SEQ * 64;
        bf16x8 qr[4];
#pragma unroll
        for (int d0 = 0; d0 < 4; ++d0) qr[d0] = *(const bf16x8*)(Qg + ((size_t)bh * SEQ + tq) * 64 + 16 * d0 + 8 * hi);
        f32x16 o[2];
#pragma unroll
        for (int r = 0; r < 16; ++r) { o[0][r] = 0.f; o[1][r] = 0.f; }
        float A = 0.f; const int kt_top = (Q0 >> 6) + 3, my_top = (Q0 >> 6) + (w >> 1);
        bool done = false;
        if (F.tid == 0) { flag[0] = 0u; flag[1] = 0u; flag[2] = 0u; }
        { v4u kr, vr; kv_issue(Kh + (size_t)kt_top * 4096, Vh + (size_t)kt_top * 4096, w, lane, kr, vr); kv_commit(L, L + 16384, w, lane, kr, vr); }
        __syncthreads();
        for (int i = 0, kt = kt_top; kt >= 0; ++i, --kt) {
            const int cb = i & 1; v4u kr, vr;
            if (kt > 0) kv_issue(Kh + (size_t)(kt - 1) * 4096, Vh + (size_t)(kt - 1) * 4096, w, lane, kr, vr);
            if (!done && kt <= my_top) {
                f32x16 p0, p1; qk_tile(L + cb * 8192, qr, r32, hi, p0, p1);
                sb_process(p0, p1, tq - 64 * kt - 4 * hi, hi, A);
                pv_tile(L + 16384 + cb * 8192, p0, p1, o, lane, hi);
                if (SB_EXIT && __all(A > 174.f)) done = true;
            }
            const int fi = i % 3; if (F.tid == 0) flag[(i + 1) % 3] = 0u;
            if (done && lane == 0) __hip_atomic_fetch_or((LAS unsigned*)(F.lds + 32768) + fi, 1u << w, __ATOMIC_RELAXED, __HIP_MEMORY_SCOPE_WORKGROUP);
            if (kt > 0) kv_commit(L + (cb ^ 1) * 8192, L + 16384 + (cb ^ 1) * 8192, w, lane, kr, vr);
            __syncthreads();
            if (flag[fi] == 0xFFu) break;
        }
        store_o(O + (size_t)(b * SEQ + tq) * 1024 + h * 64, o, hi, 1.0f);
        __syncthreads();
    }
}

struct TileMask { int lo, hi_; bool on; };
#define MX3(a, b, c) fmaxf(fmaxf((a), (b)), (c))
__device__ __forceinline__ void sm_process(f32x16& p0, f32x16& p1, float& m, float& l, f32x16 (&o)[2], const TileMask tm) {
    if (!__all(tm.lo < 0 && tm.hi_ >= 63)) {
        const int lo = tm.lo, hi_ = tm.hi_;
#pragma unroll
        for (int i = 0; i < 32; ++i) { const float s = i < 16 ? p0[i] : p1[i - 16]; const float x = (KOFF(i) > lo && KOFF(i) <= hi_) ? s : -INFINITY; if (i < 16) p0[i] = x; else p1[i - 16] = x; }
    }
    float ma = MX3(p0[0], p0[1], p1[0]), mb = MX3(p0[2], p0[3], p1[1]); ma = MX3(ma, p1[2], p1[3]);
#pragma unroll
    for (int r = 4; r < 16; r += 4) { ma = MX3(ma, p0[r], p0[r + 1]); mb = MX3(mb, p0[r + 2], p0[r + 3]); ma = MX3(ma, p1[r], p1[r + 1]); mb = MX3(mb, p1[r + 2], p1[r + 3]); }
    const float mx = swap_max(fmaxf(fmaxf(ma, mb), -1e30f));
    const float mnew = fmaxf(m, mx), alpha = __builtin_amdgcn_exp2f(m - mnew);
    const f32x2 nm = {-mnew, -mnew}; f32x2 ls2 = {0.f, 0.f};
#pragma unroll
    for (int i = 0; i < 16; i += 2) {
        f32x2 a = {p0[i], p0[i + 1]}, b = {p1[i], p1[i + 1]}; a = a + nm; b = b + nm;
        a[0] = __builtin_amdgcn_exp2f(a[0]); a[1] = __builtin_amdgcn_exp2f(a[1]); b[0] = __builtin_amdgcn_exp2f(b[0]); b[1] = __builtin_amdgcn_exp2f(b[1]);
        p0[i] = a[0]; p0[i + 1] = a[1]; p1[i] = b[0]; p1[i + 1] = b[1]; ls2 = ls2 + a; ls2 = ls2 + b; }
    l = l * alpha + (ls2[0] + ls2[1]); m = mnew;
    if (!__all(alpha == 1.0f)) { const f32x2 al = {alpha, alpha};
#pragma unroll
        for (int r = 0; r < 16; r += 2) { f32x2 a = {o[0][r], o[0][r + 1]}, b = {o[1][r], o[1][r + 1]}; a = a * al; b = b * al; o[0][r] = a[0]; o[0][r + 1] = a[1]; o[1][r] = b[0]; o[1][r + 1] = b[1]; } }
}
template <class Act, class Mask>
__device__ __forceinline__ void sm_stream(Frame& F, const bf16* Kh, const bf16* Vh, int t0, int t1, const bf16x8 (&qr)[4], float& m, float& l, f32x16 (&o)[2], Act act, Mask mask) {
    if (t0 >= t1) return;
    LAS unsigned char* L = F.lds; const int lane = F.lane, r32 = lane & 31, hi = lane >> 5, w = F.wave;
    { v4u kr, vr; kv_issue(Kh + (size_t)t0 * 4096, Vh + (size_t)t0 * 4096, w, lane, kr, vr); kv_commit(L, L + 16384, w, lane, kr, vr); }
    __syncthreads();
    for (int t = t0; t < t1; ++t) {
        const int cb = (t - t0) & 1; v4u kr, vr;
        if (t + 1 < t1) kv_issue(Kh + (size_t)(t + 1) * 4096, Vh + (size_t)(t + 1) * 4096, w, lane, kr, vr);
        if (act(t)) { f32x16 p0, p1; const TileMask tm = mask(t);
            if (__all(tm.on)) qk_tile(L + cb * 8192, qr, r32, hi, p0, p1); else qk_tile(L + cb * 8192, qr, r32, hi, p0, p1, tm.on ? 0.f : -INFINITY);
            __builtin_amdgcn_sched_barrier(0);
            sm_process(p0, p1, m, l, o, tm);
            __builtin_amdgcn_sched_barrier(0);
            pv_tile(L + 16384 + cb * 8192, p0, p1, o, lane, hi); }
        if (t + 1 < t1) kv_commit(L + (cb ^ 1) * 8192, L + 16384 + (cb ^ 1) * 8192, w, lane, kr, vr);
        __syncthreads();
    }
}

constexpr size_t MB_CNT = 0, MB_SELP = 1 * MiB, MB_SEG = 2 * MiB;
constexpr size_t MB_PARTO = 0, MB_PARTML = 96 * MiB;
__device__ __forceinline__ bool better(float va, int ia, float vb, int ib) { return va > vb || (va == vb && ia < ib); }
__device__ __forceinline__ void top3_insert(float gv, int n, float& v0, int& i0, float& v1, int& i1, float& v2, int& i2) {
    const bool b0 = better(gv, n, v0, i0), b1 = better(gv, n, v1, i1), b2 = better(gv, n, v2, i2);
    const float nv2 = b1 ? v1 : (b2 ? gv : v2), nv1 = b0 ? v0 : (b1 ? gv : v1), nv0 = b0 ? gv : v0;
    const int ni2 = b1 ? i1 : (b2 ? n : i2), ni1 = b0 ? i0 : (b1 ? n : i1), ni0 = b0 ? n : i0;
    v0 = nv0; v1 = nv1; v2 = nv2; i0 = ni0; i1 = ni1; i2 = ni2;
}
__device__ __forceinline__ void moba_gate(Frame& F) {
    const bf16* qkv = (const bf16*)(F.ws + WS_QKV);
    const bf16* KMH = (const bf16*)(F.ws + WS_KMH); const bf16* KML = (const bf16*)(F.ws + WS_KML);
    int* cnt = (int*)(F.ws + WS_ABF + MB_CNT); unsigned* selp = (unsigned*)(F.ws + WS_ABF + MB_SELP); unsigned short* seg = (unsigned short*)(F.ws + WS_ABF + MB_SEG);
    LAS int* wc = (LAS int*)F.lds;
    const int lane = F.lane, r32 = lane & 31, hi = lane >> 5, w = F.wave;
    for (int it = 0; it < 4; ++it) {
        const int u = it * F.G + F.vcu; if (u >= 1024) break;
        const int bh = u >> 5, cur = u & 31, tq = cur * 256 + 32 * w + r32;
        bf16x8 qr[4];
#pragma unroll
        for (int d0 = 0; d0 < 4; ++d0) qr[d0] = *(const bf16x8*)(qkv + pg8::E_QM + ((size_t)bh * SEQ + tq) * 64 + 16 * d0 + 8 * hi);
        f32x16 gt;
#pragma unroll
        for (int r = 0; r < 16; ++r) gt[r] = 0.f;
#pragma unroll
        for (int d0 = 0; d0 < 4; ++d0) { const bf16x8 kh = *(const bf16x8*)(KMH + ((size_t)bh * 32 + r32) * 64 + 16 * d0 + 8 * hi), kl = *(const bf16x8*)(KML + ((size_t)bh * 32 + r32) * 64 + 16 * d0 + 8 * hi);
            gt = MFMA32(kh, qr[d0], gt); gt = MFMA32(kl, qr[d0], gt); }
        float v0 = -INFINITY, v1 = -INFINITY, v2 = -INFINITY; int i0 = 99, i1 = 99, i2 = 99;
#pragma unroll
        for (int r = 0; r < 16; ++r) { const int n = crow(r, hi); const float gv = n < cur ? gt[r] : -INFINITY; top3_insert(gv, n, v0, i0, v1, i1, v2, i2); }
        const float pv0 = swap_other(v0, hi), pv1 = swap_other(v1, hi), pv2 = swap_other(v2, hi);
        const int pi0 = __builtin_bit_cast(int, swap_other(__builtin_bit_cast(float, i0), hi)), pi1 = __builtin_bit_cast(int, swap_other(__builtin_bit_cast(float, i1), hi)), pi2 = __builtin_bit_cast(int, swap_other(__builtin_bit_cast(float, i2), hi));
        top3_insert(pv0, pi0, v0, i0, v1, i1, v2, i2); top3_insert(pv1, pi1, v0, i0, v1, i1, v2, i2); top3_insert(pv2, pi2, v0, i0, v1, i1, v2, i2);
        const int s0 = (i0 < 32 && v0 > -INFINITY) ? i0 : 255, s1 = (i1 < 32 && v1 > -INFINITY) ? i1 : 255, s2 = (i2 < 32 && v2 > -INFINITY) ? i2 : 255;
        if (hi == 0) selp[(size_t)bh * SEQ + tq] = (unsigned)s0 | ((unsigned)s1 << 8) | ((unsigned)s2 << 16);
        for (int j = 0; j < cur; ++j) { const bool sel = (hi == 0) && (s0 == j || s1 == j || s2 == j); const unsigned long long bal = __ballot(sel); if (lane == 0) wc[w * 32 + j] = __popcll(bal); }
        __syncthreads();
        for (int j = 0; j < cur; ++j) { const bool sel = (hi == 0) && (s0 == j || s1 == j || s2 == j); const unsigned long long bal = __ballot(sel);
            int base = 0; for (int ww = 0; ww < w; ++ww) base += wc[ww * 32 + j];
            if (sel) { const int rank = __popcll(bal & ((1ull << r32) - 1ull)), slot = s0 == j ? 0 : (s1 == j ? 1 : 2);
                seg[(((size_t)bh * 32 + cur) * 32 + j) * 256 + base + rank] = (unsigned short)((32 * w + r32) | (slot << 8)); } }
        if (F.tid < 32) { int c = 0; if (F.tid < cur) { for (int ww = 0; ww < 8; ++ww) c += wc[ww * 32 + F.tid]; } cnt[((size_t)bh * 32 + cur) * 32 + F.tid] = c; }
        __syncthreads();
    }
}
constexpr int MB_UST = 100352, MB_TOT = 104704, MB_C32 = 108800;
__device__ __forceinline__ int moba_part_setup(Frame& F) {
    const int* cnt = (const int*)(F.ws + WS_ABF + MB_CNT); LAS int* ust = (LAS int*)(F.lds + MB_UST); LAS int* tot = (LAS int*)(F.lds + MB_TOT);
    __syncthreads();
    for (int p = F.tid; p < 1024; p += 512) { const int bh = p >> 5, j = p & 31; int t = 0; for (int cu = j + 1; cu < 32; ++cu) t += cnt[((size_t)bh * 32 + cu) * 32 + j]; tot[p] = t; }
    __syncthreads();
    LAS int* part = (LAS int*)(F.lds + MB_C32 + 512);
    if (F.tid < 32) { int a = 0; for (int q = 0; q < 32; ++q) a += (tot[F.tid * 32 + q] + 255) >> 8; part[F.tid] = a; }
    __syncthreads();
    if (F.tid == 0) { int a = 0; for (int q = 0; q < 32; ++q) { const int n = part[q]; part[q] = a; a += n; } ust[1024] = a; }
    __syncthreads();
    if (F.tid < 32) { int a = part[F.tid]; for (int q = 0; q < 32; ++q) { ust[F.tid * 32 + q] = a; a += (tot[F.tid * 32 + q] + 255) >> 8; } }
    __syncthreads();
    return ust[1024];
}
__device__ __forceinline__ int moba_part_unit(Frame& F, float* dout, const int u, const int staged) {
    const bf16* qkv = (const bf16*)(F.ws + WS_QKV);
    const int* cnt = (const int*)(F.ws + WS_ABF + MB_CNT); const unsigned short* seg = (const unsigned short*)(F.ws + WS_ABF + MB_SEG);
    bf16* parto = (bf16*)((unsigned char*)dout + MB_PARTO); float* partml = (float*)((unsigned char*)dout + MB_PARTML);
    LAS int* ust = (LAS int*)(F.lds + MB_UST); LAS int* tot = (LAS int*)(F.lds + MB_TOT); LAS int* c32 = (LAS int*)(F.lds + MB_C32);
    LAS unsigned char* L = F.lds;
    const int lane = F.lane, r32 = lane & 31, hi = lane >> 5, w = F.wave;
    int lo = 0, hb = 1024;
    while (hb - lo > 1) { const int mid = (lo + hb) >> 1; if (ust[mid] <= u) lo = mid; else hb = mid; }
    const int p = lo, bh = p >> 5, j = p & 31, k = u - ust[p], total = tot[p];
    if (p != staged) {
        __syncthreads();
        const bf16* Kh = qkv + pg8::E_KM + (size_t)bh * SEQ * 64 + (size_t)j * 16384; const bf16* Vh = qkv + pg8::E_VM + (size_t)bh * SEQ * 64 + (size_t)j * 16384;
        v4u kr[4], vr[4];
#pragma unroll
        for (int t = 0; t < 4; ++t) kv_issue(Kh + (size_t)t * 4096, Vh + (size_t)t * 4096, w, lane, kr[t], vr[t]);
        if (F.tid < 32) c32[F.tid] = F.tid > j ? cnt[((size_t)bh * 32 + F.tid) * 32 + j] : 0;
#pragma unroll
        for (int t = 0; t < 4; ++t) kv_commit(L + t * 8192, L + 32768 + t * 8192, w, lane, kr[t], vr[t]);
        __syncthreads();
    }
    const int ci = 256 * k + 32 * w + r32; const bool valid = ci < total;
    int cu = j + 1, acc = 0;
    if (valid) { for (int c2 = j + 1; c2 < 32; ++c2) { const int n = c32[c2]; if (ci >= acc + n) { acc += n; cu = c2 + 1; } else break; } }
    int ql = 0, slot = 0;
    if (valid) { const unsigned e = seg[(((size_t)bh * 32 + cu) * 32 + j) * 256 + (ci - acc)]; ql = e & 255; slot = e >> 8; } else cu = j + 1;
    const int tq = valid ? cu * 256 + ql : (j + 1) * 256;
    if (__ballot(valid) != 0ull) {
        bf16x8 qr[4];
#pragma unroll
        for (int d0 = 0; d0 < 4; ++d0) qr[d0] = *(const bf16x8*)(qkv + pg8::E_QM + ((size_t)bh * SEQ + tq) * 64 + 16 * d0 + 8 * hi);
        float m = -1e30f, l = 0.f; f32x16 o[2];
#pragma unroll
        for (int r = 0; r < 16; ++r) { o[0][r] = 0.f; o[1][r] = 0.f; }
        TileMask tm; tm.lo = -1; tm.hi_ = 63; tm.on = valid;
        const float cinit = valid ? 0.f : -INFINITY; const bool allv = __all(valid);
        for (int t = 0; t < 4; ++t) { f32x16 p0, p1; if (allv) qk_tile(L + t * 8192, qr, r32, hi, p0, p1); else qk_tile(L + t * 8192, qr, r32, hi, p0, p1, cinit);
            __builtin_amdgcn_sched_barrier(0);
            sm_process(p0, p1, m, l, o, tm);
            __builtin_amdgcn_sched_barrier(0);
            pv_tile(L + 32768 + t * 8192, p0, p1, o, lane, hi); }
        const float lt = swap_sum(l);
        if (valid) { const size_t pi = ((size_t)bh * SEQ + tq) * 3 + slot;
            store_o(parto + pi * 64, o, hi, 1.0f / lt);
            if (hi == 0) { partml[pi * 2] = m; partml[pi * 2 + 1] = lt; } }
    }
    return p;
}
__device__ __forceinline__ void moba_merge(Frame& F, const float* dout) {
    const bf16* qkv = (const bf16*)(F.ws + WS_QKV);
    const unsigned* selp = (const unsigned*)(F.ws + WS_ABF + MB_SELP);
    const bf16* parto = (const bf16*)((const unsigned char*)dout + MB_PARTO); const float* partml = (const float*)((const unsigned char*)dout + MB_PARTML);
    bf16* O = (bf16*)(F.ws + WS_O);
    const int lane = F.lane, r32 = lane & 31, hi = lane >> 5, w = F.wave;
    for (int it = 0; it < 4; ++it) {
        const int u = it * F.G + F.vcu; if (u >= 1024) break;
        const int bh = u >> 5, cur = u & 31, b = bh >> 3, h = bh & 7, tq = cur * 256 + 32 * w + r32;
        bf16x8 qr[4];
#pragma unroll
        for (int d0 = 0; d0 < 4; ++d0) qr[d0] = *(const bf16x8*)(qkv + pg8::E_QM + ((size_t)bh * SEQ + tq) * 64 + 16 * d0 + 8 * hi);
        float m = -1e30f, l = 0.f; f32x16 o[2];
#pragma unroll
        for (int r = 0; r < 16; ++r) { o[0][r] = 0.f; o[1][r] = 0.f; }
        const int wmax = cur * 256 + 32 * w + 31;
        sm_stream(F, qkv + pg8::E_KM + (size_t)bh * SEQ * 64, qkv + pg8::E_VM + (size_t)bh * SEQ * 64, 4 * cur, 4 * cur + 4, qr, m, l, o,
            [=](int t) { return 64 * t <= wmax; }, [=](int t) { TileMask tm; tm.lo = -1; tm.hi_ = tq - 64 * t - 4 * hi; tm.on = true; return tm; });
        float L = swap_sum(l);
        const unsigned sp = selp[(size_t)bh * SEQ + tq];
        float ms[3], ls[3]; float M = m;
#pragma unroll
        for (int s = 0; s < 3; ++s) { const bool on = ((sp >> (8 * s)) & 255u) != 255u; const size_t pi = ((size_t)bh * SEQ + tq) * 3 + s;
            ms[s] = on ? partml[pi * 2] : -1e30f; ls[s] = on ? partml[pi * 2 + 1] : 0.f; M = fmaxf(M, ms[s]); }
        const float wo = __builtin_amdgcn_exp2f(m - M); L *= wo;
#pragma unroll
        for (int r = 0; r < 16; ++r) { o[0][r] *= wo; o[1][r] *= wo; }
#pragma unroll
        for (int s = 0; s < 3; ++s) { const float ws_ = ls[s] * __builtin_amdgcn_exp2f(ms[s] - M); L += ws_;
            if (ls[s] > 0.f) { const bf16* po = parto + (((size_t)bh * SEQ + tq) * 3 + s) * 64;
#pragma unroll
                for (int dh = 0; dh < 2; ++dh)
#pragma unroll
                    for (int g = 0; g < 4; ++g) { const v2u pk = *(const v2u*)(po + 32 * dh + 8 * g + 4 * hi);
                        o[dh][4 * g] = fmaf(ws_, bflo(pk.x), o[dh][4 * g]); o[dh][4 * g + 1] = fmaf(ws_, bfhi(pk.x), o[dh][4 * g + 1]);
                        o[dh][4 * g + 2] = fmaf(ws_, bflo(pk.y), o[dh][4 * g + 2]); o[dh][4 * g + 3] = fmaf(ws_, bfhi(pk.y), o[dh][4 * g + 3]); } } }
        store_o(O + (size_t)(b * SEQ + tq) * 1024 + 512 + h * 64, o, hi, 1.0f / fmaxf(L, 1e-30f));
    }
}
constexpr int NSA_IMPG = 32768, NSA_IMPL = NSA_IMPG + 64 * 129 * 4, NSA_SEL = NSA_IMPL + 64 * 129 * 4;
__device__ __forceinline__ void nsa_unit(Frame& F, const int bkv, const int c) {
    const bf16* qkv = (const bf16*)(F.ws + WS_QKV);
    const float* gates = (const float*)(F.ws + WS_GATES);
    const bf16* KC = (const bf16*)(F.ws + WS_KC); const bf16* VC = (const bf16*)(F.ws + WS_VC);
    bf16* O = (bf16*)(F.ws + WS_O);
    LAS float* impG = (LAS float*)(F.lds + NSA_IMPG); LAS float* impL = (LAS float*)(F.lds + NSA_IMPL); LAS unsigned short* sel16 = (LAS unsigned short*)(F.lds + NSA_SEL);
    const int lane = F.lane, r32 = lane & 31, hi = lane >> 5, w = F.wave, ql = 8 * w + (r32 >> 2), g = r32 & 3;
    {
        const int b = bkv >> 1, kv = bkv & 1, h = kv * 4 + g, tq = 64 * c + ql, tok = b * SEQ + tq;
        bf16x8 qr[4];
#pragma unroll
        for (int d0 = 0; d0 < 4; ++d0) qr[d0] = *(const bf16x8*)(qkv + pg8::E_QA + ((size_t)(b * 8 + h) * SEQ + tq) * 64 + 16 * d0 + 8 * hi);
        const float g0 = gates[(size_t)tok * 24 + h * 3 + 0], g1 = gates[(size_t)tok * 24 + h * 3 + 1], g2 = gates[(size_t)tok * 24 + h * 3 + 2];
        f32x16 o[2]; LAS float* otl = (LAS float*)(F.lds + NSA_IMPG) + F.tid;
        for (int i = F.tid; i < 2 * 64 * 129; i += 512) impG[i] = 0.f;
        const int nvis = tq >= 31 ? min((tq - 31) / 16 + 1, 511) : 0, ntc = (4 * c + 66) >> 6;
        const bf16* kcp = KC + (size_t)bkv * 512 * 64; const bf16* vcp = VC + (size_t)bkv * 512 * 64;
        float m = -1e30f, l = 0.f;
#pragma unroll
        for (int r = 0; r < 16; ++r) { o[0][r] = 0.f; o[1][r] = 0.f; }
        sm_stream(F, kcp, vcp, 0, ntc, qr, m, l, o, [=](int t) { return true; }, [=](int t) { TileMask tm; tm.lo = -1; tm.hi_ = nvis - 1 - 64 * t - 4 * hi; tm.on = true; return tm; });
        float linv = 1.0f / fmaxf(swap_sum(l), 1e-30f);
#pragma unroll
        for (int r = 0; r < 16; ++r) { o[0][r] *= g0 * linv; o[1][r] *= g0 * linv; }
        if (c >= 16) {
            LAS unsigned char* L = F.lds;
            for (int t = 0; t < ntc; ++t) {
                { v4u kr, vr; kv_issue(kcp + (size_t)t * 4096, vcp + (size_t)t * 4096, w, lane, kr, vr); kv_commit(L, L + 16384, w, lane, kr, vr); }
                __syncthreads();
                f32x16 p0, p1; qk_tile(L, qr, r32, hi, p0, p1);
#pragma unroll
                for (int uu = 0; uu < 8; ++uu) { float pe[4];
#pragma unroll
                    for (int e = 0; e < 4; ++e) { const int i = 4 * uu + e; const float s = i < 16 ? p0[i] : p1[i - 16]; const int n = 64 * t + 32 * (i >> 4) + crow(i & 15, hi);
                        pe[e] = n < nvis ? __builtin_amdgcn_exp2f(s - m) * linv : 0.f; }
                    float G = (pe[0] + pe[1]) + (pe[2] + pe[3]), Lst = pe[3];
                    G += __shfl_xor(G, 1); G += __shfl_xor(G, 2); Lst += __shfl_xor(Lst, 1); Lst += __shfl_xor(Lst, 2);
                    const int j = 16 * t + 2 * uu + hi;
                    if (g == 0 && j < 128) { impG[ql * 129 + j] = G; impL[ql * 129 + j + 1] = Lst; } }
                __syncthreads();
            }
        }
        __syncthreads();
        { const int qs = F.tid >> 3, k8 = F.tid & 7; unsigned bits = 0u;
          if (c < 16) { if (k8 == 0) bits = (1u << (c + 1)) - 1u; }
          else { float v[16];
#pragma unroll
              for (int e = 0; e < 16; ++e) { const int j = 16 * k8 + e; v[e] = (j >= 1 && j <= c - 2) ? impG[qs * 129 + j] + impL[qs * 129 + j] : -1.0f;
                  if (j == 0 || j == c - 1 || j == c) bits |= 1u << e; }
              for (int rnd = 0; rnd < 13; ++rnd) { float bv = -1.0f; int bj = 999;
#pragma unroll
                  for (int e = 0; e < 16; ++e) { if (v[e] > bv) { bv = v[e]; bj = 16 * k8 + e; } }
#pragma unroll
                  for (int sh = 1; sh < 8; sh <<= 1) { const float ov = __shfl_xor(bv, sh); const int oj = __shfl_xor(bj, sh); if (better(ov, oj, bv, bj)) { bv = ov; bj = oj; } }
#pragma unroll
                  for (int e = 0; e < 16; ++e) { if (bj == 16 * k8 + e) { v[e] = -1.0f; bits |= 1u << e; } } } }
          sel16[qs * 8 + k8] = (unsigned short)bits; }
        __syncthreads();
#pragma unroll
        for (int r = 0; r < 16; ++r) { otl[r * 512] = o[0][r]; otl[(16 + r) * 512] = o[1][r]; }
        m = -1e30f; l = 0.f;
#pragma unroll
        for (int r = 0; r < 16; ++r) { o[0][r] = 0.f; o[1][r] = 0.f; }
        { const LAS unsigned short* myrow = sel16 + ql * 8;
          sm_stream(F, qkv + pg8::E_KSLC + (size_t)bkv * SEQ * 64, qkv + pg8::E_VSLC + (size_t)bkv * SEQ * 64, 0, c + 1, qr, m, l, o,
              [=](int t) { return __ballot((myrow[t >> 4] >> (t & 15)) & 1) != 0ull; },
              [=](int t) { TileMask tm; tm.lo = -1; tm.hi_ = tq - 64 * t - 4 * hi; tm.on = ((myrow[t >> 4] >> (t & 15)) & 1) != 0; return tm; }); }
        linv = 1.0f / fmaxf(swap_sum(l), 1e-30f);
#pragma unroll
        for (int r = 0; r < 16; ++r) { otl[r * 512] = fmaf(g1 * linv, o[0][r], otl[r * 512]); otl[(16 + r) * 512] = fmaf(g1 * linv, o[1][r], otl[(16 + r) * 512]); }
        m = -1e30f; l = 0.f;
#pragma unroll
        for (int r = 0; r < 16; ++r) { o[0][r] = 0.f; o[1][r] = 0.f; }
        sm_stream(F, qkv + pg8::E_KWIN + (size_t)bkv * SEQ * 64, qkv + pg8::E_VWIN + (size_t)bkv * SEQ * 64, max(c - 8, 0), c + 1, qr, m, l, o,
            [=](int t) { return true; }, [=](int t) { TileMask tm; tm.hi_ = tq - 64 * t - 4 * hi; tm.lo = tm.hi_ - 512; tm.on = true; return tm; });
        linv = 1.0f / fmaxf(swap_sum(l), 1e-30f);
#pragma unroll
        for (int r = 0; r < 16; ++r) { o[0][r] = fmaf(g2 * linv, o[0][r], otl[r * 512]); o[1][r] = fmaf(g2 * linv, o[1][r], otl[(16 + r) * 512]); }
        store_o(O + (size_t)tok * 1024 + h * 64, o, hi, 1.0f);
        __syncthreads();
    }
}

__global__ void __launch_bounds__(NWAVES * 64, 2) fwd_kernel(Args args) {
    extern __shared__ __attribute__((aligned(16))) unsigned char lds[];
    Frame F;
    F.lds = (LAS unsigned char*)lds; F.ws = args.ws;
    F.tid = threadIdx.x; F.lane = F.tid & 63; F.wave = __builtin_amdgcn_readfirstlane(F.tid >> 6);
    F.G = gridDim.x; { const int bx = blockIdx.x; F.vcu = (F.G % 8 == 0) ? (bx % 8) * (F.G / 8) + bx / 8 : bx; }
    for (int u = F.tid; u < (LDS_BYTES - LDSCTL_OFF) / 4; u += NWAVES * 64) ((LAS unsigned*)(F.lds + LDSCTL_OFF))[u] = 0u;
    __syncthreads();
    volatile LAS unsigned* MISC = (volatile LAS unsigned*)(F.lds + MISC_OFF);
    unsigned* ctl = (unsigned*)(args.ws + WS_CTL);
    XcdBarrier bar; bar.bar = ctl + CW_BAR + args.pad * XCD_BAR_WORDS; bar.x = 0; bar.st = nullptr;
    if (args.use_bar) bar = xcd_barrier_post(ctl + CW_BAR + args.pad * XCD_BAR_WORDS, MISC + 8);
    const int lo = args.ph_lo, hi = args.ph_hi;
#ifdef ONLYPH
#define IN(k) ((k) == ONLYPH && lo <= (k) && (k) < hi)
#else
#define IN(k) (lo <= (k) && (k) < hi)
#endif
#ifdef PROBE_REP
#define NREP(k) ((k) == PROBE_REP ? 2 : 1)
#else
#define NREP(k) 1
#endif
#ifdef PROBE_BAR
#define SEAM(k) do { if (IN(k) && IN((k) + 1)) { xcd_barrier(bar); xcd_barrier(bar); } } while (0)
#else
#define SEAM(k) do { if (IN(k) && IN((k) + 1)) xcd_barrier(bar); } while (0)
#endif
    float* R = args.out;
    bf16* RB = (bf16*)(args.ws + WS_ABF);
    bf16* ABF = (bf16*)(args.ws + WS_ABF); bf16* OB = (bf16*)(args.ws + WS_O); bf16* QKV = (bf16*)(args.ws + WS_QKV);
    bf16* XS = (bf16*)(args.ws + WS_XS); bf16* HB = (bf16*)(args.ws + WS_H);

    if (IN(0)) { for (int rep = 0; rep < NREP(0); ++rep) p0_prologue(F, args); } SEAM(0);
    if (IN(1)) { pg8::Gemm g{ABF, (const bf16*)(args.ws + WS_WIN0), NTOK, 3072, DM}; pg8::StaticOrder S; S.init(NTOK, 3072, F.G, (int)blockIdx.x);
        pg8::EpiProj0 E{QKV, (float*)(args.ws + WS_GATES), (const float*)(args.ws + WS_COS), (const float*)(args.ws + WS_SIN)};
        pg8::gemm_phase<pg8::EpiProj0, pg8::StaticOrder, true, true>(F.lds, g, S, E); } SEAM(1);
    if (IN(2)) { for (int rep = 0; rep < NREP(2); ++rep) p2_compress(F, args); } SEAM(2);
    if (IN(3)) { moba_gate(F); xcd_barrier(bar);
        { const int nmb = moba_part_setup(F), q2 = 1024 + ((nmb + 7) >> 3);
          volatile LAS int* qslot = (volatile LAS int*)(F.lds + MB_C32 + 256);
          for (;;) { __syncthreads();
              if (F.tid == 0) *qslot = (int)__hip_atomic_fetch_add(ctl + CW_Q, 1u, RLX_AGENT);
              __syncthreads();
              const int qi = *qslot; if (qi >= q2) break;
              if (qi < 1024) nsa_unit(F, qi & 7, 127 - (qi >> 3));
              else { const int u0 = (qi - 1024) * 8; int staged = -1; for (int u = u0; u < u0 + 8 && u < nmb; ++u) staged = moba_part_unit(F, R, u, staged); } } }
        xcd_barrier(bar);
        moba_merge(F, R);
    } SEAM(3);
    if (IN(4)) { pg8::Gemm g{OB, (const bf16*)(args.ws + WS_WOUT0), NTOK, DM, DM}; pg8::StaticOrder S; S.init(NTOK, DM, F.G, (int)blockIdx.x);
        pg8::EpiResX E{args.in[0], RB, ALPHA};
        pg8::gemm_phase<pg8::EpiResX, pg8::StaticOrder, true, true>(F.lds, g, S, E); } SEAM(4);
    if (IN(5)) { ln_phase<true, false>(F, args, 0, args.in[12], args.in[13], RB, nullptr); } SEAM(5);
    if (IN(6)) { for (int rep = 0; rep < NREP(6); ++rep) scatter_phase(F); } SEAM(6);
    if (IN(7)) { const int np = load_ptab(F); pg8::Gemm g{ABF, nullptr, MAXROWS, 1024, DM};
        MoeOrder1 S{F.G, (int)blockIdx.x, np * 4, (const LAS int*)(F.lds + PTAB_OFF), (const bf16*)(args.ws + WS_W1E), (const int*)(args.ws + WS_ROWMAP)};
        pg8::EpiMoe1 E{HB, (const float*)(args.ws + WS_WROW)};
        pg8::gemm_phase<pg8::EpiMoe1, MoeOrder1, true, true>(F.lds, g, S, E); } SEAM(7);
    if (IN(8)) { const int np = load_ptab(F); pg8::Gemm g{HB, nullptr, MAXROWS, 1024, 512};
        MoeOrder2 S{F.G, (int)blockIdx.x, np * 4, (const LAS int*)(F.lds + PTAB_OFF), (const bf16*)(args.ws + WS_B2)};
        pg8::EpiMoe2 E{RB, (const int*)(args.ws + WS_ROWMAP), ALPHA};
        pg8::gemm_phase<pg8::EpiMoe2, MoeOrder2, true, true>(F.lds, g, S, E); } SEAM(8);
    if (IN(9)) { ln_phase<false, false>(F, args, 0, args.in[14], args.in[15], RB, nullptr); } SEAM(9);
    if (IN(10)) { pg8::Gemm g{ABF, (const bf16*)(args.ws + WS_WIN1), NTOK, 3072, DM}; pg8::StaticOrder S; S.init(NTOK, 3072, F.G, (int)blockIdx.x);
        pg8::EpiProj1 E{QKV};
        pg8::gemm_phase<pg8::EpiProj1, pg8::StaticOrder, true, true>(F.lds, g, S, E); } SEAM(10);
    if (IN(11)) { for (int rep = 0; rep < NREP(11); ++rep) p11_sb_mfma(F); } SEAM(11);
    if (IN(12)) { pg8::Gemm g{OB, (const bf16*)(args.ws + WS_WOUT1), NTOK, DM, DM}; pg8::StaticOrder S; S.init(NTOK, DM, F.G, (int)blockIdx.x);
        pg8::EpiResB E{RB, ALPHA};
        pg8::gemm_phase<pg8::EpiResB, pg8::StaticOrder, true, true>(F.lds, g, S, E); } SEAM(12);
    if (IN(13)) { ln_phase<true, false>(F, args, 1, args.in[12] + DM, args.in[13] + DM, RB, nullptr); } SEAM(13);
    if (IN(14)) { scatter_phase(F); } SEAM(14);
    if (IN(15)) { const int np = load_ptab(F); pg8::Gemm g{ABF, nullptr, MAXROWS, 1024, DM};
        MoeOrder1 S{F.G, (int)blockIdx.x, np * 4, (const LAS int*)(F.lds + PTAB_OFF), (const bf16*)(args.ws + WS_W1E) + (size_t)16 * 512 * 1024, (const int*)(args.ws + WS_ROWMAP)};
        pg8::EpiMoe1 E{HB, (const float*)(args.ws + WS_WROW)};
        pg8::gemm_phase<pg8::EpiMoe1, MoeOrder1, true, true>(F.lds, g, S, E); } SEAM(15);
    if (IN(16)) { const int np = load_ptab(F); pg8::Gemm g{HB, nullptr, MAXROWS, 1024, 512};
        MoeOrder2 S{F.G, (int)blockIdx.x, np * 4, (const LAS int*)(F.lds + PTAB_OFF), (const bf16*)(args.ws + WS_B2) + (size_t)24 * 1024 * 512};
        pg8::EpiMoe2 E{RB, (const int*)(args.ws + WS_ROWMAP), ALPHA};
        pg8::gemm_phase<pg8::EpiMoe2, MoeOrder2, true, true>(F.lds, g, S, E); } SEAM(16);
    if (IN(17)) { ln_phase<false, true>(F, args, 1, args.in[14] + DM, args.in[15] + DM, RB, R); }
#undef IN
#undef SEAM
}


#ifdef PROBE_ATTN
__device__ __forceinline__ void mkframe(Frame& F, const Args& args, unsigned char* lds) { F.lds = (LAS unsigned char*)lds; F.ws = args.ws; F.tid = threadIdx.x; F.lane = F.tid & 63; F.wave = __builtin_amdgcn_readfirstlane(F.tid >> 6);
    F.G = gridDim.x; const int bx = blockIdx.x; F.vcu = (F.G % 8 == 0) ? (bx % 8) * (F.G / 8) + bx / 8 : bx; }
__global__ void __launch_bounds__(NWAVES * 64, 2) probe_naive(Args args) { extern __shared__ __attribute__((aligned(16))) unsigned char lds[]; Frame F; mkframe(F, args, lds);
    p3_nsa_naive(F, args, (bf16*)args.out); p3_moba_naive(F, args, (bf16*)args.out); }
__global__ void __launch_bounds__(NWAVES * 64, 2) probe_cmp(Args args) { extern __shared__ __attribute__((aligned(16))) unsigned char lds[]; Frame F; mkframe(F, args, lds);
    const bf16* o1 = (const bf16*)(args.ws + WS_O); const bf16* o2 = (const bf16*)args.out; float num = 0.f, den = 0.f;
    for (size_t i = (size_t)(F.vcu * 512 + F.tid); i < (size_t)NTOK * 1024; i += (size_t)F.G * 512) { if ((int)((i & 1023) >> 9) != PROBE_ATTN - 1) continue; const float a = bf2f(o1[i]), b = bf2f(o2[i]); num += (a - b) * (a - b); den += b * b; }
    num = wave_sum(num); den = wave_sum(den);
    if (F.lane == 0) { atomicAdd((float*)(args.ws + WS_CTL) + 32768, num); atomicAdd((float*)(args.ws + WS_CTL) + 32769, den); } }
__global__ void __launch_bounds__(NWAVES * 64, 2) probe_scale(Args args) { const float num = ((const float*)(args.ws + WS_CTL))[32768], den = ((const float*)(args.ws + WS_CTL))[32769], sc = 1.0f + 10.0f * sqrtf(num / fmaxf(den, 1e-30f));
    for (size_t i = (size_t)blockIdx.x * 512 + threadIdx.x; i < (size_t)NTOK * DM / 4; i += (size_t)gridDim.x * 512) { f32x4 v = ((const f32x4*)args.out)[i]; v = v * sc; ((f32x4*)args.out)[i] = v; } }
#endif
extern "C" void kernel_launch(void* const* d_in, const int* in_sizes, int n_in, void* d_out, int out_size, void* d_ws, size_t ws_size, hipStream_t stream) {
    static int grid = 0;
    if (grid == 0) {
        if (n_in != 23 || in_sizes[0] != NTOK * DM || out_size != NTOK * DM || ws_size < WS_END) { fprintf(stderr, "kernel_launch: unexpected shapes (n_in %d, in0 %d, out %d, ws %zu); nothing launched\n", n_in, n_in > 0 ? in_sizes[0] : -1, out_size, ws_size); grid = -1; return; }
        int dev = 0, cus = 0, per_cu = 0;
        if (hipGetDevice(&dev) != hipSuccess || hipDeviceGetAttribute(&cus, hipDeviceAttributeMultiprocessorCount, dev) != hipSuccess) { grid = -1; return; }
        if (hipFuncSetAttribute((const void*)fwd_kernel, hipFuncAttributeMaxDynamicSharedMemorySize, LDS_BYTES) != hipSuccess) { fprintf(stderr, "kernel_launch: hipFuncSetAttribute failed\n"); grid = -1; return; }
        if (hipOccupancyMaxActiveBlocksPerMultiprocessor(&per_cu, (const void*)fwd_kernel, NWAVES * 64, LDS_BYTES) != hipSuccess || per_cu < 1) { fprintf(stderr, "kernel_launch: occupancy query reports %d workgroups per CU\n", per_cu); }
        (void)hipGetLastError();
        grid = cus;
    }
    if (grid < 0) return;
    if (hipMemsetAsync((char*)d_ws + WS_CTL, 0, CTL_ZERO_BYTES, stream) != hipSuccess) return;
    Args a{};
    for (int i = 0; i < 23; ++i) a.in[i] = (const float*)d_in[i];
    a.out = (float*)d_out; a.ws = (unsigned char*)d_ws; a.pad = 0;
#if defined(PROBE_ATTN)
    hipFuncSetAttribute((const void*)probe_naive, hipFuncAttributeMaxDynamicSharedMemorySize, LDS_BYTES);
    a.ph_lo = 0; a.ph_hi = 4; a.use_bar = 1; a.pad = 0; hipLaunchKernelGGL(fwd_kernel, dim3(grid), dim3(NWAVES * 64), LDS_BYTES, stream, a);
    hipLaunchKernelGGL(probe_naive, dim3(grid), dim3(NWAVES * 64), LDS_BYTES, stream, a);
    hipLaunchKernelGGL(probe_cmp, dim3(grid), dim3(NWAVES * 64), 0, stream, a);
    a.ph_lo = 4; a.ph_hi = NPH; a.use_bar = 1; a.pad = 1; hipLaunchKernelGGL(fwd_kernel, dim3(grid), dim3(NWAVES * 64), LDS_BYTES, stream, a);
    hipLaunchKernelGGL(probe_scale, dim3(grid), dim3(NWAVES * 64), 0, stream, a);
#elif MK_N_LAUNCHES == 1
    a.ph_lo = 0; a.ph_hi = NPH; a.use_bar = 1;
    hipLaunchKernelGGL(fwd_kernel, dim3(grid), dim3(NWAVES * 64), LDS_BYTES, stream, a);
#else
    for (int p = 0; p < NPH; ++p) { a.ph_lo = p; a.ph_hi = p + 1; a.use_bar = 0;
        hipLaunchKernelGGL(fwd_kernel, dim3(grid), dim3(NWAVES * 64), LDS_BYTES, stream, a); }
#endif
}
```

```cpp
#include <hip/hip_runtime.h>
#include <cstdio>
#include <cstdint>
#include <cmath>

#ifndef MK_N_LAUNCHES
#define MK_N_LAUNCHES 1
#endif

#ifndef PG8_KALIGN
#define PG8_KALIGN ".p2align 6"
#endif
namespace pg8 {
#define PG8_LAS __attribute__((address_space(3)))
typedef unsigned short bf16_t;
typedef short bf16x8 __attribute__((ext_vector_type(8)));
typedef float f32x4 __attribute__((ext_vector_type(4)));
typedef unsigned u32x4 __attribute__((ext_vector_type(4)));
constexpr int BM = 256, BK = 64, HALF = 128, HTB = HALF * BK * 2  , STAGE_BYTES = 8 * HTB, NXCD = 8, WGM = 8;

__host__ __device__ __forceinline__ int lds_byte(int r, int c) { const int st = (r >> 4) * 2 + (c >> 5), rr = r & 15, cc = c & 31, ob = rr * 64 + cc * 2; return st * 1024 + (ob ^ (((ob >> 9) & 1) << 5)); }
__host__ __device__ __forceinline__ void stage_rc(int b, int& R, int& C) { const int st = b / 1024, sb = b % 1024, swz = sb ^ (((sb >> 9) & 1) << 5); R = (st >> 1) * 16 + swz / 64; C = (st & 1) * 32 + (swz % 64) / 2; }
__host__ __device__ __forceinline__ int perm32(int rho) { const int n = rho >> 4, i = rho & 15; return 8 * (i >> 2) + 4 * n + (i & 3); }

struct Unit { int pm, pn, aux; };
struct Gemm { const bf16_t* A; const bf16_t* Bt; int M, N, K; };

struct StaticOrder {
    static constexpr bool GATHER = false;
    int nM, nN, nwg, G, c;
    __host__ __device__ void init(int M, int N, int G_, int c_) { nM = M / BM; nN = N / BM; nwg = nM * nN; G = G_; c = c_; }
    __host__ __device__ bool next(int i, Unit& u) const {
        const long L = (long)i * G + c; if (L >= nwg) return false;
        int wgid = (int)L; { const int q = nwg / NXCD, r = nwg % NXCD, xcd = wgid % NXCD, off = wgid / NXCD; wgid = (xcd < r ? xcd * (q + 1) : r * (q + 1) + (xcd - r) * q) + off; }
        const int nig = WGM * nN, gid = wgid / nig, fm = gid * WGM, gsz = (nM - fm) < WGM ? (nM - fm) : WGM;
        u.pm = fm + ((wgid % nig) % gsz); u.pn = (wgid % nig) / gsz; u.aux = 0; return true;
    }
    __device__ __forceinline__ const char* aptr(const Gemm& g, const Unit& u, size_t tstep) const { return (const char*)g.A + (size_t)u.pm * tstep; }
    __device__ __forceinline__ const char* bptr(const Gemm& g, const Unit& u, size_t tstep) const { return (const char*)g.Bt + (size_t)u.pn * tstep; }
    __device__ __forceinline__ int arow(const Unit&, int) const { return 0; }
    __device__ __forceinline__ void a_ready(const Unit&) const {}
    __device__ __forceinline__ void done(const Unit&) const {}
};

__device__ __forceinline__ unsigned cvt_pk_bf16(float lo, float hi) { unsigned r; asm volatile("v_cvt_pk_bf16_f32 %0, %1, %2" : "=v"(r) : "v"(lo), "v"(hi)); return r; }
typedef unsigned u32x2 __attribute__((ext_vector_type(2)));
constexpr int SEQ_ = 8192;
constexpr float QLOG2 = 0.125f * 1.4426950408889634f;
constexpr size_t E_QA = 0, E_KCMP = 16777216, E_KSLC = 20971520, E_KWIN = 25165824, E_VCMP = 29360128, E_VSLC = 33554432, E_VWIN = 37748736,
                 E_QM = 41943040, E_KM = 58720256, E_VM = 75497472;

struct EpiProj0 {
    static constexpr bool PERM = true, AFTER_DRAIN = false;
    bf16_t* qkv; float* gates; const float* cosT; const float* sinT;
    __device__ __forceinline__ void operator()(const f32x4 (&acc)[2][2][4][2], const Unit& u, int wr, int wc, int fr, int fq) const {
        const int row0 = u.pm * BM + wr * 64 + fr;
        const int p0 = 32 * (wc & 1) + 8 * fq;
        const int hs0 = u.pn * 4 + (wc >> 1), hs1 = hs0 + 2;
        const bool rope0 = (hs0 < 14) || (hs0 >= 20 && hs0 < 36), rope1 = (hs1 < 14) || (hs1 >= 20 && hs1 < 36);
#pragma unroll
        for (int ai = 0; ai < 2; ++ai)
#pragma unroll
            for (int m = 0; m < 4; ++m) {
                const int r = row0 + ai * HALF + m * 16, b = r >> 13, s = r & (SEQ_ - 1);
                f32x4 c4 = {1.f, 1.f, 1.f, 1.f}, s4 = {0.f, 0.f, 0.f, 0.f};
                if (rope0 || rope1) { c4 = *(const f32x4*)(cosT + (size_t)r * 32 + (p0 >> 1)); s4 = *(const f32x4*)(sinT + (size_t)r * 32 + (p0 >> 1)); }
#pragma unroll
                for (int bj = 0; bj < 2; ++bj) {
                    const int hs = bj ? hs1 : hs0; const bool rope = bj ? rope1 : rope0;
                    f32x4 v0 = acc[ai][bj][m][0], v1 = acc[ai][bj][m][1];
                    if (hs < 44) {
                        const bool isq = hs < 8 || (hs >= 20 && hs < 28);
                        size_t base; int nh, hh;
                        if (hs < 8) { base = E_QA; nh = 8; hh = hs; }
                        else if (hs < 20) { base = E_KCMP + (size_t)((hs - 8) >> 1) * 4194304; nh = 2; hh = (hs - 8) & 1; }
                        else { base = E_QM + (size_t)((hs - 20) >> 3) * 16777216; nh = 8; hh = (hs - 20) & 7; }
                        if (rope) {
                            const f32x4 w0 = v0, w1 = v1;
                            v0[0] = w0[0] * c4[0] - w0[1] * s4[0]; v0[1] = w0[1] * c4[0] + w0[0] * s4[0];
                            v0[2] = w0[2] * c4[1] - w0[3] * s4[1]; v0[3] = w0[3] * c4[1] + w0[2] * s4[1];
                            v1[0] = w1[0] * c4[2] - w1[1] * s4[2]; v1[1] = w1[1] * c4[2] + w1[0] * s4[2];
                            v1[2] = w1[2] * c4[3] - w1[3] * s4[3]; v1[3] = w1[3] * c4[3] + w1[2] * s4[3];
                        }
                        if (isq) { v0 = v0 * QLOG2; v1 = v1 * QLOG2; }
                        u32x4 w; w.x = cvt_pk_bf16(v0[0], v0[1]); w.y = cvt_pk_bf16(v0[2], v0[3]); w.z = cvt_pk_bf16(v1[0], v1[1]); w.w = cvt_pk_bf16(v1[2], v1[3]);
                        *(u32x4*)(qkv + base + ((size_t)(b * nh + hh) * SEQ_ + s) * 64 + p0) = w;
                    } else if (hs == 44 && (wc & 1) == 0 && fq < 3) {
#pragma unroll
                        for (int e = 0; e < 4; ++e) { v0[e] = 1.0f / (1.0f + __expf(-v0[e])); v1[e] = 1.0f / (1.0f + __expf(-v1[e])); }
                        *(f32x4*)(gates + (size_t)r * 24 + p0) = v0; *(f32x4*)(gates + (size_t)r * 24 + p0 + 4) = v1;
                    }
                }
            }
    }
};
struct EpiProj1 {
    static constexpr bool PERM = true, AFTER_DRAIN = false;
    bf16_t* qkv;
    __device__ __forceinline__ void operator()(const f32x4 (&acc)[2][2][4][2], const Unit& u, int wr, int wc, int fr, int fq) const {
        const int row0 = u.pm * BM + wr * 64 + fr;
#pragma unroll
        for (int bj = 0; bj < 2; ++bj) {
            const int hs = u.pn * 4 + bj * 2 + (wc >> 1), p0 = 32 * (wc & 1) + 8 * fq, hh = hs & 15;
            const size_t base = (size_t)(hs >> 4) * 33554432;
#pragma unroll
            for (int ai = 0; ai < 2; ++ai)
#pragma unroll
                for (int m = 0; m < 4; ++m) {
                    const int r = row0 + ai * HALF + m * 16, b = r >> 13, s = r & (SEQ_ - 1);
                    f32x4 v0 = acc[ai][bj][m][0], v1 = acc[ai][bj][m][1];
                    if (hs < 16) { v0 = v0 * QLOG2; v1 = v1 * QLOG2; }
                    u32x4 w; w.x = cvt_pk_bf16(v0[0], v0[1]); w.y = cvt_pk_bf16(v0[2], v0[3]); w.z = cvt_pk_bf16(v1[0], v1[1]); w.w = cvt_pk_bf16(v1[2], v1[3]);
                    *(u32x4*)(qkv + base + ((size_t)(b * 16 + hh) * SEQ_ + s) * 64 + p0) = w;
                }
        }
    }
};
__device__ __forceinline__ float bf_lo(unsigned u) { return __builtin_bit_cast(float, u << 16); }
__device__ __forceinline__ float bf_hi(unsigned u) { return __builtin_bit_cast(float, u & 0xffff0000u); }
struct EpiResX {
    static constexpr bool PERM = false, AFTER_DRAIN = false;
    const float* resid; bf16_t* out; float alpha;
    __device__ __forceinline__ void operator()(const f32x4 (&acc)[2][2][4][2], const Unit& u, int wr, int wc, int fr, int fq) const {
        const int row0 = u.pm * BM + wr * 64 + fr, col0 = u.pn * BM + wc * 32 + 4 * fq;
#pragma unroll
        for (int ai = 0; ai < 2; ++ai)
#pragma unroll
            for (int m = 0; m < 4; ++m) { const size_t off = (size_t)(row0 + ai * HALF + m * 16) * 1024 + col0;
#pragma unroll
                for (int bj = 0; bj < 2; ++bj)
#pragma unroll
                    for (int n = 0; n < 2; ++n) { const f32x4 bs = *(const f32x4*)(resid + off + bj * HALF + n * 16); const f32x4 v = bs * alpha + acc[ai][bj][m][n];
                        u32x2 w; w.x = cvt_pk_bf16(v[0], v[1]); w.y = cvt_pk_bf16(v[2], v[3]); *(u32x2*)(out + off + bj * HALF + n * 16) = w; } }
    }
};
struct EpiResB {
    static constexpr bool PERM = false, AFTER_DRAIN = false;
    bf16_t* RB; float alpha;
    __device__ __forceinline__ void operator()(const f32x4 (&acc)[2][2][4][2], const Unit& u, int wr, int wc, int fr, int fq) const {
        const int row0 = u.pm * BM + wr * 64 + fr, col0 = u.pn * BM + wc * 32 + 4 * fq;
#pragma unroll
        for (int ai = 0; ai < 2; ++ai)
#pragma unroll
            for (int m = 0; m < 4; ++m) { const size_t off = (size_t)(row0 + ai * HALF + m * 16) * 1024 + col0;
#pragma unroll
                for (int bj = 0; bj < 2; ++bj)
#pragma unroll
                    for (int n = 0; n < 2; ++n) { const u32x2 b = *(const u32x2*)(RB + off + bj * HALF + n * 16); const f32x4 a = acc[ai][bj][m][n];
                        u32x2 w; w.x = cvt_pk_bf16(bf_lo(b.x) * alpha + a[0], bf_hi(b.x) * alpha + a[1]); w.y = cvt_pk_bf16(bf_lo(b.y) * alpha + a[2], bf_hi(b.y) * alpha + a[3]); *(u32x2*)(RB + off + bj * HALF + n * 16) = w; } }
    }
};
struct EpiMoe1 {
    static constexpr bool PERM = true, AFTER_DRAIN = false;
    bf16_t* H; const float* wrow;
    __device__ __forceinline__ void operator()(const f32x4 (&acc)[2][2][4][2], const Unit& u, int wr, int wc, int fr, int fq) const {
        const int row0 = u.pm * BM + wr * 64 + fr, slot = u.pn >> 1;
#pragma unroll
        for (int ai = 0; ai < 2; ++ai)
#pragma unroll
            for (int m = 0; m < 4; ++m) { const int prow = row0 + ai * HALF + m * 16; const float w = wrow[(size_t)prow * 2 + slot];
#pragma unroll
                for (int bj = 0; bj < 2; ++bj) { const f32x4 g = acc[ai][bj][m][0], up = acc[ai][bj][m][1]; float hv[4];
#pragma unroll
                    for (int e = 0; e < 4; ++e) hv[e] = g[e] / (1.0f + __expf(-g[e])) * up[e] * w;
                    u32x2 o; o.x = cvt_pk_bf16(hv[0], hv[1]); o.y = cvt_pk_bf16(hv[2], hv[3]);
                    *(u32x2*)(H + (size_t)prow * 512 + u.pn * 128 + bj * 64 + wc * 16 + 4 * fq) = o; } }
    }
};
struct EpiMoe2 {
    static constexpr bool PERM = false, AFTER_DRAIN = false;
    bf16_t* RB; const int* rowmap; float alpha;
    __device__ __forceinline__ void operator()(const f32x4 (&acc)[2][2][4][2], const Unit& u, int wr, int wc, int fr, int fq) const {
        const int row0 = u.pm * BM + wr * 64 + fr, col0 = u.pn * BM + wc * 32 + 4 * fq;
#pragma unroll
        for (int ai = 0; ai < 2; ++ai)
#pragma unroll
            for (int m = 0; m < 4; ++m) { const int tok = rowmap[row0 + ai * HALF + m * 16];
                if (tok >= 0) { const size_t off = (size_t)tok * 1024 + col0;
#pragma unroll
                    for (int bj = 0; bj < 2; ++bj)
#pragma unroll
                        for (int n = 0; n < 2; ++n) { const u32x2 b = *(const u32x2*)(RB + off + bj * HALF + n * 16); const f32x4 a = acc[ai][bj][m][n];
                            u32x2 w; w.x = cvt_pk_bf16(bf_lo(b.x) * alpha + a[0], bf_hi(b.x) * alpha + a[1]); w.y = cvt_pk_bf16(bf_lo(b.y) * alpha + a[2], bf_hi(b.y) * alpha + a[3]); *(u32x2*)(RB + off + bj * HALF + n * 16) = w; } } }
    }
};

template <class Epi, class Sched, bool ALIGN_EPI = false, bool SP2 = false>
__device__ __forceinline__ void gemm_phase(PG8_LAS unsigned char* lds, const Gemm g, const Sched& S, const Epi& E) {
    const int tid = threadIdx.x, wid = __builtin_amdgcn_readfirstlane(tid >> 6), lane = tid & 63, wr = wid >> 2, wc = wid & 3, fr = lane & 15, fq = lane >> 4;
    const int K = g.K, nt = K / BK;
    unsigned voffA[2], voffB[2]; int Rv[2], Cv[2];
#pragma unroll
    for (int i = 0; i < 2; ++i) { int R, C; stage_rc(tid * 16 + i * 8192, R, C); const int Rb = Epi::PERM ? ((R & ~31) + perm32(R & 31)) : R; Rv[i] = R; Cv[i] = C;
        voffA[i] = (unsigned)(R * K + C) * 2u; voffB[i] = (unsigned)(Rb * K + C) * 2u; }
    constexpr bool GATHER = Sched::GATHER; static_assert(!GATHER || SP2, "gather is wired into the SP2 loop only");
    unsigned gA[2][2], gN[2][2];
#define PG8_SETG(G_, U_) do { _Pragma("unroll") for (int _h = 0; _h < 2; ++_h) _Pragma("unroll") for (int _i = 0; _i < 2; ++_i) G_[_h][_i] = GATHER ? (unsigned)S.arow(U_, _h * HALF + Rv[_i]) * (unsigned)(K * 2) + (unsigned)(Cv[_i] * 2) : voffA[_i]; } while (0)
#define PG8_SELG(dst, h_, nx_) unsigned dst[2] = { (nx_) ? gN[h_][0] : gA[h_][0], (nx_) ? gN[h_][1] : gA[h_][1] }
    const size_t kstep = (size_t)(BK * 2);
    const size_t hstep = (size_t)HALF * K * 2;
    const size_t hstepA = GATHER ? (size_t)0 : hstep;
    const size_t tstep = 2 * hstep;
    const unsigned ldsw = (unsigned)wid * 1024u;
    const int aoff = lds_byte(wr * 64 + fr, fq * 8), boff = lds_byte(wc * 32 + fr, fq * 8);
#define PG8_SA(b, h) (((b) * 2 + (h)) * HTB)
#define PG8_SB(b, h) ((4 + (b) * 2 + (h)) * HTB)
#define PG8_STAGE(bufoff, gbase, voff) do { _Pragma("unroll") for (int _i = 0; _i < 2; ++_i) \
        __builtin_amdgcn_global_load_lds((const unsigned*)((const char*)(gbase) + (voff)[_i]), (PG8_LAS unsigned*)(lds + (bufoff) + ldsw + _i * 8192), 16, 0, 0); } while (0)
#define PG8_LDA(dst, b, h) do { _Pragma("unroll") for (int m = 0; m < 4; ++m) _Pragma("unroll") for (int k = 0; k < 2; ++k) dst[m][k] = *(const PG8_LAS bf16x8*)(lds + PG8_SA(b, h) + aoff + m * 2048 + k * 1024); } while (0)
#define PG8_LDB(dst, b, h) do { _Pragma("unroll") for (int n = 0; n < 2; ++n) _Pragma("unroll") for (int k = 0; k < 2; ++k) dst[n][k] = *(const PG8_LAS bf16x8*)(lds + PG8_SB(b, h) + boff + n * 2048 + k * 1024); } while (0)
#define PG8_MMA(ai, bj, At, Bt) do { __builtin_amdgcn_s_setprio(1); _Pragma("unroll") for (int m = 0; m < 4; ++m) _Pragma("unroll") for (int n = 0; n < 2; ++n) _Pragma("unroll") for (int k = 0; k < 2; ++k) \
        acc[ai][bj][m][n] = __builtin_amdgcn_mfma_f32_16x16x32_bf16(Bt[n][k], At[m][k], acc[ai][bj][m][n], 0, 0, 0); __builtin_amdgcn_s_setprio(0); } while (0)
#define PG8_WAIT_V(n) asm volatile("s_waitcnt vmcnt(" #n ")" ::: "memory")
#define PG8_WAIT_L(n) asm volatile("s_waitcnt lgkmcnt(" #n ")" ::: "memory")
#define PG8_BAR __builtin_amdgcn_s_barrier()
#define PG8_SCHED __builtin_amdgcn_sched_barrier(0)
    Unit cur, nxt; int ui = 0;
    if (!S.next(0, cur)) return;
    f32x4 acc[2][2][4][2];
#pragma unroll
    for (int a = 0; a < 2; ++a)
#pragma unroll
        for (int b = 0; b < 2; ++b)
#pragma unroll
            for (int m = 0; m < 4; ++m)
#pragma unroll
                for (int n = 0; n < 2; ++n) acc[a][b][m][n] = (f32x4){0.f, 0.f, 0.f, 0.f};
    bf16x8 At[4][2], B0[2][2], B1[2][2];
    const char* cA = GATHER ? (const char*)g.A : S.aptr(g, cur, tstep); const char* cB = S.bptr(g, cur, tstep);
    S.a_ready(cur);
    PG8_SETG(gA, cur);
    if constexpr (SP2) {
        PG8_STAGE(PG8_SB(0, 0), cB, voffB); PG8_STAGE(PG8_SB(0, 1), cB + hstep, voffB); PG8_STAGE(PG8_SA(0, 0), cA, gA[0]); PG8_STAGE(PG8_SA(0, 1), cA + hstepA, gA[1]);
        if (wr == 1) PG8_BAR;
        PG8_WAIT_V(2); PG8_BAR;
        PG8_STAGE(PG8_SB(1, 0), cB + kstep, voffB); PG8_STAGE(PG8_SA(1, 0), cA + kstep, gA[0]); PG8_STAGE(PG8_SB(1, 1), cB + hstep + kstep, voffB);
        PG8_WAIT_V(6); PG8_BAR;
    } else {
        PG8_STAGE(PG8_SB(0, 0), cB, voffB); PG8_STAGE(PG8_SA(0, 0), cA, voffA); PG8_STAGE(PG8_SB(0, 1), cB + hstep, voffB); PG8_STAGE(PG8_SA(0, 1), cA + hstep, voffA);
        if (wr == 1) PG8_BAR;
        PG8_WAIT_V(4); PG8_BAR;
        PG8_STAGE(PG8_SB(1, 0), cB + kstep, voffB); PG8_STAGE(PG8_SA(1, 0), cA + kstep, voffA); PG8_STAGE(PG8_SB(1, 1), cB + hstep + kstep, voffB);
        PG8_WAIT_V(6); PG8_BAR;
    }
    for (;;) {
        const bool has_next = S.next(ui + 1, nxt);
        const char* nA = (has_next && !GATHER) ? S.aptr(g, nxt, tstep) : cA; const char* nB = has_next ? S.bptr(g, nxt, tstep) : cB;
        if (has_next) PG8_SETG(gN, nxt); else { _Pragma("unroll") for (int _h = 0; _h < 2; ++_h) _Pragma("unroll") for (int _i = 0; _i < 2; ++_i) gN[_h][_i] = gA[_h][_i]; }
        asm volatile(PG8_KALIGN ::: "memory");
        for (int t = 0; t < nt; t += 2) {
            const bool last = (t == nt - 2);
            const char* a1 = cA + (size_t)(t + 1) * kstep;
            const char* a2 = last ? nA : cA + (size_t)(t + 2) * kstep; const char* b2 = last ? nB : cB + (size_t)(t + 2) * kstep;
            const char* a3 = a2 + kstep; const char* b3 = b2 + kstep;
            if (last && has_next) S.a_ready(nxt);
            if constexpr (SP2) {
            PG8_LDB(B0, 0, 0); PG8_LDB(B1, 0, 1); PG8_SCHED; PG8_LDA(At, 0, 0); PG8_STAGE(PG8_SA(1, 1), a1 + hstepA, gA[1]);
            PG8_WAIT_V(8); PG8_WAIT_L(0); PG8_BAR; PG8_MMA(0, 0, At, B0); PG8_MMA(0, 1, At, B1); PG8_BAR; PG8_SCHED;
            PG8_LDA(At, 0, 1); PG8_STAGE(PG8_SB(0, 0), b2, voffB); PG8_STAGE(PG8_SB(0, 1), b2 + hstep, voffB); { PG8_SELG(gs_, 0, last); PG8_STAGE(PG8_SA(0, 0), a2, gs_); }
            PG8_WAIT_V(8); PG8_WAIT_L(0); PG8_BAR; PG8_MMA(1, 0, At, B0); PG8_MMA(1, 1, At, B1); PG8_BAR; PG8_SCHED;
            PG8_LDB(B0, 1, 0); PG8_LDB(B1, 1, 1); PG8_SCHED; PG8_LDA(At, 1, 0); { PG8_SELG(gs_, 1, last); PG8_STAGE(PG8_SA(0, 1), a2 + hstepA, gs_); }
            PG8_WAIT_V(8); PG8_WAIT_L(0); PG8_BAR; PG8_MMA(0, 0, At, B0); PG8_MMA(0, 1, At, B1); PG8_BAR; PG8_SCHED;
            PG8_LDA(At, 1, 1); PG8_STAGE(PG8_SB(1, 0), b3, voffB); PG8_STAGE(PG8_SB(1, 1), b3 + hstep, voffB); { PG8_SELG(gs_, 0, last); PG8_STAGE(PG8_SA(1, 0), a3, gs_); }
            PG8_WAIT_V(8); PG8_WAIT_L(0); PG8_BAR; PG8_MMA(1, 0, At, B0); PG8_MMA(1, 1, At, B1); PG8_BAR; PG8_SCHED;
            } else {
            PG8_LDB(B0, 0, 0); PG8_SCHED; PG8_LDA(At, 0, 0); PG8_STAGE(PG8_SA(1, 1), a1 + hstep, voffA);
            PG8_WAIT_L(8); PG8_BAR; PG8_WAIT_L(0); PG8_MMA(0, 0, At, B0); PG8_BAR; PG8_SCHED;
            PG8_LDB(B1, 0, 1); PG8_STAGE(PG8_SB(0, 0), b2, voffB);
            PG8_BAR; PG8_WAIT_L(0); PG8_MMA(0, 1, At, B1); PG8_BAR;
            PG8_LDA(At, 0, 1); PG8_STAGE(PG8_SA(0, 0), a2, voffA);
            PG8_BAR; PG8_WAIT_L(0); PG8_MMA(1, 0, At, B0); PG8_BAR; PG8_SCHED;
            PG8_STAGE(PG8_SB(0, 1), b2 + hstep, voffB);
            PG8_WAIT_V(6); PG8_BAR; PG8_MMA(1, 1, At, B1); PG8_BAR;
            PG8_LDB(B0, 1, 0); PG8_SCHED; PG8_LDA(At, 1, 0); PG8_STAGE(PG8_SA(0, 1), a2 + hstep, voffA);
            PG8_WAIT_L(8); PG8_BAR; PG8_WAIT_L(0); PG8_MMA(0, 0, At, B0); PG8_BAR; PG8_SCHED;
            PG8_LDB(B1, 1, 1); PG8_STAGE(PG8_SB(1, 0), b3, voffB);
            PG8_BAR; PG8_WAIT_L(0); PG8_MMA(0, 1, At, B1); PG8_BAR;
            PG8_LDA(At, 1, 1); PG8_STAGE(PG8_SA(1, 0), a3, voffA);
            PG8_BAR; PG8_WAIT_L(0); PG8_MMA(1, 0, At, B0); PG8_BAR; PG8_SCHED;
            PG8_STAGE(PG8_SB(1, 1), b3 + hstep, voffB);
            PG8_WAIT_V(6); PG8_BAR; PG8_MMA(1, 1, At, B1); PG8_BAR;
            }
        }
        if constexpr (ALIGN_EPI) { if (wr == 0) PG8_BAR; }
        if constexpr (!Epi::AFTER_DRAIN) { E(acc, cur, wr, wc, fr, fq); S.done(cur); }
        if (!has_next) break;
#pragma unroll
        for (int a = 0; a < 2; ++a)
#pragma unroll
            for (int b = 0; b < 2; ++b)
#pragma unroll
                for (int m = 0; m < 4; ++m)
#pragma unroll
                    for (int n = 0; n < 2; ++n) acc[a][b][m][n] = (f32x4){0.f, 0.f, 0.f, 0.f};
        cur = nxt; cA = nA; cB = nB; ++ui;
#pragma unroll
        for (int _h = 0; _h < 2; ++_h)
#pragma unroll
            for (int _i = 0; _i < 2; ++_i) gA[_h][_i] = gN[_h][_i];
        if constexpr (ALIGN_EPI) { if (wr == 1) PG8_BAR; }
    }
    PG8_WAIT_V(0);
    if constexpr (!ALIGN_EPI) { if (wr == 0) PG8_BAR; }
    PG8_BAR;
    if constexpr (Epi::AFTER_DRAIN) { E.fused(acc, cur, wr, wc, fr, fq, lds, wid, lane); S.done(cur); }
#undef PG8_SETG
#undef PG8_SELG
#undef PG8_SA
#undef PG8_SB
#undef PG8_STAGE
#undef PG8_LDA
#undef PG8_LDB
#undef PG8_MMA
#undef PG8_WAIT_V
#undef PG8_WAIT_L
#undef PG8_BAR
#undef PG8_SCHED
}
}

constexpr int NWAVES = 8;
constexpr int BATCH = 4, SEQ = 8192, DM = 1024, NTOK = BATCH * SEQ;
constexpr int NPH = 18;
constexpr float LN_EPS = 1e-5f;
constexpr float ALPHA = 1.4142135623730951f;
constexpr float QSCALE = 0.125f;
constexpr float NAIVE_SC = 0.6931471805599453f;
constexpr int MAXPAN = 152, MAXROWS = MAXPAN * 256;
constexpr size_t MiB = 1u << 20;
constexpr size_t WS_CTL = 0, CTL_ZERO_BYTES = 1 * MiB;
constexpr size_t WS_POSB = 1 * MiB, WS_KC = 1 * MiB + 4096, WS_VC = WS_KC + 524288, WS_KMEAN = WS_VC + 524288;
constexpr size_t WS_KMH = 2 * MiB + 512 * 1024, WS_KML = 2 * MiB + 768 * 1024;
constexpr size_t WS_W1T = 3 * MiB;
constexpr size_t WS_COS = 4 * MiB, WS_SIN = 8 * MiB;
constexpr size_t WS_TOKI = 12 * MiB, WS_ROWMAP = WS_TOKI + 524288, WS_WROW = WS_ROWMAP + 262144;
constexpr size_t WS_HIST = 13 * MiB + 512 * 1024, WS_GTAB = WS_HIST + 32768;
constexpr size_t WS_WIN0 = 14 * MiB, WS_WOUT0 = 20 * MiB, WS_WIN1 = 22 * MiB, WS_WOUT1 = 28 * MiB, WS_W1E = 30 * MiB, WS_B2 = 62 * MiB;
constexpr size_t WS_ABF = 110 * MiB, WS_O = 174 * MiB, WS_QKV = 238 * MiB, WS_END = 430 * MiB;
constexpr size_t WS_GATES = WS_QKV + 176 * MiB;
constexpr size_t WS_XS = WS_QKV, WS_H = WS_QKV + 80 * MiB;
static_assert(WS_WROW + (size_t)MAXROWS * 8 <= WS_WIN0 && WS_KMEAN + 262144 <= WS_COS && (size_t)MAXROWS * 2048 <= 80 * MiB && (size_t)MAXROWS * 1024 <= 96 * MiB, "ws map");
constexpr int CW_BAR = 4096;
constexpr int CW_Q = 20480;
constexpr int CW_CNT = 16384;
constexpr int RING_BYTES = 131072;
constexpr int LDSCTL_OFF = RING_BYTES, MISC_OFF = LDSCTL_OFF + 320;
constexpr int PTAB_OFF = LDSCTL_OFF + 1024;
constexpr int LDS_BYTES = 147456;

#define GAS __attribute__((address_space(1)))
#define LAS __attribute__((address_space(3)))
typedef unsigned short bf16;
typedef unsigned v4u __attribute__((ext_vector_type(4)));
typedef unsigned v2u __attribute__((ext_vector_type(2)));
typedef float f32x4 __attribute__((ext_vector_type(4)));
typedef GAS unsigned gu32;
#define RLX_AGENT __ATOMIC_RELAXED, __HIP_MEMORY_SCOPE_AGENT
#define LDS_WAIT() asm volatile("s_waitcnt lgkmcnt(0)" ::: "memory")
__device__ __forceinline__ unsigned f2bf(float f) { unsigned u = __builtin_bit_cast(unsigned, f); return (u + 0x7fffu + ((u >> 16) & 1u)) >> 16; }
__device__ __forceinline__ unsigned pk2(float lo, float hi) { return f2bf(lo) | (f2bf(hi) << 16); }
__device__ __forceinline__ float bflo(unsigned u) { return __builtin_bit_cast(float, u << 16); }
__device__ __forceinline__ float bfhi(unsigned u) { return __builtin_bit_cast(float, u & 0xffff0000u); }
__device__ __forceinline__ float bf2f(bf16 h) { return __builtin_bit_cast(float, (unsigned)h << 16); }

#define XB_TMO      128
#define XB_XCNT(j)  (256  + 64 * (j))
#define XB_XSUB(j)  (1280 + 64 * (j))
#define XB_XGEN(j)  (2304 + 64 * (j))
#define XB_TOP      3328
#define XB_TOPGEN   3392
#define XCD_BAR_WORDS 3456
#define XB_SPIN_CAP (1u << 24)
__device__ __forceinline__ unsigned xb_ld(unsigned* p)              { return __hip_atomic_load(p, __ATOMIC_RELAXED, __HIP_MEMORY_SCOPE_AGENT); }
__device__ __forceinline__ unsigned xb_add(unsigned* p, unsigned v) { return __hip_atomic_fetch_add(p, v, __ATOMIC_RELAXED, __HIP_MEMORY_SCOPE_AGENT); }
__device__ __forceinline__ unsigned xb_xcc_id() { return (unsigned)__builtin_amdgcn_s_getreg((3 << 11) | 20) & 0xFu; }
#define XB_SPIN(cond, bar) do { unsigned _sp = 0; while (cond) { __builtin_amdgcn_s_sleep(1); \
    if ((++_sp & 255u) == 0u) { if (xb_ld(&(bar)[XB_TMO])) break; if (_sp > XB_SPIN_CAP) { atomicAdd(&(bar)[XB_TMO], 1u); break; } } } } while (0)
struct XcdBarrier { unsigned* bar; unsigned x; volatile LAS unsigned* st; };
__device__ __forceinline__ XcdBarrier xcd_barrier_post(unsigned* bar, volatile LAS unsigned* st) {
    XcdBarrier b; b.bar = bar; b.x = xb_xcc_id(); b.st = st;
    if (threadIdx.x == 0) (void)xb_add(&bar[XB_XCNT(b.x)], 1u);
    return b;
}
__device__ __forceinline__ void xcd_barrier_complete(unsigned* bar, unsigned x, unsigned& nloc, unsigned& nx) {
    const unsigned G = gridDim.x * gridDim.y * gridDim.z;
    unsigned sum, cnt, mine, sp = 0u;
    for (;;) {
        sum = 0u; cnt = 0u; mine = 0u;
#pragma unroll
        for (unsigned j = 0; j < 16; ++j) { const unsigned c = xb_ld(&bar[XB_XCNT(j)]); sum += c; cnt += (c > 0u) ? 1u : 0u; mine = (j == x) ? c : mine; }
        if (sum == G) break;
        __builtin_amdgcn_s_sleep(1);
        if ((++sp & 255u) == 0u) { if (xb_ld(&bar[XB_TMO])) break; if (sp > XB_SPIN_CAP) { atomicAdd(&bar[XB_TMO], 1u); break; } }
    }
    nloc = mine > 0u ? mine : 1u; nx = cnt > 0u ? cnt : 1u;
}
__device__ __forceinline__ void xcd_barrier(const XcdBarrier& b) {
    asm volatile("s_waitcnt vmcnt(0)" ::: "memory");
    __syncthreads();
    if (threadIdx.x == 0) {
        unsigned* bar = b.bar;
        __builtin_amdgcn_s_waitcnt(0);
        unsigned nloc = b.st[0], nx = b.st[1];
        if (nloc == 0u) { xcd_barrier_complete(bar, b.x, nloc, nx); b.st[0] = nloc; b.st[1] = nx; }
        const unsigned old = xb_add(&bar[XB_XSUB(b.x)], 1u);
        const unsigned gen = old / nloc;
        if (old + 1u == (gen + 1u) * nloc) {
            __builtin_amdgcn_fence(__ATOMIC_RELEASE, "agent");
            asm volatile("s_waitcnt vmcnt(0)" ::: "memory");
            const unsigned og = xb_add(&bar[XB_TOP], 1u);
            const unsigned tg = og / nx;
            if (og + 1u == (tg + 1u) * nx) xb_add(&bar[XB_TOPGEN], 1u);
            else XB_SPIN(xb_ld(&bar[XB_TOPGEN]) == tg, bar);
            __builtin_amdgcn_fence(__ATOMIC_ACQUIRE, "agent");
            xb_add(&bar[XB_XGEN(b.x)], 1u);
            asm volatile("s_waitcnt vmcnt(0)" ::: "memory");
        } else {
            XB_SPIN(xb_ld(&bar[XB_XGEN(b.x)]) == gen, bar);
            __builtin_amdgcn_fence(__ATOMIC_ACQUIRE, "agent");
            asm volatile("s_waitcnt vmcnt(0)" ::: "memory");
        }
    }
    __syncthreads();
}

struct Args { const float* in[23]; float* out; unsigned char* ws; int ph_lo, ph_hi, use_bar, pad; };
struct Frame {
    LAS unsigned char* lds;
    unsigned char* ws;
    int tid, lane, wave, vcu, G;
};
__device__ __forceinline__ float wave_sum(float v) {
#pragma unroll
    for (int o = 1; o < 64; o <<= 1) v += __shfl_xor(v, o);
    return v;
}

template <class Map>
__device__ __forceinline__ void tr_item(const float* W, int N, int kb, int nb, bf16* WT, int ldt, int koff, LAS float* scr, int lane, Map map) {
    const int k0 = 64 * kb, n0 = 32 * nb;
#pragma unroll 8
    for (int i = 0; i < 32; ++i) { const int kk = 2 * i + (lane >> 5), n = n0 + (lane & 31); scr[kk * 33 + (lane & 31)] = (n < N) ? W[(size_t)(k0 + kk) * N + n] : 0.f; }
    LDS_WAIT(); asm volatile("" ::: "memory");
    const int c = lane & 7;
#pragma unroll
    for (int j = 0; j < 4; ++j) { const int nl = (lane >> 3) + 8 * j, n = n0 + nl; const LAS float* s = scr + (8 * c) * 33 + nl;
        if (n < N) { const int row = map(n);
            if (row >= 0) { v4u o; o.x = pk2(s[0 * 33], s[1 * 33]); o.y = pk2(s[2 * 33], s[3 * 33]); o.z = pk2(s[4 * 33], s[5 * 33]); o.w = pk2(s[6 * 33], s[7 * 33]);
                *(v4u*)(WT + (size_t)row * ldt + koff + k0 + 8 * c) = o; } } }
    LDS_WAIT(); asm volatile("" ::: "memory");
}
__device__ __forceinline__ int rope_perm(int d) { return d < 32 ? 2 * d : 2 * (d - 32) + 1; }
struct MapIdent { __device__ __forceinline__ int operator()(int n) const { return n; } };
struct MapGU { int up; __device__ __forceinline__ int operator()(int n) const { return (n >> 2) * 8 + up * 4 + (n & 3); } };
struct MapIn0 {
    __device__ __forceinline__ int operator()(int n) const {
        int hs, d; bool rope;
        if (n < 512) { hs = n >> 6; d = n & 63; rope = true; }
        else if (n < 1280) { const int seg = (n - 512) >> 7, w = (n - 512) & 127;
            rope = (seg & 1) == 0; hs = (rope ? 8 : 14) + (seg >> 1) * 2 + (w >> 6); d = w & 63; }
        else if (n < 1304) { return 44 * 64 + (n - 1280); }
        else { const int m = n - 1304, t = m >> 9; hs = 20 + t * 8 + ((m & 511) >> 6); d = m & 63; rope = t < 2; }
        return hs * 64 + (rope ? rope_perm(d) : d);
    }
};
__device__ __forceinline__ void bucket_pair(int pi, int& lo, int& hi) { lo = pi < 3 ? 0 : (pi < 5 ? 1 : 2); hi = pi < 3 ? pi + 1 : (pi < 5 ? pi - 1 : 3); }

__device__ __forceinline__ void p0_prologue(Frame& F, const Args& A) {
    LAS float* scr = (LAS float*)(F.lds + F.wave * 16384);
    const int gw = F.vcu * NWAVES + F.wave, NGW = F.G * NWAVES;
    bf16* WIN0 = (bf16*)(F.ws + WS_WIN0); bf16* WOUT0 = (bf16*)(F.ws + WS_WOUT0); bf16* WIN1 = (bf16*)(F.ws + WS_WIN1); bf16* WOUT1 = (bf16*)(F.ws + WS_WOUT1);
    bf16* W1E = (bf16*)(F.ws + WS_W1E); bf16* B2 = (bf16*)(F.ws + WS_B2);
    constexpr int I_A = 16 * 89, I_B = 16 * 32, I_C = 16 * 96, I_D = 16 * 32, I_E = 64 * 128, I_F = 96 * 128;
    constexpr int NITEMS = I_A + I_B + I_C + I_D + I_E + I_F;
    for (int it = gw; it < NITEMS; it += NGW) {
        int r = it;
        if (r < I_A) { tr_item(A.in[2], 2840, r / 89, r % 89, WIN0, 1024, 0, scr, F.lane, MapIn0()); continue; } r -= I_A;
        if (r < I_B) { tr_item(A.in[3], 1024, r / 32, r % 32, WOUT0, 1024, 0, scr, F.lane, MapIdent()); continue; } r -= I_B;
        if (r < I_C) { tr_item(A.in[10], 3072, r / 96, r % 96, WIN1, 1024, 0, scr, F.lane, MapIdent()); continue; } r -= I_C;
        if (r < I_D) { tr_item(A.in[11], 1024, r / 32, r % 32, WOUT1, 1024, 0, scr, F.lane, MapIdent()); continue; } r -= I_D;
        if (r < I_E) { const int job = r >> 7, sub = r & 127, le = job >> 1, up = job & 1;
            const float* src = (up ? A.in[21] : A.in[20]) + (size_t)le * 1024 * 256; MapGU mp; mp.up = up;
            tr_item(src, 256, sub >> 3, sub & 7, W1E + (size_t)le * 512 * 1024, 1024, 0, scr, F.lane, mp); continue; } r -= I_E;
        { const int job = r >> 7, sub = r & 127, slot = job & 1, lb = job >> 1, layer = lb / 24, bkt = lb % 24, g = bkt / 6; int lo, hi; bucket_pair(bkt % 6, lo, hi);
            const int e = g * 4 + (slot ? hi : lo);
            tr_item(A.in[22] + (size_t)(layer * 16 + e) * 256 * 1024, 1024, sub >> 5, sub & 31, B2 + (size_t)lb * 1024 * 512, 512, slot * 256, scr, F.lane, MapIdent()); }
    }
    { const float* x = A.in[0]; bf16* xb = (bf16*)(F.ws + WS_ABF);
      for (size_t i = (size_t)(F.vcu * 512 + F.tid); i < (size_t)NTOK * DM / 8; i += (size_t)F.G * 512) {
          const f32x4 a = *(const f32x4*)(x + i * 8), b = *(const f32x4*)(x + i * 8 + 4);
          v4u o; o.x = pk2(a[0], a[1]); o.y = pk2(a[2], a[3]); o.z = pk2(b[0], b[1]); o.w = pk2(b[2], b[3]); *(v4u*)(xb + i * 8) = o; } }
    { const int* pos = (const int*)A.in[1]; float* cosT = (float*)(F.ws + WS_COS); float* sinT = (float*)(F.ws + WS_SIN);
      for (int i = F.vcu * 512 + F.tid; i < NTOK * 32; i += F.G * 512) { const int tok = i >> 5, k = i & 31;
          const float inv = powf(10000.0f, -(float)k / 32.0f), ang = (float)pos[tok] * inv; cosT[i] = cosf(ang); sinT[i] = sinf(ang); } }
    { bf16* W1T = (bf16*)(F.ws + WS_W1T);
      for (int i = F.vcu * 512 + F.tid; i < 2 * 2048 * 128; i += F.G * 512) { const int sel = i >> 18, f = (i >> 7) & 2047, j = i & 127;
          const float v = A.in[sel ? 8 : 6][(size_t)f * 128 + j]; const int fp = sel ? f : ((f & ~63) | rope_perm(f & 63));
          W1T[(size_t)sel * 262144 + (size_t)j * 2048 + fp] = (bf16)f2bf(v); } }
    if (F.vcu < 32) { const int sel = F.vcu >> 4, j = 8 * (F.vcu & 15) + (F.tid & 7), part = F.tid >> 3; const float* pe = A.in[4 + sel]; const float* w1 = A.in[sel ? 8 : 6]; float s = 0.f;
#pragma unroll 8
        for (int i = part * 32; i < part * 32 + 32; ++i) s = fmaf(pe[i], w1[(size_t)i * 128 + j], s);
        __syncthreads();
        LAS float* red = (LAS float*)F.lds; red[F.tid] = s; __syncthreads();
        if (F.tid < 8) { float t = 0.f; for (int k = 0; k < 64; ++k) t += red[k * 8 + F.tid]; ((float*)(F.ws + WS_POSB))[sel * 128 + 8 * (F.vcu & 15) + F.tid] = t; } }
}

__device__ __forceinline__ float gelu_tanh(float x) { const float u = 0.7978845608028654f * (x + 0.044715f * x * x * x); return 0.5f * x * (1.0f + tanhf(u)); }
__device__ __forceinline__ void p2_compress(Frame& F, const Args& A) {
    typedef short bf16x8_ __attribute__((ext_vector_type(8))); typedef float f32x16_ __attribute__((ext_vector_type(16)));
    LAS float* part = (LAS float*)F.lds;
    LAS float* hid = (LAS float*)(F.lds + 32768);
    const bf16* qkv = (const bf16*)(F.ws + WS_QKV); const bf16* W1T = (const bf16*)(F.ws + WS_W1T);
    const float* posb = (const float*)(F.ws + WS_POSB);
    const int lane = F.lane, r32 = lane & 31, hi = lane >> 5, cg = F.wave & 3, kh = F.wave >> 2;
    for (int tile = F.vcu; tile < 256; tile += F.G) {
        const int sel = tile >> 7, bkv = (tile >> 4) & 7, n0 = (tile & 15) * 32;
        const bf16* src = qkv + (sel ? pg8::E_VCMP : pg8::E_KCMP) + (size_t)bkv * SEQ * 64;
        const float* w2 = A.in[sel ? 9 : 7];
        const int nrow = min(n0 + r32, 510);
        const bf16* ap = src + (size_t)nrow * 1024 + kh * 1024 + 8 * hi;
        const bf16* bp = W1T + (size_t)sel * 262144 + (size_t)(32 * cg + r32) * 2048 + kh * 1024 + 8 * hi;
        f32x16_ acc;
#pragma unroll
        for (int r = 0; r < 16; ++r) acc[r] = 0.f;
#pragma unroll 8
        for (int kk = 0; kk < 64; ++kk) { const bf16x8_ a = *(const bf16x8_*)(ap + 16 * kk), bb = *(const bf16x8_*)(bp + 16 * kk);
            acc = __builtin_amdgcn_mfma_f32_32x32x16_bf16(a, bb, acc, 0, 0, 0); }
#pragma unroll
        for (int r = 0; r < 16; ++r) part[kh * 4096 + ((r & 3) + 8 * (r >> 2) + 4 * hi) * 128 + 32 * cg + r32] = acc[r];
        __syncthreads();
        for (int idx = F.tid; idx < 4096; idx += 512) { const float x = part[idx] + part[4096 + idx] + posb[sel * 128 + (idx & 127)]; hid[idx] = gelu_tanh(x); }
        __syncthreads();
        { const int row = F.tid >> 4, c0 = (F.tid & 15) * 4; float y0 = 0.f, y1 = 0.f, y2 = 0.f, y3 = 0.f;
          for (int jj = 0; jj < 128; ++jj) { const float hv = hid[row * 128 + jj]; const f32x4 wv = *(const f32x4*)(w2 + jj * 64 + c0); y0 = fmaf(hv, wv[0], y0); y1 = fmaf(hv, wv[1], y1); y2 = fmaf(hv, wv[2], y2); y3 = fmaf(hv, wv[3], y3); }
          bf16* dst = (bf16*)(F.ws + (sel ? WS_VC : WS_KC)) + ((size_t)bkv * 512 + n0 + row) * 64;
          if (sel) { v2u w; w.x = pk2(y0, y1); w.y = pk2(y2, y3); *(v2u*)(dst + c0) = w; }
          else { dst[rope_perm(c0)] = (bf16)f2bf(y0); dst[rope_perm(c0 + 1)] = (bf16)f2bf(y1); dst[rope_perm(c0 + 2)] = (bf16)f2bf(y2); dst[rope_perm(c0 + 3)] = (bf16)f2bf(y3); } }
        __syncthreads();
    }
    { const bf16* km = qkv + pg8::E_KM; float* kmean = (float*)(F.ws + WS_KMEAN);
      for (int it = F.vcu * NWAVES + F.wave; it < 1024; it += F.G * NWAVES) { const int bh = it >> 5, blk = it & 31; float s = 0.f;
          const bf16* p = km + ((size_t)bh * SEQ + blk * 256) * 64 + F.lane;
          for (int i = 0; i < 256; ++i) s += bf2f(p[(size_t)i * 64]);
          const float mean = s * (1.0f / 256.0f); kmean[(size_t)it * 64 + F.lane] = mean;
          const unsigned hb = f2bf(mean); const float hf = __builtin_bit_cast(float, hb << 16);
          ((bf16*)(F.ws + WS_KMH))[(size_t)it * 64 + F.lane] = (bf16)hb; ((bf16*)(F.ws + WS_KML))[(size_t)it * 64 + F.lane] = (bf16)f2bf(mean - hf); } }
}

__device__ __forceinline__ void ldrow(const bf16* p, unsigned (&r)[32]) {
#pragma unroll
    for (int i = 0; i < 8; ++i) { const v4u t = *(const v4u*)(p + 8 * i); r[4 * i] = t.x; r[4 * i + 1] = t.y; r[4 * i + 2] = t.z; r[4 * i + 3] = t.w; }
}
__device__ __forceinline__ float dot64(const unsigned (&q)[32], const unsigned (&k)[32]) {
    float s0 = 0.f, s1 = 0.f;
#pragma unroll
    for (int i = 0; i < 32; ++i) { s0 = fmaf(bflo(q[i]), bflo(k[i]), s0); s1 = fmaf(bfhi(q[i]), bfhi(k[i]), s1); }
    return s0 + s1;
}
__device__ __forceinline__ void osm_step(bool ok, float s, float& m, float& l, float (&o)[64], const unsigned (&v)[32]) {
    if (ok) {
        if (s > m) { const float f = __expf(m - s); l *= f;
#pragma unroll
            for (int i = 0; i < 64; ++i) o[i] *= f;
            m = s; }
        const float p = __expf(s - m); l += p;
#pragma unroll
        for (int i = 0; i < 32; ++i) { o[2 * i] = fmaf(p, bflo(v[i]), o[2 * i]); o[2 * i + 1] = fmaf(p, bfhi(v[i]), o[2 * i + 1]); }
    }
}

__device__ __forceinline__ void p3_nsa_naive(Frame& F, const Args& A, bf16* O) {
    LAS float* imp = (LAS float*)F.lds;
    const bf16* qkv = (const bf16*)(F.ws + WS_QKV);
    const float* gates = (const float*)(F.ws + WS_GATES);
    const bf16* KC = (const bf16*)(F.ws + WS_KC); const bf16* VC = (const bf16*)(F.ws + WS_VC);
    for (int item = F.vcu; item < 512; item += F.G) {
        const int b = item >> 7, kv = (item >> 6) & 1, qt = item & 63;
        const int ql = F.tid >> 2, g = F.tid & 3, t = qt * 128 + ql, h = kv * 4 + g, tok = b * SEQ + t;
        unsigned q[32]; ldrow(qkv + pg8::E_QA + ((size_t)(b * 8 + h) * SEQ + t) * 64, q);
        float o[64]; float* otp = (float*)(F.ws + WS_ABF) + (size_t)tok * 512 + h * 64;
        for (int i = F.tid; i < 128 * 129; i += 512) imp[i] = 0.f;
        __syncthreads();
        const float g0 = gates[(size_t)tok * 24 + h * 3 + 0], g1 = gates[(size_t)tok * 24 + h * 3 + 1], g2 = gates[(size_t)tok * 24 + h * 3 + 2];
        const int nvis = t >= 31 ? min((t - 31) / 16 + 1, 511) : 0;
        const int nbound = min((qt * 128 + 127 - 31) / 16 + 1, 511);
        const bf16* kcp = KC + (size_t)(b * 2 + kv) * 512 * 64; const bf16* vcp = VC + (size_t)(b * 2 + kv) * 512 * 64;
        float m = -1e30f, l = 0.f;
#pragma unroll
        for (int i = 0; i < 64; ++i) o[i] = 0.f;
        for (int n = 0; n < nbound; ++n) { unsigned kr[32]; ldrow(kcp + (size_t)n * 64, kr);
            const float s = dot64(q, kr) * NAIVE_SC; asm volatile("" ::: "memory"); ldrow(vcp + (size_t)n * 64, kr); osm_step(n < nvis, s, m, l, o, kr); }
        float linv = 1.0f / fmaxf(l, 1e-30f);
#pragma unroll
        for (int i = 0; i < 16; ++i) { f32x4 w; w[0] = g0 * linv * o[4 * i]; w[1] = g0 * linv * o[4 * i + 1]; w[2] = g0 * linv * o[4 * i + 2]; w[3] = g0 * linv * o[4 * i + 3]; *(f32x4*)(otp + 4 * i) = w; }
        { float acc = 0.f;
          for (int n = 0; n < nbound; ++n) { unsigned kr[32]; ldrow(kcp + (size_t)n * 64, kr);
              const float s = dot64(q, kr) * NAIVE_SC; float p = (n < nvis) ? __expf(s - m) * linv : 0.f;
              p += __shfl_xor(p, 1); p += __shfl_xor(p, 2); acc += p;
              if ((n & 3) == 3) { if (g == 0) imp[ql * 129 + (n >> 2)] = acc; acc = p; } } }
        __syncthreads();
        const int cur = t >> 6; unsigned m0 = 0u, m1 = 0u, m2 = 0u, m3 = 0u;
#define SETBIT(j) do { const unsigned _b = 1u << ((j) & 31); const int _w = (j) >> 5; m0 |= _w == 0 ? _b : 0u; m1 |= _w == 1 ? _b : 0u; m2 |= _w == 2 ? _b : 0u; m3 |= _w == 3 ? _b : 0u; } while (0)
        if (cur < 16) { m0 = (1u << (cur + 1)) - 1u; }
        else { SETBIT(0); SETBIT(cur - 1); SETBIT(cur);
            for (int r = 0; r < 13; ++r) { float best = -0.5f; int bj = 1;
                for (int j = 1; j <= cur - 2; ++j) { const float v = imp[ql * 129 + j]; if (v > best) { best = v; bj = j; } }
                imp[ql * 129 + bj] = -1.0f; SETBIT(bj); } }
        m = -1e30f; l = 0.f;
#pragma unroll
        for (int i = 0; i < 64; ++i) o[i] = 0.f;
        { const bf16* kb = qkv + pg8::E_KSLC + (size_t)(b * 2 + kv) * SEQ * 64; const bf16* vb = qkv + pg8::E_VSLC + (size_t)(b * 2 + kv) * SEQ * 64;
          for (int it = 0; it < 16; ++it) {
              const bool have = (m0 | m1 | m2 | m3) != 0u; int j = 0;
              if (m0) { j = __builtin_ctz(m0); m0 &= m0 - 1u; } else if (m1) { j = 32 + __builtin_ctz(m1); m1 &= m1 - 1u; }
              else if (m2) { j = 64 + __builtin_ctz(m2); m2 &= m2 - 1u; } else if (m3) { j = 96 + __builtin_ctz(m3); m3 &= m3 - 1u; }
              for (int kk = 0; kk < 64; ++kk) { const int row = j * 64 + kk; unsigned kr[32]; ldrow(kb + (size_t)row * 64, kr);
                  const float s = dot64(q, kr) * NAIVE_SC; asm volatile("" ::: "memory"); ldrow(vb + (size_t)row * 64, kr); osm_step(have && row <= t, s, m, l, o, kr); } } }
        linv = 1.0f / fmaxf(l, 1e-30f);
#pragma unroll
        for (int i = 0; i < 16; ++i) { f32x4 w = *(const f32x4*)(otp + 4 * i); w[0] = fmaf(g1 * linv, o[4 * i], w[0]); w[1] = fmaf(g1 * linv, o[4 * i + 1], w[1]); w[2] = fmaf(g1 * linv, o[4 * i + 2], w[2]); w[3] = fmaf(g1 * linv, o[4 * i + 3], w[3]); *(f32x4*)(otp + 4 * i) = w; }
        m = -1e30f; l = 0.f;
#pragma unroll
        for (int i = 0; i < 64; ++i) o[i] = 0.f;
        { const bf16* kb = qkv + pg8::E_KWIN + (size_t)(b * 2 + kv) * SEQ * 64; const bf16* vb = qkv + pg8::E_VWIN + (size_t)(b * 2 + kv) * SEQ * 64;
          const int shi = qt * 128 + 127, slo = max(qt * 128 - 511, 0);
          for (int s_ = shi; s_ >= slo; --s_) { unsigned kr[32]; ldrow(kb + (size_t)s_ * 64, kr);
              const float s = dot64(q, kr) * NAIVE_SC; asm volatile("" ::: "memory"); ldrow(vb + (size_t)s_ * 64, kr); osm_step(s_ <= t && s_ > t - 512, s, m, l, o, kr); } }
        linv = 1.0f / fmaxf(l, 1e-30f);
        { bf16* op = O + (size_t)tok * 1024 + h * 64;
#pragma unroll
          for (int i = 0; i < 8; ++i) { const f32x4 a0 = *(const f32x4*)(otp + 8 * i), a1 = *(const f32x4*)(otp + 8 * i + 4); const float gl = g2 * linv; v4u w;
              w.x = pk2(fmaf(gl, o[8 * i], a0[0]), fmaf(gl, o[8 * i + 1], a0[1])); w.y = pk2(fmaf(gl, o[8 * i + 2], a0[2]), fmaf(gl, o[8 * i + 3], a0[3]));
              w.z = pk2(fmaf(gl, o[8 * i + 4], a1[0]), fmaf(gl, o[8 * i + 5], a1[1])); w.w = pk2(fmaf(gl, o[8 * i + 6], a1[2]), fmaf(gl, o[8 * i + 7], a1[3])); *(v4u*)(op + 8 * i) = w; } }
        __syncthreads();
    }
}

__device__ __forceinline__ void p3_moba_naive(Frame& F, const Args& A, bf16* O) {
    const bf16* qkv = (const bf16*)(F.ws + WS_QKV);
    const float* kmean = (const float*)(F.ws + WS_KMEAN);
    for (int item = F.vcu; item < 512; item += F.G) {
        const int bh = item >> 4, tile = item & 15, b = bh >> 3, h = bh & 7, t = tile * 512 + F.tid, tok = b * SEQ + t, cur = t >> 8;
        unsigned q[32]; ldrow(qkv + pg8::E_QM + ((size_t)bh * SEQ + t) * 64, q);
        float v0 = -3e38f, v1 = -3e38f, v2 = -3e38f; int i0 = -1, i1 = -1, i2 = -1;
        for (int n = 0; n < cur; ++n) { const float* kmp = kmean + ((size_t)bh * 32 + n) * 64; float gs = 0.f;
#pragma unroll
            for (int i = 0; i < 32; ++i) { gs = fmaf(bflo(q[i]), kmp[2 * i], gs); gs = fmaf(bfhi(q[i]), kmp[2 * i + 1], gs); }
            if (gs > v0) { v2 = v1; i2 = i1; v1 = v0; i1 = i0; v0 = gs; i0 = n; } else if (gs > v1) { v2 = v1; i2 = i1; v1 = gs; i1 = n; } else if (gs > v2) { v2 = gs; i2 = n; } }
        float o[64], m = -1e30f, l = 0.f;
#pragma unroll
        for (int i = 0; i < 64; ++i) o[i] = 0.f;
        const bf16* kb = qkv + pg8::E_KM + (size_t)bh * SEQ * 64; const bf16* vb = qkv + pg8::E_VM + (size_t)bh * SEQ * 64;
        for (int si = 0; si < 3; ++si) { const int j = si == 0 ? i0 : (si == 1 ? i1 : i2); const bool have = j >= 0; const int jj = have ? j : 0;
            for (int kk = 0; kk < 256; ++kk) { const int row = jj * 256 + kk; unsigned kr[32], vr[32]; ldrow(kb + (size_t)row * 64, kr); ldrow(vb + (size_t)row * 64, vr);
                const float s = dot64(q, kr) * NAIVE_SC; osm_step(have, s, m, l, o, vr); } }
        { const int r0 = (tile * 512 + (F.tid & ~63)) & ~255, r1 = tile * 512 + (F.tid | 63);
          for (int row = r0; row <= r1; ++row) { unsigned kr[32], vr[32]; ldrow(kb + (size_t)row * 64, kr); ldrow(vb + (size_t)row * 64, vr);
              const float s = dot64(q, kr) * NAIVE_SC; osm_step(row <= t, s, m, l, o, vr); } }
        const float linv = 1.0f / fmaxf(l, 1e-30f);
        { bf16* op = O + (size_t)tok * 1024 + 512 + h * 64;
#pragma unroll
          for (int i = 0; i < 8; ++i) { v4u w; w.x = pk2(o[8 * i] * linv, o[8 * i + 1] * linv); w.y = pk2(o[8 * i + 2] * linv, o[8 * i + 3] * linv); w.z = pk2(o[8 * i + 4] * linv, o[8 * i + 5] * linv); w.w = pk2(o[8 * i + 6] * linv, o[8 * i + 7] * linv); *(v4u*)(op + 8 * i) = w; } }
    }
}

__device__ __forceinline__ void p11_sb_naive(Frame& F, const Args& A) {
    const bf16* qkv = (const bf16*)(F.ws + WS_QKV);
    bf16* O = (bf16*)(F.ws + WS_O);
    for (int item = F.vcu; item < 1024; item += F.G) {
        const int bh = item >> 4, tile = item & 15, b = bh >> 4, h = bh & 15, t = tile * 512 + F.tid, tok = b * SEQ + t;
        unsigned q[32]; ldrow(qkv + ((size_t)bh * SEQ + t) * 64, q);
        const bf16* kb = qkv + (size_t)33554432 + (size_t)bh * SEQ * 64; const bf16* vb = qkv + (size_t)67108864 + (size_t)bh * SEQ * 64;
        float o[64], C = 0.f;
#pragma unroll
        for (int i = 0; i < 64; ++i) o[i] = 0.f;
        for (int s_ = tile * 512 + (F.tid | 63) - 1; s_ >= 0; --s_) {
            if (!__any(C > -120.f)) break;
            unsigned kr[32], vr[32]; ldrow(kb + (size_t)s_ * 64, kr); ldrow(vb + (size_t)s_ * 64, vr);
            const float z = dot64(q, kr) * NAIVE_SC, sp = fmaxf(z, 0.f) + __logf(1.0f + __expf(-fabsf(z)));
            if (s_ < t && C > -120.f) { const float w = __expf(z - sp + C); C -= sp;
#pragma unroll
                for (int i = 0; i < 32; ++i) { o[2 * i] = fmaf(w, bflo(vr[i]), o[2 * i]); o[2 * i + 1] = fmaf(w, bfhi(vr[i]), o[2 * i + 1]); } } }
        { bf16* op = O + (size_t)tok * 1024 + h * 64;
#pragma unroll
          for (int i = 0; i < 8; ++i) { v4u w; w.x = pk2(o[8 * i], o[8 * i + 1]); w.y = pk2(o[8 * i + 2], o[8 * i + 3]); w.z = pk2(o[8 * i + 4], o[8 * i + 5]); w.w = pk2(o[8 * i + 6], o[8 * i + 7]); *(v4u*)(op + 8 * i) = w; } }
    }
}

template <bool ROUTE, bool FINAL>
__device__ __forceinline__ void ln_phase(Frame& F, const Args& A, int layer, const float* gain, const float* bias, bf16* RB, float* outf) {
    const int TPW = NTOK / F.G, tok_lo = F.vcu * TPW;
    LAS float* WR = (LAS float*)F.lds;
    LAS int* hist = (LAS int*)(F.lds + 81920);
    if (ROUTE) {
        if (F.tid < 24) hist[F.tid] = 0;
        const float* wg = A.in[16] + (size_t)layer * 1024 * 4; const float* wrt = A.in[18] + (size_t)layer * 4 * 1024 * 4;
        for (int i = F.tid; i < 20 * 1024; i += 512) { const int c = i >> 10, k = i & 1023; WR[i] = c < 4 ? wg[k * 4 + c] : wrt[(size_t)((c - 4) >> 2) * 4096 + k * 4 + ((c - 4) & 3)]; }
        int* rowmap = (int*)(F.ws + WS_ROWMAP);
        for (int i = F.vcu * 512 + F.tid; i < MAXROWS; i += F.G * 512) rowmap[i] = -1;
        __syncthreads();
    }
    f32x4 gn[4], bs[4];
#pragma unroll
    for (int j = 0; j < 4; ++j) { gn[j] = *(const f32x4*)(gain + 4 * F.lane + 256 * j); bs[j] = *(const f32x4*)(bias + 4 * F.lane + 256 * j); }
    for (int ir = F.wave; ir < TPW; ir += NWAVES) { const int mrow = tok_lo + ir;
        bf16* xr = RB + (size_t)mrow * DM + 4 * F.lane;
        f32x4 v[4]; float s = 0.f;
#pragma unroll
        for (int j = 0; j < 4; ++j) { const v2u b = *(const v2u*)(xr + 256 * j); v[j][0] = bflo(b.x); v[j][1] = bfhi(b.x); v[j][2] = bflo(b.y); v[j][3] = bfhi(b.y); s += (v[j][0] + v[j][1]) + (v[j][2] + v[j][3]); }
        const float mean = wave_sum(s) * (1.f / DM); float s2 = 0.f;
#pragma unroll
        for (int j = 0; j < 4; ++j) { v[j] = v[j] - mean; s2 += (v[j][0] * v[j][0] + v[j][1] * v[j][1]) + (v[j][2] * v[j][2] + v[j][3] * v[j][3]); }
        const float rstd = 1.f / sqrtf(wave_sum(s2) * (1.f / DM) + LN_EPS);
#pragma unroll
        for (int j = 0; j < 4; ++j) { v[j] = v[j] * rstd * gn[j] + bs[j];
            if (FINAL) *(f32x4*)(outf + (size_t)mrow * DM + 4 * F.lane + 256 * j) = v[j];
            else { v2u w; w.x = pk2(v[j][0], v[j][1]); w.y = pk2(v[j][2], v[j][3]); *(v2u*)(xr + 256 * j) = w; } }
        if (ROUTE) {
            float lg[4];
#pragma unroll
            for (int c = 0; c < 4; ++c) { float p = 0.f;
#pragma unroll
                for (int j = 0; j < 4; ++j) { const f32x4 w = *(const LAS f32x4*)(WR + c * 1024 + 4 * F.lane + 256 * j); p += (v[j][0] * w[0] + v[j][1] * w[1]) + (v[j][2] * w[2] + v[j][3] * w[3]); }
                lg[c] = wave_sum(p) + A.in[17][layer * 4 + c]; }
            int g = 0; float gm = lg[0];
#pragma unroll
            for (int c = 1; c < 4; ++c) if (lg[c] > gm) { gm = lg[c]; g = c; }
            const float wgp = 1.0f / ((__expf(lg[0] - gm) + __expf(lg[1] - gm)) + (__expf(lg[2] - gm) + __expf(lg[3] - gm)));
            float le[4];
#pragma unroll
            for (int e = 0; e < 4; ++e) { float p = 0.f;
#pragma unroll
                for (int j = 0; j < 4; ++j) { const f32x4 w = *(const LAS f32x4*)(WR + (4 + g * 4 + e) * 1024 + 4 * F.lane + 256 * j); p += (v[j][0] * w[0] + v[j][1] * w[1]) + (v[j][2] * w[2] + v[j][3] * w[3]); }
                le[e] = wave_sum(p) + A.in[19][layer * 16 + g * 4 + e]; }
            int i1 = 0; float e1 = le[0];
#pragma unroll
            for (int e = 1; e < 4; ++e) if (le[e] > e1) { e1 = le[e]; i1 = e; }
            int i2 = -1; float e2 = -3e38f;
#pragma unroll
            for (int e = 0; e < 4; ++e) if (e != i1 && le[e] > e2) { e2 = le[e]; i2 = e; }
            const float w1 = 1.0f / (1.0f + __expf(e2 - e1)), w2 = 1.0f - w1;
            const int lo = min(i1, i2), hi = max(i1, i2), pi = lo == 0 ? hi - 1 : (lo == 1 ? hi + 1 : 5), bkt = g * 6 + pi;
            const float wlo = (i1 < i2 ? w1 : w2) * wgp, whi = (i1 < i2 ? w2 : w1) * wgp;
            if (F.lane == 0) { f32x4 ti; ti[0] = __builtin_bit_cast(float, bkt); ti[1] = 0.f; ti[2] = wlo; ti[3] = whi; *(f32x4*)(F.ws + WS_TOKI + (size_t)mrow * 16) = ti; }
            if (F.lane == 0) __hip_atomic_fetch_add(hist + bkt, 1, __ATOMIC_RELAXED, __HIP_MEMORY_SCOPE_WORKGROUP);
        }
    }
    if (ROUTE) { __syncthreads(); if (F.tid < 24) ((int*)(F.ws + WS_HIST))[F.vcu * 24 + F.tid] = hist[F.tid]; }
}
__device__ __forceinline__ void scatter_phase(Frame& F) {
    const int TPW = NTOK / F.G, tok_lo = F.vcu * TPW;
    LAS int* ptab = (LAS int*)(F.lds + PTAB_OFF); LAS int* pstart = (LAS int*)(F.lds + PTAB_OFF + 1024);
    LAS int* cnt = (LAS int*)(F.lds + PTAB_OFF + 1280); LAS int* lt = (LAS int*)(F.lds + PTAB_OFF + 1408);
    LAS int* H = (LAS int*)F.lds;
    LAS int* dstl = (LAS int*)(F.lds + 32768); LAS int* bkl = (LAS int*)(F.lds + 36864);
    __syncthreads();
    for (int i = F.tid; i < F.G * 24; i += 512) H[i] = ((const int*)(F.ws + WS_HIST))[i];
    for (int i = F.tid; i < TPW; i += 512) bkl[i] = *(const int*)(F.ws + WS_TOKI + (size_t)(tok_lo + i) * 16);
    __syncthreads();
    if (F.tid < 24) { int c = 0, l = 0; for (int v = 0; v < F.G; ++v) { const int h = H[v * 24 + F.tid]; c += h; l += v < F.vcu ? h : 0; } cnt[F.tid] = c; lt[F.tid] = l; }
    __syncthreads();
    if (F.tid == 0) { int p = 0;
        for (int bkt = 0; bkt < 24; ++bkt) { const int np = (cnt[bkt] + 255) >> 8;
            pstart[bkt] = p; for (int i = 0; i < np && p < MAXPAN; ++i) ptab[p++] = bkt; }
        pstart[24] = p;
        for (int i = 0; i < TPW; ++i) { const int bkt = bkl[i]; dstl[i] = pstart[bkt] * 256 + lt[bkt]; lt[bkt] = lt[bkt] + 1; } }
    __syncthreads();
    if (F.vcu == 0) { int* gt = (int*)(F.ws + WS_GTAB); const int np = pstart[24]; if (F.tid == 0) gt[0] = np; if (F.tid < np) gt[1 + F.tid] = ptab[F.tid]; }
    int* rowmap = (int*)(F.ws + WS_ROWMAP); float* wrow = (float*)(F.ws + WS_WROW);
    for (int i = F.tid; i < TPW; i += 512) {
        const int mrow = tok_lo + i, dst = dstl[i];
        const f32x4 ti = *(const f32x4*)(F.ws + WS_TOKI + (size_t)mrow * 16);
        rowmap[dst] = mrow; wrow[(size_t)dst * 2] = ti[2]; wrow[(size_t)dst * 2 + 1] = ti[3];
    }
    __syncthreads();
}
__device__ __forceinline__ int load_ptab(Frame& F) {
    LAS int* ptab = (LAS int*)(F.lds + PTAB_OFF); const int* gt = (const int*)(F.ws + WS_GTAB);
    __syncthreads();
    const int np = gt[0];
    if (F.tid < np && F.tid < MAXPAN) ptab[F.tid] = gt[1 + F.tid];
    __syncthreads();
    return np < MAXPAN ? np : MAXPAN;
}
struct MoeOrder1 {
    static constexpr bool GATHER = true;
    int G, c, nunits; const LAS int* ptab; const bf16* W1E; const int* rowmap;
    __device__ __forceinline__ int arow(const pg8::Unit& u, int r) const { const int t = rowmap[u.pm * 256 + r]; return t < 0 ? 0 : t; }
    __device__ __forceinline__ bool next(int i, pg8::Unit& u) const { const int L = i * G + c; if (L >= nunits) return false; u.pm = L >> 2; u.pn = L & 3; u.aux = __builtin_amdgcn_readfirstlane(ptab[u.pm]); return true; }
    __device__ __forceinline__ const char* aptr(const pg8::Gemm& g, const pg8::Unit& u, size_t tstep) const { return (const char*)g.A + (size_t)u.pm * tstep; }
    __device__ __forceinline__ const char* bptr(const pg8::Gemm& g, const pg8::Unit& u, size_t tstep) const {
        const int grp = u.aux / 6; int lo, hi; bucket_pair(u.aux % 6, lo, hi); const int e = grp * 4 + ((u.pn >> 1) ? hi : lo);
        return (const char*)(W1E + ((size_t)e * 512 + (size_t)(u.pn & 1) * 256) * 1024); }
    __device__ __forceinline__ void a_ready(const pg8::Unit&) const {}
    __device__ __forceinline__ void done(const pg8::Unit&) const {}
};
struct MoeOrder2 {
    static constexpr bool GATHER = false;
    __device__ __forceinline__ int arow(const pg8::Unit&, int) const { return 0; }
    int G, c, nunits; const LAS int* ptab; const bf16* B2;
    __device__ __forceinline__ bool next(int i, pg8::Unit& u) const { const int L = i * G + c; if (L >= nunits) return false; u.pm = L >> 2; u.pn = L & 3; u.aux = __builtin_amdgcn_readfirstlane(ptab[u.pm]); return true; }
    __device__ __forceinline__ const char* aptr(const pg8::Gemm& g, const pg8::Unit& u, size_t tstep) const { return (const char*)g.A + (size_t)u.pm * tstep; }
    __device__ __forceinline__ const char* bptr(const pg8::Gemm& g, const pg8::Unit& u, size_t tstep) const { return (const char*)(B2 + ((size_t)u.aux * 1024 + (size_t)u.pn * 256) * 512); }
    __device__ __forceinline__ void a_ready(const pg8::Unit&) const {}
    __device__ __forceinline__ void done(const pg8::Unit&) const {}
};

#define KOFF(i) (32 * ((i) >> 4) + 8 * (((i) & 15) >> 2) + ((i) & 3))
typedef short bf16x8 __attribute__((ext_vector_type(8)));
typedef short s16x4 __attribute__((ext_vector_type(4)));
typedef float f32x16 __attribute__((ext_vector_type(16)));
typedef float f32x2 __attribute__((ext_vector_type(2)));
#define MFMA32(a, b, c) __builtin_amdgcn_mfma_f32_32x32x16_bf16(a, b, c, 0, 0, 0)
#ifndef SB_EXIT
#define SB_EXIT 1
#endif
constexpr float L2E = 1.4426950408889634f, LN2 = 0.6931471805599453f;
__device__ __forceinline__ int crow(int r, int hi) { return (r & 3) + 8 * (r >> 2) + 4 * hi; }
typedef __bf16 bf16x2_t __attribute__((ext_vector_type(2)));
__device__ __forceinline__ unsigned cvtpk(float lo, float hi) { bf16x2_t v; v[0] = (__bf16)lo; v[1] = (__bf16)hi; return __builtin_bit_cast(unsigned, v); }
__device__ __forceinline__ void swap32(float v, float& r0, float& r1) { unsigned a = __builtin_bit_cast(unsigned, v), b = a;
    asm volatile("v_nop\n\tv_nop\n\tv_permlane32_swap_b32 %0, %1" : "+v"(a), "+v"(b)); r0 = __builtin_bit_cast(float, a); r1 = __builtin_bit_cast(float, b); }
__device__ __forceinline__ float swap_sum(float v) { float r0, r1; swap32(v, r0, r1); return r0 + r1; }
__device__ __forceinline__ float swap_max(float v) { float r0, r1; swap32(v, r0, r1); return fmaxf(r0, r1); }
__device__ __forceinline__ float swap_other(float v, int hi) { float r0, r1; swap32(v, r0, r1); return hi ? r0 : r1; }
__device__ __forceinline__ void kv_issue(const bf16* Kt, const bf16* Vt, int wave, int lane, v4u& kr, v4u& vr) {
    kr = *(const v4u*)(Kt + (size_t)lane * 64 + wave * 8);
    vr = *(const v4u*)(Vt + (size_t)(16 * (wave & 3) + (lane >> 2)) * 64 + (wave >> 2) * 32 + (lane & 3) * 8);
}
__device__ __forceinline__ void kv_commit(LAS unsigned char* kbuf, LAS unsigned char* vbuf, int wave, int lane, const v4u& kr, const v4u& vr) {
    *(LAS v4u*)(kbuf + wave * 1024 + lane * 16) = kr; *(LAS v4u*)(vbuf + wave * 1024 + lane * 16) = vr;
}
__device__ __forceinline__ void qk_tile(const LAS unsigned char* kbuf, const bf16x8 (&qr)[4], int r32, int hi, f32x16& p0, f32x16& p1, const float cinit = 0.f) {
#pragma unroll
    for (int r = 0; r < 16; ++r) { p0[r] = cinit; p1[r] = cinit; }
#pragma unroll
    for (int d0 = 0; d0 < 4; ++d0) { const LAS unsigned char* kp = kbuf + (2 * d0 + hi) * 1024 + r32 * 16;
        const bf16x8 k0 = *(const LAS bf16x8*)kp, k1 = *(const LAS bf16x8*)(kp + 512);
        p0 = MFMA32(k0, qr[d0], p0); p1 = MFMA32(k1, qr[d0], p1); }
}
__device__ __forceinline__ s16x4 vtr(const LAS unsigned char* p) { return __builtin_bit_cast(s16x4, __builtin_amdgcn_ds_read_tr16_b64_v4i16((LAS s16x4*)p)); }
__device__ __forceinline__ void pv_tile(const LAS unsigned char* vbuf, const f32x16& p0, const f32x16& p1, f32x16 (&o)[2], int lane, int hi) {
    const LAS unsigned char* vp0 = vbuf + ((lane >> 4) & 1) * 32 + (lane & 3) * 8 + (4 * hi + ((lane & 15) >> 2)) * 64;
#pragma unroll
    for (int s = 0; s < 4; ++s) { const int rb = 8 * (s & 1); v4u w;
        if (s < 2) { w.x = cvtpk(p0[rb], p0[rb + 1]); w.y = cvtpk(p0[rb + 2], p0[rb + 3]); w.z = cvtpk(p0[rb + 4], p0[rb + 5]); w.w = cvtpk(p0[rb + 6], p0[rb + 7]); }
        else       { w.x = cvtpk(p1[rb], p1[rb + 1]); w.y = cvtpk(p1[rb + 2], p1[rb + 3]); w.z = cvtpk(p1[rb + 4], p1[rb + 5]); w.w = cvtpk(p1[rb + 6], p1[rb + 7]); }
        const bf16x8 pb = __builtin_bit_cast(bf16x8, w);
#pragma unroll
        for (int dh = 0; dh < 2; ++dh) {
#ifdef DBG_SAFE_TR
            bf16x8 a;
#pragma unroll
            for (int j = 0; j < 8; ++j) { const int key = 16 * s + 8 * (j >> 2) + 4 * hi + (j & 3); a[j] = *(const LAS short*)(vbuf + dh * 4096 + key * 64 + (lane & 31) * 2); }
#else
            const s16x4 lo = vtr(vp0 + dh * 4096 + s * 1024), hi4 = vtr(vp0 + dh * 4096 + s * 1024 + 512);
            bf16x8 a; a[0] = lo[0]; a[1] = lo[1]; a[2] = lo[2]; a[3] = lo[3]; a[4] = hi4[0]; a[5] = hi4[1]; a[6] = hi4[2]; a[7] = hi4[3];
#endif
            o[dh] = MFMA32(a, pb, o[dh]); }
        __builtin_amdgcn_sched_barrier(0); }
}
__device__ __forceinline__ void store_o(bf16* orow, const f32x16 (&o)[2], int hi, float sc) {
#pragma unroll
    for (int dh = 0; dh < 2; ++dh)
#pragma unroll
        for (int g = 0; g < 4; ++g) { v2u w; w.x = pk2(o[dh][4 * g] * sc, o[dh][4 * g + 1] * sc); w.y = pk2(o[dh][4 * g + 2] * sc, o[dh][4 * g + 3] * sc);
            *(v2u*)(orow + 32 * dh + 8 * g + 4 * hi) = w; }
}

__device__ __forceinline__ void sb_process(f32x16& p0, f32x16& p1, int thr, int hi, float& A) {
    float sp[32], T[8];
    if (__all(thr >= 60)) {
#pragma unroll
        for (int i = 0; i < 32; i += 2) { f32x2 z = {i < 16 ? p0[i] : p1[i - 16], i < 16 ? p0[i + 1] : p1[i - 15]};
            f32x2 e; e[0] = __builtin_amdgcn_exp2f(-fabsf(z[0])); e[1] = __builtin_amdgcn_exp2f(-fabsf(z[1]));
            e = e + 1.0f; f32x2 lg; lg[0] = __builtin_amdgcn_logf(e[0]); lg[1] = __builtin_amdgcn_logf(e[1]);
            f32x2 mxz; mxz[0] = fmaxf(z[0], 0.f); mxz[1] = fmaxf(z[1], 0.f);
            const f32x2 spv = mxz + lg, zz = z - spv; sp[i] = spv[0]; sp[i + 1] = spv[1];
            if (i < 16) { p0[i] = zz[0]; p0[i + 1] = zz[1]; } else { p1[i - 16] = zz[0]; p1[i - 15] = zz[1]; } }
    } else {
#pragma unroll
        for (int i = 0; i < 32; ++i) { const float z = i < 16 ? p0[i] : p1[i - 16];
            const float e = __builtin_amdgcn_exp2f(-fabsf(z)), spv = fmaxf(z, 0.f) + __builtin_amdgcn_logf(1.0f + e);
            const bool valid = KOFF(i) < thr; sp[i] = valid ? spv : 0.f; const float zz = valid ? (z - spv) : -1e30f;
            if (i < 16) p0[i] = zz; else p1[i - 16] = zz; }
    }
#pragma unroll
    for (int u = 0; u < 8; ++u) T[u] = (sp[4 * u] + sp[4 * u + 1]) + (sp[4 * u + 2] + sp[4 * u + 3]);
    float after = A;
#pragma unroll
    for (int u = 7; u >= 0; --u) { const float pt = swap_sum(T[u]); const float hb = after + (hi ? 0.f : (pt - T[u]));
        const float s3 = hb, s2 = hb + sp[4 * u + 3], s1 = s2 + sp[4 * u + 2], s0 = s1 + sp[4 * u + 1];
        const int i0 = 4 * u;
        f32x2 a = {i0 < 16 ? p0[i0] : p1[i0 - 16], i0 < 16 ? p0[i0 + 1] : p1[i0 - 15]}, b = {i0 < 16 ? p0[i0 + 2] : p1[i0 - 14], i0 < 16 ? p0[i0 + 3] : p1[i0 - 13]};
        const f32x2 sa = {s0, s1}, sb = {s2, s3}; a = a - sa; b = b - sb;
        const float w0 = __builtin_amdgcn_exp2f(a[0]), w1 = __builtin_amdgcn_exp2f(a[1]), w2 = __builtin_amdgcn_exp2f(b[0]), w3 = __builtin_amdgcn_exp2f(b[1]);
        if (i0 < 16) { p0[i0] = w0; p0[i0 + 1] = w1; p0[i0 + 2] = w2; p0[i0 + 3] = w3; } else { p1[i0 - 16] = w0; p1[i0 - 15] = w1; p1[i0 - 14] = w2; p1[i0 - 13] = w3; }
        after += pt; }
    A = after;
}
__device__ __forceinline__ void p11_sb_mfma(Frame& F) {
    const bf16* Qg = (const bf16*)(F.ws + WS_QKV); const bf16* Kg = Qg + (size_t)33554432; const bf16* Vg = Qg + (size_t)67108864;
    bf16* O = (bf16*)(F.ws + WS_O);
    volatile LAS unsigned* flag = (volatile LAS unsigned*)(F.lds + 65536);
    const int lane = F.lane, r32 = lane & 31, hi = lane >> 5, w = F.wave, hs = w >> 2, w4 = w & 3;
    LAS unsigned char* L = F.lds + hs * 32768;
    for (int unit = F.vcu; unit < 2048; unit += F.G) {
        const int bhp = unit >> 6, qb = unit & 63, b = bhp >> 3, h = 2 * (bhp & 7) + hs, bh = b * 16 + h, Q0 = qb * 128, tq = Q0 + 32 * w4 + r32;
        const bf16* K0 = Kg + (size_t)(b * 16 + 2 * (bhp & 7)) * SEQ * 64; const bf16* V0 = Vg + (size_t)(b * 16 + 2 * (bhp & 7)) * SEQ * 64;
        bf16x8 qr[4];
#pragma unroll
        for (int d0 = 0; d0 < 4; ++d0) qr[d0] = *(const bf16x8*)(Qg + ((size_t)bh * SEQ + tq) * 64 + 16 * d0 + 8 * hi);
        f32x16 o[2];
#pragma unroll
        for (int r = 0; r < 16; ++r) { o[0][r] = 0.f; o[1][r] = 0.f; }
        float A = 0.f; const int kt_top = (Q0 >> 6) + 1, my_top = (Q0 >> 6) + (w4 >> 1);
        bool done = false;
        if (F.tid == 0) { flag[0] = 0u; flag[1] = 0u; flag[2] = 0u; }
        { v4u kr0, vr0, kr1, vr1; kv_issue(K0 + (size_t)kt_top * 4096, V0 + (size_t)kt_top * 4096, w, lane, kr0, vr0); kv_issue(K0 + (size_t)SEQ * 64 + (size_t)kt_top * 4096, V0 + (size_t)SEQ * 64 + (size_t)kt_top * 4096, w, lane, kr1, vr1);
          kv_commit(F.lds, F.lds + 16384, w, lane, kr0, vr0); kv_commit(F.lds + 32768, F.lds + 32768 + 16384, w, lane, kr1, vr1); }
        __syncthreads();
        for (int i = 0, kt = kt_top; kt >= 0; ++i, --kt) {
            const int cb = i & 1; v4u kr0, vr0, kr1, vr1;
            if (kt > 0) { kv_issue(K0 + (size_t)(kt - 1) * 4096, V0 + (size_t)(kt - 1) * 4096, w, lane, kr0, vr0); kv_issue(K0 + (size_t)SEQ * 64 + (size_t)(kt - 1) * 4096, V0 + (size_t)SEQ * 64 + (size_t)(kt - 1) * 4096, w, lane, kr1, vr1); }
            if (!done && kt <= my_top) {
                f32x16 p0, p1; qk_tile(L + cb * 8192, qr, r32, hi, p0, p1);
                sb_process(p0, p1, tq - 64 * kt - 4 * hi, hi, A);
                pv_tile(L + 16384 + cb * 8192, p0, p1, o, lane, hi);
                if (SB_EXIT && __all(A > 174.f)) done = true;
            }
            const int fi = i % 3; if (F.tid == 0) flag[(i + 1) % 3] = 0u;
            if (done && lane == 0) __hip_atomic_fetch_or((LAS unsigned*)(F.lds + 65536) + fi, 1u << w, __ATOMIC_RELAXED, __HIP_MEMORY_SCOPE_WORKGROUP);
            if (kt > 0) { kv_commit(F.lds + (cb ^ 1) * 8192, F.lds + 16384 + (cb ^ 1) * 8192, w, lane, kr0, vr0); kv_commit(F.lds + 32768 + (cb ^ 1) * 8192, F.lds + 32768 + 16384 + (cb ^ 1) * 8192, w, lane, kr1, vr1); }
            __syncthreads();
            if (flag[fi] == 0xFFu) break;
        }
        store_o(O + (size_t)(b * SEQ + tq) * 1024 + h * 64, o, hi, 1.0f);
        __syncthreads();
    }
}

struct TileMask { int lo, hi_; bool on; };
#define MX3(a, b, c) fmaxf(fmaxf((a), (b)), (c))
__device__ __forceinline__ void sm_process(f32x16& p0, f32x16& p1, float& m, float& l, f32x16 (&o)[2], const TileMask tm) {
    if (!__all(tm.lo < 0 && tm.hi_ >= 63)) {
        const int lo = tm.lo, hi_ = tm.hi_;
#pragma unroll
        for (int i = 0; i < 32; ++i) { const float s = i < 16 ? p0[i] : p1[i - 16]; const float x = (KOFF(i) > lo && KOFF(i) <= hi_) ? s : -INFINITY; if (i < 16) p0[i] = x; else p1[i - 16] = x; }
    }
    float ma = MX3(p0[0], p0[1], p1[0]), mb = MX3(p0[2], p0[3], p1[1]); ma = MX3(ma, p1[2], p1[3]);
#pragma unroll
    for (int r = 4; r < 16; r += 4) { ma = MX3(ma, p0[r], p0[r + 1]); mb = MX3(mb, p0[r + 2], p0[r + 3]); ma = MX3(ma, p1[r], p1[r + 1]); mb = MX3(mb, p1[r + 2], p1[r + 3]); }
    const float mx = swap_max(fmaxf(fmaxf(ma, mb), -1e30f));
    const float mnew = fmaxf(m, mx), alpha = __builtin_amdgcn_exp2f(m - mnew);
    const f32x2 nm = {-mnew, -mnew}; f32x2 ls2 = {0.f, 0.f};
#pragma unroll
    for (int i = 0; i < 16; i += 2) {
        f32x2 a = {p0[i], p0[i + 1]}, b = {p1[i], p1[i + 1]}; a = a + nm; b = b + nm;
        a[0] = __builtin_amdgcn_exp2f(a[0]); a[1] = __builtin_amdgcn_exp2f(a[1]); b[0] = __builtin_amdgcn_exp2f(b[0]); b[1] = __builtin_amdgcn_exp2f(b[1]);
        p0[i] = a[0]; p0[i + 1] = a[1]; p1[i] = b[0]; p1[i + 1] = b[1]; ls2 = ls2 + a; ls2 = ls2 + b; }
    l = l * alpha + (ls2[0] + ls2[1]); m = mnew;
    if (!__all(alpha == 1.0f)) { const f32x2 al = {alpha, alpha};
#pragma unroll
        for (int r = 0; r < 16; r += 2) { f32x2 a = {o[0][r], o[0][r + 1]}, b = {o[1][r], o[1][r + 1]}; a = a * al; b = b * al; o[0][r] = a[0]; o[0][r + 1] = a[1]; o[1][r] = b[0]; o[1][r + 1] = b[1]; } }
}
template <class Act, class Mask>
__device__ __forceinline__ void sm_stream(Frame& F, const bf16* Kh, const bf16* Vh, int t0, int t1, const bf16x8 (&qr)[4], float& m, float& l, f32x16 (&o)[2], Act act, Mask mask) {
    if (t0 >= t1) return;
    LAS unsigned char* L = F.lds; const int lane = F.lane, r32 = lane & 31, hi = lane >> 5, w = F.wave;
    { v4u kr, vr; kv_issue(Kh + (size_t)t0 * 4096, Vh + (size_t)t0 * 4096, w, lane, kr, vr); kv_commit(L, L + 16384, w, lane, kr, vr); }
    __syncthreads();
    for (int t = t0; t < t1; ++t) {
        const int cb = (t - t0) & 1; v4u kr, vr;
        if (t + 1 < t1) kv_issue(Kh + (size_t)(t + 1) * 4096, Vh + (size_t)(t + 1) * 4096, w, lane, kr, vr);
        if (act(t)) { f32x16 p0, p1; const TileMask tm = mask(t);
            if (__all(tm.on)) qk_tile(L + cb * 8192, qr, r32, hi, p0, p1); else qk_tile(L + cb * 8192, qr, r32, hi, p0, p1, tm.on ? 0.f : -INFINITY);
            __builtin_amdgcn_sched_barrier(0);
            sm_process(p0, p1, m, l, o, tm);
            __builtin_amdgcn_sched_barrier(0);
            pv_tile(L + 16384 + cb * 8192, p0, p1, o, lane, hi); }
        if (t + 1 < t1) kv_commit(L + (cb ^ 1) * 8192, L + 16384 + (cb ^ 1) * 8192, w, lane, kr, vr);
        __syncthreads();
    }
}

constexpr size_t MB_SCR = 104 * MiB;
constexpr size_t MB_CNT = MB_SCR, MB_SELP = MB_SCR + 1 * MiB, MB_SEG = MB_SCR + 2 * MiB;
constexpr size_t MB_PARTO = 0, MB_PARTML = 96 * MiB;
__device__ __forceinline__ bool better(float va, int ia, float vb, int ib) { return va > vb || (va == vb && ia < ib); }
__device__ __forceinline__ void top3_insert(float gv, int n, float& v0, int& i0, float& v1, int& i1, float& v2, int& i2) {
    const bool b0 = better(gv, n, v0, i0), b1 = better(gv, n, v1, i1), b2 = better(gv, n, v2, i2);
    const float nv2 = b1 ? v1 : (b2 ? gv : v2), nv1 = b0 ? v0 : (b1 ? gv : v1), nv0 = b0 ? gv : v0;
    const int ni2 = b1 ? i1 : (b2 ? n : i2), ni1 = b0 ? i0 : (b1 ? n : i1), ni0 = b0 ? n : i0;
    v0 = nv0; v1 = nv1; v2 = nv2; i0 = ni0; i1 = ni1; i2 = ni2;
}
__device__ __forceinline__ void moba_gate(Frame& F, float* dout) {
    const bf16* qkv = (const bf16*)(F.ws + WS_QKV);
    const bf16* KMH = (const bf16*)(F.ws + WS_KMH); const bf16* KML = (const bf16*)(F.ws + WS_KML);
    int* cnt = (int*)((unsigned char*)dout + MB_CNT); unsigned* selp = (unsigned*)((unsigned char*)dout + MB_SELP); unsigned short* seg = (unsigned short*)((unsigned char*)dout + MB_SEG);
    LAS int* wc = (LAS int*)F.lds;
    const int lane = F.lane, r32 = lane & 31, hi = lane >> 5, w = F.wave;
    for (int u = F.vcu; u < 1024; u += F.G) {
        const int bh = u >> 5, cur = u & 31, tq = cur * 256 + 32 * w + r32;
        bf16x8 qr[4];
#pragma unroll
        for (int d0 = 0; d0 < 4; ++d0) qr[d0] = *(const bf16x8*)(qkv + pg8::E_QM + ((size_t)bh * SEQ + tq) * 64 + 16 * d0 + 8 * hi);
        f32x16 gt;
#pragma unroll
        for (int r = 0; r < 16; ++r) gt[r] = 0.f;
#pragma unroll
        for (int d0 = 0; d0 < 4; ++d0) { const bf16x8 kh = *(const bf16x8*)(KMH + ((size_t)bh * 32 + r32) * 64 + 16 * d0 + 8 * hi), kl = *(const bf16x8*)(KML + ((size_t)bh * 32 + r32) * 64 + 16 * d0 + 8 * hi);
            gt = MFMA32(kh, qr[d0], gt); gt = MFMA32(kl, qr[d0], gt); }
        float v0 = -INFINITY, v1 = -INFINITY, v2 = -INFINITY; int i0 = 99, i1 = 99, i2 = 99;
#pragma unroll
        for (int r = 0; r < 16; ++r) { const int n = crow(r, hi); const float gv = n < cur ? gt[r] : -INFINITY; top3_insert(gv, n, v0, i0, v1, i1, v2, i2); }
        const float pv0 = swap_other(v0, hi), pv1 = swap_other(v1, hi), pv2 = swap_other(v2, hi);
        const int pi0 = __builtin_bit_cast(int, swap_other(__builtin_bit_cast(float, i0), hi)), pi1 = __builtin_bit_cast(int, swap_other(__builtin_bit_cast(float, i1), hi)), pi2 = __builtin_bit_cast(int, swap_other(__builtin_bit_cast(float, i2), hi));
        top3_insert(pv0, pi0, v0, i0, v1, i1, v2, i2); top3_insert(pv1, pi1, v0, i0, v1, i1, v2, i2); top3_insert(pv2, pi2, v0, i0, v1, i1, v2, i2);
        const int s0 = (i0 < 32 && v0 > -INFINITY) ? i0 : 255, s1 = (i1 < 32 && v1 > -INFINITY) ? i1 : 255, s2 = (i2 < 32 && v2 > -INFINITY) ? i2 : 255;
        if (hi == 0) selp[(size_t)bh * SEQ + tq] = (unsigned)s0 | ((unsigned)s1 << 8) | ((unsigned)s2 << 16);
        for (int j = 0; j < cur; ++j) { const bool sel = (hi == 0) && (s0 == j || s1 == j || s2 == j); const unsigned long long bal = __ballot(sel); if (lane == 0) wc[w * 32 + j] = __popcll(bal); }
        __syncthreads();
        for (int j = 0; j < cur; ++j) { const bool sel = (hi == 0) && (s0 == j || s1 == j || s2 == j); const unsigned long long bal = __ballot(sel);
            int base = 0; for (int ww = 0; ww < w; ++ww) base += wc[ww * 32 + j];
            if (sel) { const int rank = __popcll(bal & ((1ull << r32) - 1ull)), slot = s0 == j ? 0 : (s1 == j ? 1 : 2);
                seg[(((size_t)bh * 32 + cur) * 32 + j) * 256 + base + rank] = (unsigned short)((32 * w + r32) | (slot << 8)); } }
        if (F.tid < 32) { int c = 0; if (F.tid < cur) { for (int ww = 0; ww < 8; ++ww) c += wc[ww * 32 + F.tid]; } cnt[((size_t)bh * 32 + cur) * 32 + F.tid] = c; }
        __syncthreads();
    }
}
constexpr int MB_UST = 100352, MB_TOT = 104704, MB_C32 = 108800;
__device__ __forceinline__ int moba_part_setup(Frame& F, const float* dout) {
    const int* cnt = (const int*)((const unsigned char*)dout + MB_CNT); LAS int* ust = (LAS int*)(F.lds + MB_UST); LAS int* tot = (LAS int*)(F.lds + MB_TOT);
    __syncthreads();
    for (int p = F.tid; p < 1024; p += 512) { const int bh = p >> 5, j = p & 31; int t = 0; for (int cu = j + 1; cu < 32; ++cu) t += cnt[((size_t)bh * 32 + cu) * 32 + j]; tot[p] = t; }
    __syncthreads();
    LAS int* part = (LAS int*)(F.lds + MB_C32 + 512);
    if (F.tid < 32) { int a = 0; for (int q = 0; q < 32; ++q) a += (tot[F.tid * 32 + q] + 255) >> 8; part[F.tid] = a; }
    __syncthreads();
    if (F.tid == 0) { int a = 0; for (int q = 0; q < 32; ++q) { const int n = part[q]; part[q] = a; a += n; } ust[1024] = a; }
    __syncthreads();
    if (F.tid < 32) { int a = part[F.tid]; for (int q = 0; q < 32; ++q) { ust[F.tid * 32 + q] = a; a += (tot[F.tid * 32 + q] + 255) >> 8; } }
    __syncthreads();
    return ust[1024];
}
__device__ __forceinline__ int moba_part_unit(Frame& F, float* dout, const int u, const int staged) {
    const bf16* qkv = (const bf16*)(F.ws + WS_QKV);
    const int* cnt = (const int*)((const unsigned char*)dout + MB_CNT); const unsigned short* seg = (const unsigned short*)((const unsigned char*)dout + MB_SEG);
    bf16* parto = (bf16*)((unsigned char*)dout + MB_PARTO); float* partml = (float*)((unsigned char*)dout + MB_PARTML);
    LAS int* ust = (LAS int*)(F.lds + MB_UST); LAS int* tot = (LAS int*)(F.lds + MB_TOT); LAS int* c32 = (LAS int*)(F.lds + MB_C32);
    LAS unsigned char* L = F.lds;
    const int lane = F.lane, r32 = lane & 31, hi = lane >> 5, w = F.wave;
    int lo = 0, hb = 1024;
    while (hb - lo > 1) { const int mid = (lo + hb) >> 1; if (ust[mid] <= u) lo = mid; else hb = mid; }
    const int p = lo, bh = p >> 5, j = p & 31, k = u - ust[p], total = tot[p];
    if (p != staged) {
        __syncthreads();
        const bf16* Kh = qkv + pg8::E_KM + (size_t)bh * SEQ * 64 + (size_t)j * 16384; const bf16* Vh = qkv + pg8::E_VM + (size_t)bh * SEQ * 64 + (size_t)j * 16384;
        v4u kr[4], vr[4];
#pragma unroll
        for (int t = 0; t < 4; ++t) kv_issue(Kh + (size_t)t * 4096, Vh + (size_t)t * 4096, w, lane, kr[t], vr[t]);
        if (F.tid < 32) c32[F.tid] = F.tid > j ? cnt[((size_t)bh * 32 + F.tid) * 32 + j] : 0;
#pragma unroll
        for (int t = 0; t < 4; ++t) kv_commit(L + t * 8192, L + 32768 + t * 8192, w, lane, kr[t], vr[t]);
        __syncthreads();
    }
    const int ci = 256 * k + 32 * w + r32; const bool valid = ci < total;
    int cu = j + 1, acc = 0;
    if (valid) { for (int c2 = j + 1; c2 < 32; ++c2) { const int n = c32[c2]; if (ci >= acc + n) { acc += n; cu = c2 + 1; } else break; } }
    int ql = 0, slot = 0;
    if (valid) { const unsigned e = seg[(((size_t)bh * 32 + cu) * 32 + j) * 256 + (ci - acc)]; ql = e & 255; slot = e >> 8; } else cu = j + 1;
    const int tq = valid ? cu * 256 + ql : (j + 1) * 256;
    if (__ballot(valid) != 0ull) {
        bf16x8 qr[4];
#pragma unroll
        for (int d0 = 0; d0 < 4; ++d0) qr[d0] = *(const bf16x8*)(qkv + pg8::E_QM + ((size_t)bh * SEQ + tq) * 64 + 16 * d0 + 8 * hi);
        float m = -1e30f, l = 0.f; f32x16 o[2];
#pragma unroll
        for (int r = 0; r < 16; ++r) { o[0][r] = 0.f; o[1][r] = 0.f; }
        TileMask tm; tm.lo = -1; tm.hi_ = 63; tm.on = valid;
        const float cinit = valid ? 0.f : -INFINITY; const bool allv = __all(valid);
        for (int t = 0; t < 4; ++t) { f32x16 p0, p1; if (allv) qk_tile(L + t * 8192, qr, r32, hi, p0, p1); else qk_tile(L + t * 8192, qr, r32, hi, p0, p1, cinit);
            __builtin_amdgcn_sched_barrier(0);
            sm_process(p0, p1, m, l, o, tm);
            __builtin_amdgcn_sched_barrier(0);
            pv_tile(L + 32768 + t * 8192, p0, p1, o, lane, hi); }
        const float lt = swap_sum(l);
        if (valid) { const size_t pi = ((size_t)bh * SEQ + tq) * 3 + slot;
            store_o(parto + pi * 64, o, hi, 1.0f / lt);
            if (hi == 0) { partml[pi * 2] = m; partml[pi * 2 + 1] = lt; } }
    }
    return p;
}
__device__ __forceinline__ void moba_merge(Frame& F, const float* dout) {
    const bf16* qkv = (const bf16*)(F.ws + WS_QKV);
    const unsigned* selp = (const unsigned*)((const unsigned char*)dout + MB_SELP);
    const bf16* parto = (const bf16*)((const unsigned char*)dout + MB_PARTO); const float* partml = (const float*)((const unsigned char*)dout + MB_PARTML);
    bf16* O = (bf16*)(F.ws + WS_O);
    const int lane = F.lane, r32 = lane & 31, hi = lane >> 5, w = F.wave;
    for (int u = F.vcu; u < 1024; u += F.G) {
        const int bh = u >> 5, cur = u & 31, b = bh >> 3, h = bh & 7, tq = cur * 256 + 32 * w + r32;
        bf16x8 qr[4];
#pragma unroll
        for (int d0 = 0; d0 < 4; ++d0) qr[d0] = *(const bf16x8*)(qkv + pg8::E_QM + ((size_t)bh * SEQ + tq) * 64 + 16 * d0 + 8 * hi);
        float m = -1e30f, l = 0.f; f32x16 o[2];
#pragma unroll
        for (int r = 0; r < 16; ++r) { o[0][r] = 0.f; o[1][r] = 0.f; }
        const int wmax = cur * 256 + 32 * w + 31;
        sm_stream(F, qkv + pg8::E_KM + (size_t)bh * SEQ * 64, qkv + pg8::E_VM + (size_t)bh * SEQ * 64, 4 * cur, 4 * cur + 4, qr, m, l, o,
            [=](int t) { return 64 * t <= wmax; }, [=](int t) { TileMask tm; tm.lo = -1; tm.hi_ = tq - 64 * t - 4 * hi; tm.on = true; return tm; });
        float L = swap_sum(l);
        const unsigned sp = selp[(size_t)bh * SEQ + tq];
        float ms[3], ls[3]; float M = m;
#pragma unroll
        for (int s = 0; s < 3; ++s) { const bool on = ((sp >> (8 * s)) & 255u) != 255u; const size_t pi = ((size_t)bh * SEQ + tq) * 3 + s;
            ms[s] = on ? partml[pi * 2] : -1e30f; ls[s] = on ? partml[pi * 2 + 1] : 0.f; M = fmaxf(M, ms[s]); }
        const float wo = __builtin_amdgcn_exp2f(m - M); L *= wo;
#pragma unroll
        for (int r = 0; r < 16; ++r) { o[0][r] *= wo; o[1][r] *= wo; }
#pragma unroll
        for (int s = 0; s < 3; ++s) { const float ws_ = ls[s] * __builtin_amdgcn_exp2f(ms[s] - M); L += ws_;
            if (ls[s] > 0.f) { const bf16* po = parto + (((size_t)bh * SEQ + tq) * 3 + s) * 64;
#pragma unroll
                for (int dh = 0; dh < 2; ++dh)
#pragma unroll
                    for (int g = 0; g < 4; ++g) { const v2u pk = *(const v2u*)(po + 32 * dh + 8 * g + 4 * hi);
                        o[dh][4 * g] = fmaf(ws_, bflo(pk.x), o[dh][4 * g]); o[dh][4 * g + 1] = fmaf(ws_, bfhi(pk.x), o[dh][4 * g + 1]);
                        o[dh][4 * g + 2] = fmaf(ws_, bflo(pk.y), o[dh][4 * g + 2]); o[dh][4 * g + 3] = fmaf(ws_, bfhi(pk.y), o[dh][4 * g + 3]); } } }
        store_o(O + (size_t)(b * SEQ + tq) * 1024 + 512 + h * 64, o, hi, 1.0f / fmaxf(L, 1e-30f));
    }
}
constexpr int NSA_IMPG = 32768, NSA_IMPL = NSA_IMPG + 64 * 129 * 4, NSA_SEL = NSA_IMPL + 64 * 129 * 4;
__device__ __forceinline__ void nsa_unit(Frame& F, const int bkv, const int c) {
    const bf16* qkv = (const bf16*)(F.ws + WS_QKV);
    const float* gates = (const float*)(F.ws + WS_GATES);
    const bf16* KC = (const bf16*)(F.ws + WS_KC); const bf16* VC = (const bf16*)(F.ws + WS_VC);
    bf16* O = (bf16*)(F.ws + WS_O);
    LAS float* impG = (LAS float*)(F.lds + NSA_IMPG); LAS float* impL = (LAS float*)(F.lds + NSA_IMPL); LAS unsigned short* sel16 = (LAS unsigned short*)(F.lds + NSA_SEL);
    const int lane = F.lane, r32 = lane & 31, hi = lane >> 5, w = F.wave, ql = 8 * w + (r32 >> 2), g = r32 & 3;
    {
        const int b = bkv >> 1, kv = bkv & 1, h = kv * 4 + g, tq = 64 * c + ql, tok = b * SEQ + tq;
        bf16x8 qr[4];
#pragma unroll
        for (int d0 = 0; d0 < 4; ++d0) qr[d0] = *(const bf16x8*)(qkv + pg8::E_QA + ((size_t)(b * 8 + h) * SEQ + tq) * 64 + 16 * d0 + 8 * hi);
        const float g0 = gates[(size_t)tok * 24 + h * 3 + 0], g1 = gates[(size_t)tok * 24 + h * 3 + 1], g2 = gates[(size_t)tok * 24 + h * 3 + 2];
        f32x16 o[2]; LAS float* otl = (LAS float*)(F.lds + NSA_IMPG) + F.tid;
        for (int i = F.tid; i < 2 * 64 * 129; i += 512) impG[i] = 0.f;
        const int nvis = tq >= 31 ? min((tq - 31) / 16 + 1, 511) : 0, ntc = (4 * c + 66) >> 6;
        const bf16* kcp = KC + (size_t)bkv * 512 * 64; const bf16* vcp = VC + (size_t)bkv * 512 * 64;
        float m = -1e30f, l = 0.f;
#pragma unroll
        for (int r = 0; r < 16; ++r) { o[0][r] = 0.f; o[1][r] = 0.f; }
        sm_stream(F, kcp, vcp, 0, ntc, qr, m, l, o, [=](int t) { return true; }, [=](int t) { TileMask tm; tm.lo = -1; tm.hi_ = nvis - 1 - 64 * t - 4 * hi; tm.on = true; return tm; });
        float linv = 1.0f / fmaxf(swap_sum(l), 1e-30f);
#pragma unroll
        for (int r = 0; r < 16; ++r) { o[0][r] *= g0 * linv; o[1][r] *= g0 * linv; }
        if (c >= 16) {
            LAS unsigned char* L = F.lds;
            { const v4u kr = *(const v4u*)(kcp + (size_t)lane * 64 + w * 8); *(LAS v4u*)(L + w * 1024 + lane * 16) = kr; }
            __syncthreads();
            for (int t = 0; t < ntc; ++t) {
                v4u kn; if (t + 1 < ntc) kn = *(const v4u*)(kcp + (size_t)(t + 1) * 4096 + (size_t)lane * 64 + w * 8);
                f32x16 p0, p1; qk_tile(L + (t & 1) * 8192, qr, r32, hi, p0, p1);
#pragma unroll
                for (int uu = 0; uu < 8; ++uu) { float pe[4];
#pragma unroll
                    for (int e = 0; e < 4; ++e) { const int i = 4 * uu + e; const float s = i < 16 ? p0[i] : p1[i - 16]; const int n = 64 * t + 32 * (i >> 4) + crow(i & 15, hi);
                        pe[e] = n < nvis ? __builtin_amdgcn_exp2f(s - m) * linv : 0.f; }
                    float G = (pe[0] + pe[1]) + (pe[2] + pe[3]), Lst = pe[3];
                    G += __shfl_xor(G, 1); G += __shfl_xor(G, 2); Lst += __shfl_xor(Lst, 1); Lst += __shfl_xor(Lst, 2);
                    const int j = 16 * t + 2 * uu + hi;
                    if (g == 0 && j < 128) { impG[ql * 129 + j] = G; impL[ql * 129 + j + 1] = Lst; } }
                if (t + 1 < ntc) *(LAS v4u*)(L + ((t + 1) & 1) * 8192 + w * 1024 + lane * 16) = kn;
                __syncthreads();
            }
        }
        __syncthreads();
        { const int qs = F.tid >> 3, k8 = F.tid & 7; unsigned bits = 0u;
          if (c < 16) { if (k8 == 0) bits = (1u << (c + 1)) - 1u; }
          else { float v[16];
#pragma unroll
              for (int e = 0; e < 16; ++e) { const int j = 16 * k8 + e; v[e] = (j >= 1 && j <= c - 2) ? impG[qs * 129 + j] + impL[qs * 129 + j] : -1.0f;
                  if (j == 0 || j == c - 1 || j == c) bits |= 1u << e; }
              for (int rnd = 0; rnd < 13; ++rnd) { float bv = -1.0f; int bj = 999;
#pragma unroll
                  for (int e = 0; e < 16; ++e) { if (v[e] > bv) { bv = v[e]; bj = 16 * k8 + e; } }
#pragma unroll
                  for (int sh = 1; sh < 8; sh <<= 1) { const float ov = __shfl_xor(bv, sh); const int oj = __shfl_xor(bj, sh); if (better(ov, oj, bv, bj)) { bv = ov; bj = oj; } }
#pragma unroll
                  for (int e = 0; e < 16; ++e) { if (bj == 16 * k8 + e) { v[e] = -1.0f; bits |= 1u << e; } } } }
          sel16[qs * 8 + k8] = (unsigned short)bits; }
        __syncthreads();
#pragma unroll
        for (int r = 0; r < 16; ++r) { otl[r * 512] = o[0][r]; otl[(16 + r) * 512] = o[1][r]; }
        m = -1e30f; l = 0.f;
#pragma unroll
        for (int r = 0; r < 16; ++r) { o[0][r] = 0.f; o[1][r] = 0.f; }
        { const LAS unsigned short* myrow = sel16 + ql * 8;
          sm_stream(F, qkv + pg8::E_KSLC + (size_t)bkv * SEQ * 64, qkv + pg8::E_VSLC + (size_t)bkv * SEQ * 64, 0, c + 1, qr, m, l, o,
              [=](int t) { return __ballot((myrow[t >> 4] >> (t & 15)) & 1) != 0ull; },
              [=](int t) { TileMask tm; tm.lo = -1; tm.hi_ = tq - 64 * t - 4 * hi; tm.on = ((myrow[t >> 4] >> (t & 15)) & 1) != 0; return tm; }); }
        linv = 1.0f / fmaxf(swap_sum(l), 1e-30f);
#pragma unroll
        for (int r = 0; r < 16; ++r) { otl[r * 512] = fmaf(g1 * linv, o[0][r], otl[r * 512]); otl[(16 + r) * 512] = fmaf(g1 * linv, o[1][r], otl[(16 + r) * 512]); }
        m = -1e30f; l = 0.f;
#pragma unroll
        for (int r = 0; r < 16; ++r) { o[0][r] = 0.f; o[1][r] = 0.f; }
        sm_stream(F, qkv + pg8::E_KWIN + (size_t)bkv * SEQ * 64, qkv + pg8::E_VWIN + (size_t)bkv * SEQ * 64, max(c - 8, 0), c + 1, qr, m, l, o,
            [=](int t) { return true; }, [=](int t) { TileMask tm; tm.hi_ = tq - 64 * t - 4 * hi; tm.lo = tm.hi_ - 512; tm.on = true; return tm; });
        linv = 1.0f / fmaxf(swap_sum(l), 1e-30f);
#pragma unroll
        for (int r = 0; r < 16; ++r) { o[0][r] = fmaf(g2 * linv, o[0][r], otl[r * 512]); o[1][r] = fmaf(g2 * linv, o[1][r], otl[(16 + r) * 512]); }
        store_o(O + (size_t)tok * 1024 + h * 64, o, hi, 1.0f);
        __syncthreads();
    }
}

__global__ void __launch_bounds__(NWAVES * 64, 2) fwd_kernel(Args args) {
    extern __shared__ __attribute__((aligned(16))) unsigned char lds[];
    Frame F;
    F.lds = (LAS unsigned char*)lds; F.ws = args.ws;
    F.tid = threadIdx.x; F.lane = F.tid & 63; F.wave = __builtin_amdgcn_readfirstlane(F.tid >> 6);
    F.G = gridDim.x; { const int bx = blockIdx.x; F.vcu = (F.G % 8 == 0) ? (bx % 8) * (F.G / 8) + bx / 8 : bx; }
    for (int u = F.tid; u < (LDS_BYTES - LDSCTL_OFF) / 4; u += NWAVES * 64) ((LAS unsigned*)(F.lds + LDSCTL_OFF))[u] = 0u;
    __syncthreads();
    volatile LAS unsigned* MISC = (volatile LAS unsigned*)(F.lds + MISC_OFF);
    unsigned* ctl = (unsigned*)(args.ws + WS_CTL);
    XcdBarrier bar; bar.bar = ctl + CW_BAR + args.pad * XCD_BAR_WORDS; bar.x = 0; bar.st = nullptr;
    if (args.use_bar) bar = xcd_barrier_post(ctl + CW_BAR + args.pad * XCD_BAR_WORDS, MISC + 8);
    const int lo = args.ph_lo, hi = args.ph_hi;
#ifdef ONLYPH
#define IN(k) ((k) == ONLYPH && lo <= (k) && (k) < hi)
#else
#define IN(k) (lo <= (k) && (k) < hi)
#endif
#ifdef PROBE_REP
#define NREP(k) ((k) == PROBE_REP ? 2 : 1)
#else
#define NREP(k) 1
#endif
#ifdef PROBE_BAR
#define SEAM(k) do { if (IN(k) && IN((k) + 1)) { xcd_barrier(bar); xcd_barrier(bar); } } while (0)
#else
#define SEAM(k) do { if (IN(k) && IN((k) + 1)) xcd_barrier(bar); } while (0)
#endif
    float* R = args.out;
    bf16* RB = (bf16*)(args.ws + WS_ABF);
    bf16* ABF = (bf16*)(args.ws + WS_ABF); bf16* OB = (bf16*)(args.ws + WS_O); bf16* QKV = (bf16*)(args.ws + WS_QKV);
    bf16* XS = (bf16*)(args.ws + WS_XS); bf16* HB = (bf16*)(args.ws + WS_H);

    if (IN(0)) { for (int rep = 0; rep < NREP(0); ++rep) p0_prologue(F, args); } SEAM(0);
    if (IN(1)) { pg8::Gemm g{ABF, (const bf16*)(args.ws + WS_WIN0), NTOK, 3072, DM}; pg8::StaticOrder S; S.init(NTOK, 3072, F.G, (int)blockIdx.x);
        pg8::EpiProj0 E{QKV, (float*)(args.ws + WS_GATES), (const float*)(args.ws + WS_COS), (const float*)(args.ws + WS_SIN)};
        pg8::gemm_phase<pg8::EpiProj0, pg8::StaticOrder, true, true>(F.lds, g, S, E); if (NREP(1) > 1) { __syncthreads(); pg8::gemm_phase<pg8::EpiProj0, pg8::StaticOrder, true, true>(F.lds, g, S, E); } } SEAM(1);
    if (IN(2)) { for (int rep = 0; rep < NREP(2); ++rep) p2_compress(F, args); } SEAM(2);
    if (IN(3)) { moba_gate(F, R); xcd_barrier(bar);
        { const int nmb = moba_part_setup(F, R), q2 = 1024 + ((nmb + 7) >> 3);
          volatile LAS int* qslot = (volatile LAS int*)(F.lds + MB_C32 + 256);
          for (;;) { __syncthreads();
              if (F.tid == 0) *qslot = (int)__hip_atomic_fetch_add(ctl + CW_Q, 1u, RLX_AGENT);
              __syncthreads();
              const int qi = *qslot; if (qi >= q2) break;
              if (qi < 1024) nsa_unit(F, qi & 7, 127 - (qi >> 3));
              else { const int u0 = (qi - 1024) * 8; int staged = -1; for (int u = u0; u < u0 + 8 && u < nmb; ++u) staged = moba_part_unit(F, R, u, staged); } } }
        xcd_barrier(bar);
        moba_merge(F, R);
    } SEAM(3);
    if (IN(4)) { pg8::Gemm g{OB, (const bf16*)(args.ws + WS_WOUT0), NTOK, DM, DM}; pg8::StaticOrder S; S.init(NTOK, DM, F.G, (int)blockIdx.x);
        pg8::EpiResB E{RB, ALPHA};
        pg8::gemm_phase<pg8::EpiResB, pg8::StaticOrder, true, true>(F.lds, g, S, E); } SEAM(4);
    if (IN(5)) { ln_phase<true, false>(F, args, 0, args.in[12], args.in[13], RB, nullptr); } SEAM(5);
    if (IN(6)) { for (int rep = 0; rep < NREP(6); ++rep) scatter_phase(F); } SEAM(6);
    if (IN(7)) { const int np = load_ptab(F); pg8::Gemm g{ABF, nullptr, MAXROWS, 1024, DM};
        MoeOrder1 S{F.G, (int)blockIdx.x, np * 4, (const LAS int*)(F.lds + PTAB_OFF), (const bf16*)(args.ws + WS_W1E), (const int*)(args.ws + WS_ROWMAP)};
        pg8::EpiMoe1 E{HB, (const float*)(args.ws + WS_WROW)};
        pg8::gemm_phase<pg8::EpiMoe1, MoeOrder1, true, true>(F.lds, g, S, E); } SEAM(7);
    if (IN(8)) { const int np = load_ptab(F); pg8::Gemm g{HB, nullptr, MAXROWS, 1024, 512};
        MoeOrder2 S{F.G, (int)blockIdx.x, np * 4, (const LAS int*)(F.lds + PTAB_OFF), (const bf16*)(args.ws + WS_B2)};
        pg8::EpiMoe2 E{RB, (const int*)(args.ws + WS_ROWMAP), ALPHA};
        pg8::gemm_phase<pg8::EpiMoe2, MoeOrder2, true, true>(F.lds, g, S, E); } SEAM(8);
    if (IN(9)) { ln_phase<false, false>(F, args, 0, args.in[14], args.in[15], RB, nullptr); } SEAM(9);
    if (IN(10)) { pg8::Gemm g{ABF, (const bf16*)(args.ws + WS_WIN1), NTOK, 3072, DM}; pg8::StaticOrder S; S.init(NTOK, 3072, F.G, (int)blockIdx.x);
        pg8::EpiProj1 E{QKV};
        pg8::gemm_phase<pg8::EpiProj1, pg8::StaticOrder, true, true>(F.lds, g, S, E); if (NREP(10) > 1) { __syncthreads(); pg8::gemm_phase<pg8::EpiProj1, pg8::StaticOrder, true, true>(F.lds, g, S, E); } } SEAM(10);
    if (IN(11)) { for (int rep = 0; rep < NREP(11); ++rep) p11_sb_mfma(F); } SEAM(11);
    if (IN(12)) { pg8::Gemm g{OB, (const bf16*)(args.ws + WS_WOUT1), NTOK, DM, DM}; pg8::StaticOrder S; S.init(NTOK, DM, F.G, (int)blockIdx.x);
        pg8::EpiResB E{RB, ALPHA};
        pg8::gemm_phase<pg8::EpiResB, pg8::StaticOrder, true, true>(F.lds, g, S, E); } SEAM(12);
    if (IN(13)) { ln_phase<true, false>(F, args, 1, args.in[12] + DM, args.in[13] + DM, RB, nullptr); } SEAM(13);
    if (IN(14)) { scatter_phase(F); } SEAM(14);
    if (IN(15)) { const int np = load_ptab(F); pg8::Gemm g{ABF, nullptr, MAXROWS, 1024, DM};
        MoeOrder1 S{F.G, (int)blockIdx.x, np * 4, (const LAS int*)(F.lds + PTAB_OFF), (const bf16*)(args.ws + WS_W1E) + (size_t)16 * 512 * 1024, (const int*)(args.ws + WS_ROWMAP)};
        pg8::EpiMoe1 E{HB, (const float*)(args.ws + WS_WROW)};
        pg8::gemm_phase<pg8::EpiMoe1, MoeOrder1, true, true>(F.lds, g, S, E); } SEAM(15);
    if (IN(16)) { const int np = load_ptab(F); pg8::Gemm g{HB, nullptr, MAXROWS, 1024, 512};
        MoeOrder2 S{F.G, (int)blockIdx.x, np * 4, (const LAS int*)(F.lds + PTAB_OFF), (const bf16*)(args.ws + WS_B2) + (size_t)24 * 1024 * 512};
        pg8::EpiMoe2 E{RB, (const int*)(args.ws + WS_ROWMAP), ALPHA};
        pg8::gemm_phase<pg8::EpiMoe2, MoeOrder2, true, true>(F.lds, g, S, E); } SEAM(16);
    if (IN(17)) { ln_phase<false, true>(F, args, 1, args.in[14] + DM, args.in[15] + DM, RB, R); }
#undef IN
#undef SEAM
}


#ifdef PROBE_ATTN
__device__ __forceinline__ void mkframe(Frame& F, const Args& args, unsigned char* lds) { F.lds = (LAS unsigned char*)lds; F.ws = args.ws; F.tid = threadIdx.x; F.lane = F.tid & 63; F.wave = __builtin_amdgcn_readfirstlane(F.tid >> 6);
    F.G = gridDim.x; const int bx = blockIdx.x; F.vcu = (F.G % 8 == 0) ? (bx % 8) * (F.G / 8) + bx / 8 : bx; }
__global__ void __launch_bounds__(NWAVES * 64, 2) probe_naive(Args args) { extern __shared__ __attribute__((aligned(16))) unsigned char lds[]; Frame F; mkframe(F, args, lds);
    p3_nsa_naive(F, args, (bf16*)args.out); p3_moba_naive(F, args, (bf16*)args.out); }
__global__ void __launch_bounds__(NWAVES * 64, 2) probe_cmp(Args args) { extern __shared__ __attribute__((aligned(16))) unsigned char lds[]; Frame F; mkframe(F, args, lds);
    const bf16* o1 = (const bf16*)(args.ws + WS_O); const bf16* o2 = (const bf16*)args.out; float num = 0.f, den = 0.f;
    for (size_t i = (size_t)(F.vcu * 512 + F.tid); i < (size_t)NTOK * 1024; i += (size_t)F.G * 512) { if ((int)((i & 1023) >> 9) != PROBE_ATTN - 1) continue; const float a = bf2f(o1[i]), b = bf2f(o2[i]); num += (a - b) * (a - b); den += b * b; }
    num = wave_sum(num); den = wave_sum(den);
    if (F.lane == 0) { atomicAdd((float*)(args.ws + WS_CTL) + 32768, num); atomicAdd((float*)(args.ws + WS_CTL) + 32769, den); } }
__global__ void __launch_bounds__(NWAVES * 64, 2) probe_scale(Args args) { const float num = ((const float*)(args.ws + WS_CTL))[32768], den = ((const float*)(args.ws + WS_CTL))[32769], sc = 1.0f + 10.0f * sqrtf(num / fmaxf(den, 1e-30f));
    for (size_t i = (size_t)blockIdx.x * 512 + threadIdx.x; i < (size_t)NTOK * DM / 4; i += (size_t)gridDim.x * 512) { f32x4 v = ((const f32x4*)args.out)[i]; v = v * sc; ((f32x4*)args.out)[i] = v; } }
#endif
extern "C" void kernel_launch(void* const* d_in, const int* in_sizes, int n_in, void* d_out, int out_size, void* d_ws, size_t ws_size, hipStream_t stream) {
    static int grid = 0;
    if (grid == 0) {
        if (n_in != 23 || in_sizes[0] != NTOK * DM || out_size != NTOK * DM || ws_size < WS_END) { fprintf(stderr, "kernel_launch: unexpected shapes (n_in %d, in0 %d, out %d, ws %zu); nothing launched\n", n_in, n_in > 0 ? in_sizes[0] : -1, out_size, ws_size); grid = -1; return; }
        int dev = 0, cus = 0, per_cu = 0;
        if (hipGetDevice(&dev) != hipSuccess || hipDeviceGetAttribute(&cus, hipDeviceAttributeMultiprocessorCount, dev) != hipSuccess) { grid = -1; return; }
        if (hipFuncSetAttribute((const void*)fwd_kernel, hipFuncAttributeMaxDynamicSharedMemorySize, LDS_BYTES) != hipSuccess) { fprintf(stderr, "kernel_launch: hipFuncSetAttribute failed\n"); grid = -1; return; }
        if (hipOccupancyMaxActiveBlocksPerMultiprocessor(&per_cu, (const void*)fwd_kernel, NWAVES * 64, LDS_BYTES) != hipSuccess || per_cu < 1) { fprintf(stderr, "kernel_launch: occupancy query reports %d workgroups per CU\n", per_cu); }
        (void)hipGetLastError();
        grid = cus;
    }
    if (grid < 0) return;
    if (hipMemsetAsync((char*)d_ws + WS_CTL, 0, CTL_ZERO_BYTES, stream) != hipSuccess) return;
    Args a{};
    for (int i = 0; i < 23; ++i) a.in[i] = (const float*)d_in[i];
    a.out = (float*)d_out; a.ws = (unsigned char*)d_ws; a.pad = 0;
#if defined(PROBE_ATTN)
    hipFuncSetAttribute((const void*)probe_naive, hipFuncAttributeMaxDynamicSharedMemorySize, LDS_BYTES);
    a.ph_lo = 0; a.ph_hi = 4; a.use_bar = 1; a.pad = 0; hipLaunchKernelGGL(fwd_kernel, dim3(grid), dim3(NWAVES * 64), LDS_BYTES, stream, a);
    hipLaunchKernelGGL(probe_naive, dim3(grid), dim3(NWAVES * 64), LDS_BYTES, stream, a);
    hipLaunchKernelGGL(probe_cmp, dim3(grid), dim3(NWAVES * 64), 0, stream, a);
    a.ph_lo = 4; a.ph_hi = NPH; a.use_bar = 1; a.pad = 1; hipLaunchKernelGGL(fwd_kernel, dim3(grid), dim3(NWAVES * 64), LDS_BYTES, stream, a);
    hipLaunchKernelGGL(probe_scale, dim3(grid), dim3(NWAVES * 64), 0, stream, a);
#elif MK_N_LAUNCHES == 1
    a.ph_lo = 0; a.ph_hi = NPH; a.use_bar = 1;
    hipLaunchKernelGGL(fwd_kernel, dim3(grid), dim3(NWAVES * 64), LDS_BYTES, stream, a);
#else
    for (int p = 0; p < NPH; ++p) { a.ph_lo = p; a.ph_hi = p + 1; a.use_bar = 0;
        hipLaunchKernelGGL(fwd_kernel, dim3(grid), dim3(NWAVES * 64), LDS_BYTES, stream, a); }
#endif
}
```
